# Optimizing an MI355X kernel written in HIP

```python
import math
import jax, jax.numpy as jnp
from jax import lax
import numpy as np

D_MODEL = 2048
BATCH = 4
SEQ = 2048
DEPTH = 4

N_MIXERS = 4
N_LAYERS_A = (DEPTH + N_MIXERS - 1) // N_MIXERS
N_LAYERS_B = (DEPTH + N_MIXERS - 2) // N_MIXERS
N_LAYERS_C = (DEPTH + N_MIXERS - 3) // N_MIXERS
N_LAYERS_D = (DEPTH + N_MIXERS - 4) // N_MIXERS

MEM_LEN = 256
D_FF = 5632
RMS_EPS = 1e-6
BLOCK = 128

MEM_HEADS = 4
MEM_HEAD_DIM = 128
MEM_WIDTH = MEM_HEADS * MEM_HEAD_DIM

CONV_WIDTH = D_MODEL
CONV_K = 3
CONV_IN = 3 * CONV_WIDTH

MLA_HEADS = 16
MLA_Q_RANK = 512
MLA_KV_RANK = 512
MLA_NOPE = 128
MLA_ROPE = 64
MLA_V = 128
MLA_QK = MLA_NOPE + MLA_ROPE
MLA_IN = MLA_Q_RANK + MLA_KV_RANK + MLA_ROPE
ROPE_THETA = 10000.0

SWA_Q_HEADS = 32
SWA_KV_HEADS = 4
SWA_HEAD_DIM = 64
WINDOW = 128
SWA_IN = (SWA_Q_HEADS + 2 * SWA_KV_HEADS) * SWA_HEAD_DIM
REL_BUCKETS = 32
REL_MAX_DIST = 128

FOX_HEADS = 32
FOX_HEAD_DIM = 64
FOX_WIDTH = FOX_HEADS * FOX_HEAD_DIM
FOX_IN = 3 * FOX_WIDTH + FOX_HEADS

kernel_name = "hybrid_interleaved_macaron_trunk"


def rms_norm(x, g):
    xf = x.astype(jnp.float32)
    y = xf * lax.rsqrt(jnp.mean(xf * xf, axis=-1, keepdims=True) + RMS_EPS)
    return (y * g.astype(jnp.float32)).astype(x.dtype)


def swiglu(h, w_gate, w_up, w_down):
    return (jax.nn.silu(h @ w_gate) * (h @ w_up)) @ w_down


def rope(t, pos):
    half = t.shape[-1] // 2
    inv = ROPE_THETA ** (-jnp.arange(half, dtype=jnp.float32) / half)
    ang = pos.astype(jnp.float32)[:, None] * inv
    cos = jnp.cos(ang)[:, None, :]
    sin = jnp.sin(ang)[:, None, :]
    t1 = t[..., :half].astype(jnp.float32)
    t2 = t[..., half:].astype(jnp.float32)
    return jnp.concatenate([t1 * cos - t2 * sin, t1 * sin + t2 * cos], axis=-1).astype(t.dtype)


def t5_causal_bucket(dist):
    exact = REL_BUCKETS // 2
    d = np.maximum(dist, 0)
    log_b = exact + (np.log(np.maximum(d, 1) / exact) / np.log(REL_MAX_DIST / exact)
                     * (REL_BUCKETS - exact)).astype(np.int32)
    log_b = np.minimum(log_b, REL_BUCKETS - 1)
    return np.where(d < exact, d, log_b).astype(np.int32)


def causal_attention_blocks(q, k, v, scale, log_f_cum=None):
    b, s, h, _ = q.shape
    nblk = s // BLOCK
    k_pos = jnp.arange(s)
    c_bhs = None if log_f_cum is None else log_f_cum.astype(jnp.float32).transpose(0, 2, 1)

    def one_block(i):
        start = i * BLOCK
        qb = lax.dynamic_slice_in_dim(q, start, BLOCK, axis=1)
        logits = jnp.einsum('bqhd,bkhd->bhqk', qb, k, preferred_element_type=jnp.float32) * scale
        if c_bhs is not None:
            cq = lax.dynamic_slice_in_dim(c_bhs, start, BLOCK, axis=2)
            logits = logits + (cq[..., :, None] - c_bhs[..., None, :])
        q_pos = start + jnp.arange(BLOCK)
        mask = k_pos[None, :] <= q_pos[:, None]
        logits = jnp.where(mask, logits, -jnp.inf)
        p = jax.nn.softmax(logits, axis=-1).astype(v.dtype)
        return jnp.einsum('bhqk,bkhd->bqhd', p, v)

    out = lax.map(one_block, jnp.arange(nblk))
    return out.swapaxes(0, 1).reshape(b, s, h, v.shape[-1])


def sliding_window_attention(q, k, v, sinks, rel_bias):
    b, s, hq, d = q.shape
    hkv = k.shape[2]
    g = hq // hkv
    nblk = s // BLOCK
    qb = q.reshape(b, nblk, BLOCK, hkv, g, d)

    def band(t):
        tb = t.reshape(b, nblk, BLOCK, hkv, d)
        prev = jnp.pad(tb, ((0, 0), (1, 0), (0, 0), (0, 0), (0, 0)))[:, :-1]
        return jnp.concatenate([prev, tb], axis=2)

    kb, vb = band(k), band(v)
    logits = jnp.einsum('bnqhgd,bnkhd->bnhgqk', qb, kb,
                        preferred_element_type=jnp.float32) * (1.0 / math.sqrt(d))
    dist = np.arange(BLOCK)[:, None] + BLOCK - np.arange(2 * BLOCK)[None, :]
    in_window = (dist >= 0) & (dist < WINDOW)
    bias = rel_bias.astype(jnp.float32)[t5_causal_bucket(dist)]
    bias = bias.reshape(BLOCK, 2 * BLOCK, hkv, g).transpose(2, 3, 0, 1)
    key_valid = (np.arange(nblk)[:, None] * BLOCK - BLOCK + np.arange(2 * BLOCK)[None, :]) >= 0
    mask = in_window[None] & key_valid[:, None, :]
    logits = jnp.where(mask[None, :, None, None], logits + bias, -jnp.inf)
    sink = sinks.astype(jnp.float32).reshape(hkv, g)[None, None, :, :, None, None]
    sink = jnp.broadcast_to(sink, logits.shape[:-1] + (1,))
    probs = jax.nn.softmax(jnp.concatenate([logits, sink], axis=-1), axis=-1)[..., :-1]
    out = jnp.einsum('bnhgqk,bnkhd->bnqhgd', probs.astype(v.dtype), vb)
    return out.reshape(b, s, hq, d)


def memory_attention(mq, mk, mv):
    logits = jnp.einsum('bshd,bmhd->bhsm', mq, mk,
                        preferred_element_type=jnp.float32) * (1.0 / math.sqrt(MEM_HEAD_DIM))
    p = jax.nn.softmax(logits, axis=-1).astype(mv.dtype)
    return jnp.einsum('bhsm,bmhd->bshd', p, mv)


def short_conv_mixer(u, conv_w):
    s = u.shape[1]
    gb, gc, xt = jnp.split(u, 3, axis=-1)
    z = gc * xt
    zp = jnp.pad(z, ((0, 0), (CONV_K - 1, 0), (0, 0)))
    conv = zp[:, 0:s] * conv_w[0]
    for tap in range(1, CONV_K):
        conv = conv + zp[:, tap:tap + s] * conv_w[tap]
    return gb * conv


def mla_mixer(u, q_a_norm, w_q_b, kv_a_norm, w_kv_b, q_norm, k_norm):
    b, s, _ = u.shape
    q_lat = u[..., :MLA_Q_RANK]
    kv_lat = u[..., MLA_Q_RANK:MLA_Q_RANK + MLA_KV_RANK]
    k_rope = u[..., MLA_Q_RANK + MLA_KV_RANK:].reshape(b, s, 1, MLA_ROPE)
    q = (rms_norm(q_lat, q_a_norm) @ w_q_b).reshape(b, s, MLA_HEADS, MLA_QK)
    kv = (rms_norm(kv_lat, kv_a_norm) @ w_kv_b).reshape(b, s, MLA_HEADS, MLA_NOPE + MLA_V)
    k_nope, v = kv[..., :MLA_NOPE], kv[..., MLA_NOPE:]
    pos = jnp.arange(s)
    q_nope = rms_norm(q[..., :MLA_NOPE], q_norm[:MLA_NOPE])
    q_rot = rope(rms_norm(q[..., MLA_NOPE:], q_norm[MLA_NOPE:]), pos)
    k_nope = rms_norm(k_nope, k_norm[:MLA_NOPE])
    k_rot = rope(rms_norm(k_rope, k_norm[MLA_NOPE:]), pos)
    k_rot = jnp.broadcast_to(k_rot, (b, s, MLA_HEADS, MLA_ROPE))
    q_full = jnp.concatenate([q_nope, q_rot], axis=-1)
    k_full = jnp.concatenate([k_nope, k_rot], axis=-1)
    out = causal_attention_blocks(q_full, k_full, v, 1.0 / math.sqrt(MLA_QK))
    return out.reshape(b, s, MLA_HEADS * MLA_V)


def swa_mixer(u, q_norm, k_norm, sinks, rel_bias):
    b, s, _ = u.shape
    nq = SWA_Q_HEADS * SWA_HEAD_DIM
    nk = SWA_KV_HEADS * SWA_HEAD_DIM
    q = rms_norm(u[..., :nq].reshape(b, s, SWA_Q_HEADS, SWA_HEAD_DIM), q_norm)
    k = rms_norm(u[..., nq:nq + nk].reshape(b, s, SWA_KV_HEADS, SWA_HEAD_DIM), k_norm)
    v = u[..., nq + nk:].reshape(b, s, SWA_KV_HEADS, SWA_HEAD_DIM)
    out = sliding_window_attention(q, k, v, sinks, rel_bias)
    return out.reshape(b, s, nq)


def fox_mixer(u, b_f, q_norm, k_norm):
    b, s, _ = u.shape
    q = rms_norm(u[..., :FOX_WIDTH].reshape(b, s, FOX_HEADS, FOX_HEAD_DIM), q_norm)
    k = rms_norm(u[..., FOX_WIDTH:2 * FOX_WIDTH].reshape(b, s, FOX_HEADS, FOX_HEAD_DIM), k_norm)
    v = u[..., 2 * FOX_WIDTH:3 * FOX_WIDTH].reshape(b, s, FOX_HEADS, FOX_HEAD_DIM)
    f_logit = u[..., 3 * FOX_WIDTH:].astype(jnp.float32) + b_f.astype(jnp.float32)
    log_f_cum = jnp.cumsum(jax.nn.log_sigmoid(f_logit), axis=1)
    out = causal_attention_blocks(q, k, v, 1.0 / math.sqrt(FOX_HEAD_DIM), log_f_cum)
    return out.reshape(b, s, FOX_WIDTH)


def setup_inputs(seed: int = 0) -> dict:
    key = jax.random.key(seed)
    keys = iter(jax.random.split(key, 64))

    def nrm(shape, fan_in):
        return jax.random.normal(next(keys), shape, jnp.float32) * (fan_in ** -0.5)

    def gain(shape):
        return 1.0 + 0.1 * jax.random.normal(next(keys), shape, jnp.float32)

    d, f = D_MODEL, D_FF
    inp = {}
    inp["x"] = jax.random.normal(next(keys), (BATCH, SEQ, d), jnp.float32)
    inp["mem"] = jax.random.normal(next(keys), (BATCH, MEM_LEN, d), jnp.float32)
    inp["norm_ffn1"] = gain((DEPTH, d))
    inp["ffn1_w_gate"] = nrm((DEPTH, d, f), d)
    inp["ffn1_w_up"] = nrm((DEPTH, d, f), d)
    inp["ffn1_w_down"] = nrm((DEPTH, f, d), f)
    inp["norm_mix"] = gain((DEPTH, d))
    inp["norm_ffn2"] = gain((DEPTH, d))
    inp["ffn2_w_gate"] = nrm((DEPTH, d, f), d)
    inp["ffn2_w_up"] = nrm((DEPTH, d, f), d)
    inp["ffn2_w_down"] = nrm((DEPTH, f, d), f)
    inp["norm_mem"] = gain((DEPTH, d))
    inp["mem_w_kv"] = nrm((DEPTH, d, 2 * MEM_WIDTH), d)
    inp["mem_q_norm"] = gain((DEPTH, MEM_HEAD_DIM))
    inp["mem_k_norm"] = gain((DEPTH, MEM_HEAD_DIM))
    inp["conv_w_in"] = nrm((N_LAYERS_A, d, CONV_IN + MEM_WIDTH), d)
    inp["conv_w"] = nrm((N_LAYERS_A, CONV_K, CONV_WIDTH), CONV_K)
    inp["conv_w_out"] = nrm((N_LAYERS_A, CONV_WIDTH + MEM_WIDTH, d), CONV_WIDTH + MEM_WIDTH)
    inp["mla_w_in"] = nrm((N_LAYERS_B, d, MLA_IN + MEM_WIDTH), d)
    inp["mla_q_a_norm"] = gain((N_LAYERS_B, MLA_Q_RANK))
    inp["mla_w_q_b"] = nrm((N_LAYERS_B, MLA_Q_RANK, MLA_HEADS * MLA_QK), MLA_Q_RANK)
    inp["mla_kv_a_norm"] = gain((N_LAYERS_B, MLA_KV_RANK))
    inp["mla_w_kv_b"] = nrm((N_LAYERS_B, MLA_KV_RANK, MLA_HEADS * (MLA_NOPE + MLA_V)), MLA_KV_RANK)
    inp["mla_q_norm"] = gain((N_LAYERS_B, MLA_QK))
    inp["mla_k_norm"] = gain((N_LAYERS_B, MLA_QK))
    inp["mla_w_out"] = nrm((N_LAYERS_B, MLA_HEADS * MLA_V + MEM_WIDTH, d), MLA_HEADS * MLA_V + MEM_WIDTH)
    inp["swa_w_in"] = nrm((N_LAYERS_C, d, SWA_IN + MEM_WIDTH), d)
    inp["swa_q_norm"] = gain((N_LAYERS_C, SWA_HEAD_DIM))
    inp["swa_k_norm"] = gain((N_LAYERS_C, SWA_HEAD_DIM))
    inp["swa_sinks"] = 0.5 * jax.random.normal(next(keys), (N_LAYERS_C, SWA_Q_HEADS), jnp.float32)
    swa_out_in = SWA_Q_HEADS * SWA_HEAD_DIM + MEM_WIDTH
    inp["swa_w_out"] = nrm((N_LAYERS_C, swa_out_in, d), swa_out_in)
    inp["rel_bias"] = 0.5 * jax.random.normal(next(keys), (REL_BUCKETS, SWA_Q_HEADS), jnp.float32)
    inp["fox_w_in"] = nrm((N_LAYERS_D, d, FOX_IN + MEM_WIDTH), d)
    inp["fox_b_f"] = jax.random.uniform(next(keys), (N_LAYERS_D, FOX_HEADS), jnp.float32, 1.0, 4.0)
    inp["fox_q_norm"] = gain((N_LAYERS_D, FOX_HEAD_DIM))
    inp["fox_k_norm"] = gain((N_LAYERS_D, FOX_HEAD_DIM))
    inp["fox_w_out"] = nrm((N_LAYERS_D, FOX_WIDTH + MEM_WIDTH, d), FOX_WIDTH + MEM_WIDTH)
    return inp


def reference(x, mem, norm_ffn1, ffn1_w_gate, ffn1_w_up, ffn1_w_down, norm_mix,
              norm_ffn2, ffn2_w_gate, ffn2_w_up, ffn2_w_down,
              norm_mem, mem_w_kv, mem_q_norm, mem_k_norm,
              conv_w_in, conv_w, conv_w_out,
              mla_w_in, mla_q_a_norm, mla_w_q_b, mla_kv_a_norm, mla_w_kv_b, mla_q_norm, mla_k_norm, mla_w_out,
              swa_w_in, swa_q_norm, swa_k_norm, swa_sinks, swa_w_out, rel_bias,
              fox_w_in, fox_b_f, fox_q_norm, fox_k_norm, fox_w_out):
    b, s, _ = x.shape
    m_len = mem.shape[1]
    for i in range(DEPTH):
        kind, occ = i % N_MIXERS, i // N_MIXERS
        x = x + 0.5 * swiglu(rms_norm(x, norm_ffn1[i]), ffn1_w_gate[i], ffn1_w_up[i], ffn1_w_down[i])
        h = rms_norm(x, norm_mix[i])
        if kind == 0:
            u = h @ conv_w_in[occ]
            mix = short_conv_mixer(u[..., :-MEM_WIDTH], conv_w[occ])
            w_out = conv_w_out[occ]
        elif kind == 1:
            u = h @ mla_w_in[occ]
            mix = mla_mixer(u[..., :-MEM_WIDTH], mla_q_a_norm[occ], mla_w_q_b[occ], mla_kv_a_norm[occ],
                            mla_w_kv_b[occ], mla_q_norm[occ], mla_k_norm[occ])
            w_out = mla_w_out[occ]
        elif kind == 2:
            u = h @ swa_w_in[occ]
            mix = swa_mixer(u[..., :-MEM_WIDTH], swa_q_norm[occ], swa_k_norm[occ], swa_sinks[occ], rel_bias)
            w_out = swa_w_out[occ]
        else:
            u = h @ fox_w_in[occ]
            mix = fox_mixer(u[..., :-MEM_WIDTH], fox_b_f[occ], fox_q_norm[occ], fox_k_norm[occ])
            w_out = fox_w_out[occ]
        mkv = (rms_norm(mem, norm_mem[i]) @ mem_w_kv[i]).reshape(b, m_len, 2, MEM_HEADS, MEM_HEAD_DIM)
        mk = rms_norm(mkv[:, :, 0], mem_k_norm[i])
        mv = mkv[:, :, 1]
        mq = rms_norm(u[..., -MEM_WIDTH:].reshape(b, s, MEM_HEADS, MEM_HEAD_DIM), mem_q_norm[i])
        mem_out = memory_attention(mq, mk, mv).reshape(b, s, MEM_WIDTH)
        x = x + jnp.concatenate([mix, mem_out], axis=-1) @ w_out
        x = x + 0.5 * swiglu(rms_norm(x, norm_ffn2[i]), ffn2_w_gate[i], ffn2_w_up[i], ffn2_w_down[i])
    return x
```

```cpp
#include <hip/hip_runtime.h>
#include <cstdio>
#include <cstdint>

#ifndef MK_ONE_LAUNCH
#define MK_ONE_LAUNCH 0
#endif

#define LAS __attribute__((address_space(3)))
typedef unsigned short bf16_t;
typedef short bf16x8 __attribute__((ext_vector_type(8)));
typedef float f32x4 __attribute__((ext_vector_type(4)));
typedef float f32x16 __attribute__((ext_vector_type(16)));
typedef unsigned u32x4 __attribute__((ext_vector_type(4)));
typedef unsigned u32x2 __attribute__((ext_vector_type(2)));

constexpr int D_MODEL = 2048, BATCH = 4, SEQ = 2048, MTOK = BATCH * SEQ, D_FF = 5632, MEM_LEN = 256, MMEM = BATCH * MEM_LEN;
constexpr int N_GU = 2 * D_FF;
constexpr int NIN0 = 6656, NIN1 = 1792, NIN2 = 3072, NIN3 = 6912;
constexpr int K_OUT = 2560;
constexpr float RMS_EPS = 1e-6f;
constexpr float LOG2E = 1.4426950408889634f;

constexpr size_t MiB = 1u << 20;
constexpr size_t WS_CTL = 0, CTL_ZERO_BYTES = 1 * MiB;
constexpr size_t WS_PSUM = 1 * MiB, WS_UPS = 2 * MiB, WS_PSMEM = 3 * MiB, WS_CB = 4 * MiB;
constexpr size_t WS_XB = 8 * MiB, WS_MEMB = 40 * MiB, WS_MKV = 44 * MiB, WS_MK = 52 * MiB, WS_MVT = 56 * MiB;
constexpr size_t WS_CAT = 60 * MiB, WS_HID = 100 * MiB, WS_U = 188 * MiB, WS_QM = 296 * MiB, WS_KVM = 344 * MiB;
constexpr size_t WS_KBUF = 408 * MiB, WS_VTBUF = 456 * MiB;
constexpr size_t WS_WGU = 488 * MiB;
constexpr size_t WS_WD = 840 * MiB;
constexpr size_t WS_WIN0 = 1016 * MiB, WS_WIN1 = 1042 * MiB, WS_WIN2 = 1049 * MiB, WS_WIN3 = 1061 * MiB;
constexpr size_t WS_WOUT = 1088 * MiB;
constexpr size_t WS_WQB = 1128 * MiB, WS_WKVB = 1131 * MiB, WS_WMKV = 1135 * MiB, WS_END = 1151 * MiB;
constexpr size_t WGU_BYTES = (size_t)N_GU * D_MODEL * 2, WD_BYTES = (size_t)D_MODEL * D_FF * 2, WOUT_BYTES = (size_t)D_MODEL * K_OUT * 2;
static_assert(WGU_BYTES == 44 * MiB && WD_BYTES == 22 * MiB && WOUT_BYTES == 10 * MiB, "weight sizes");

enum { I_X = 0, I_MEM, I_NORM_FFN1, I_F1G, I_F1U, I_F1D, I_NORM_MIX, I_NORM_FFN2, I_F2G, I_F2U, I_F2D, I_NORM_MEM, I_MEM_WKV, I_MEM_QN, I_MEM_KN,
       I_CONV_WIN, I_CONV_W, I_CONV_WOUT, I_MLA_WIN, I_MLA_QAN, I_MLA_WQB, I_MLA_KVAN, I_MLA_WKVB, I_MLA_QN, I_MLA_KN, I_MLA_WOUT,
       I_SWA_WIN, I_SWA_QN, I_SWA_KN, I_SWA_SINKS, I_SWA_WOUT, I_REL_BIAS, I_FOX_WIN, I_FOX_BF, I_FOX_QN, I_FOX_KN, I_FOX_WOUT, N_INPUTS };

__device__ __forceinline__ unsigned pk2(float lo, float hi) {
    typedef __bf16 b2 __attribute__((ext_vector_type(2))); typedef float f2 __attribute__((ext_vector_type(2)));
    return __builtin_bit_cast(unsigned, __builtin_convertvector((f2){lo, hi}, b2)); }
__device__ __forceinline__ float bf_lo(unsigned w) { return __uint_as_float(w << 16); }
__device__ __forceinline__ float bf_hi(unsigned w) { return __uint_as_float(w & 0xffff0000u); }
__device__ __forceinline__ void unpack8(const u32x4 v, float (&f)[8]) {
    f[0] = bf_lo(v.x); f[1] = bf_hi(v.x); f[2] = bf_lo(v.y); f[3] = bf_hi(v.y); f[4] = bf_lo(v.z); f[5] = bf_hi(v.z); f[6] = bf_lo(v.w); f[7] = bf_hi(v.w); }
__device__ __forceinline__ u32x4 pack8(const float (&f)[8]) { u32x4 o; o.x = pk2(f[0], f[1]); o.y = pk2(f[2], f[3]); o.z = pk2(f[4], f[5]); o.w = pk2(f[6], f[7]); return o; }
#define GAS __attribute__((address_space(1)))
__device__ __forceinline__ const GAS char* uni_ptr(const char* p) {
    const unsigned long long v = (unsigned long long)p; const unsigned lo = __builtin_amdgcn_readfirstlane((unsigned)v), hi = __builtin_amdgcn_readfirstlane((unsigned)(v >> 32));
    return (const GAS char*)(((unsigned long long)hi << 32) | lo); }
__device__ __forceinline__ float rope_invf_turns(int i) {
    return __builtin_amdgcn_exp2f(-(float)i * (13.287712379549449f / 32.0f)) * 0.15915494309189535f; }
__device__ __forceinline__ void rope_cs(int pos, int i, float& c, float& s) {
    float t = (float)pos * rope_invf_turns(i); t = t - floorf(t); c = __builtin_amdgcn_cosf(t); s = __builtin_amdgcn_sinf(t); }

namespace pg8 {
constexpr int BM = 256, BK = 64, HALF = 128, HTB = HALF * BK * 2, STAGE_BYTES = 8 * HTB, NXCD = 8, WGM = 8;
__host__ __device__ __forceinline__ int lds_byte(int r, int c) { const int st = (r >> 4) * 2 + (c >> 5), rr = r & 15, cc = c & 31, ob = rr * 64 + cc * 2; return st * 1024 + (ob ^ (((ob >> 9) & 1) << 5)); }
__host__ __device__ __forceinline__ void stage_rc(int b, int& R, int& C) { const int st = b / 1024, sb = b % 1024, swz = sb ^ (((sb >> 9) & 1) << 5); R = (st >> 1) * 16 + swz / 64; C = (st & 1) * 32 + (swz % 64) / 2; }
__host__ __device__ __forceinline__ int perm32(int rho) { const int n = rho >> 4, i = rho & 15; return 8 * (i >> 2) + 4 * n + (i & 3); }
struct Unit { int pm, pn; };
struct Gemm { const bf16_t* A; const bf16_t* Bt; int M, N, K, lda; };
struct StaticOrder {
    int nM, nN, nwg, G, c;
    __host__ __device__ void init(int M, int N, int G_, int c_) { nM = M / BM; nN = N / BM; nwg = nM * nN; G = G_; c = c_; }
    __host__ __device__ bool next(int i, Unit& u) const {
        const long L = (long)i * G + c; if (L >= nwg) return false;
        int wgid = (int)L; { const int q = nwg / NXCD, r = nwg % NXCD, xcd = wgid % NXCD, off = wgid / NXCD; wgid = (xcd < r ? xcd * (q + 1) : r * (q + 1) + (xcd - r) * q) + off; }
        const int nig = WGM * nN, gid = wgid / nig, fm = gid * WGM, gsz = (nM - fm) < WGM ? (nM - fm) : WGM;
        u.pm = fm + ((wgid % nig) % gsz); u.pn = (wgid % nig) / gsz; return true;
    }
    __device__ __forceinline__ void a_ready(const Unit&) const {}
    __device__ __forceinline__ void done(const Unit&) const {}
};

template <int CNT>
__device__ __forceinline__ void rows_rstd(const float* ps, int pitch, int off, int row0, int fq, float inv_dim, float (&rs)[2][4]) {
    float t[2][4];
#pragma unroll
    for (int ai = 0; ai < 2; ++ai)
#pragma unroll
        for (int m = 0; m < 4; ++m) { const float* p = ps + (size_t)(row0 + ai * HALF + m * 16) * pitch + off + fq * (CNT / 4); float s = 0.f;
#pragma unroll
            for (int i = 0; i < CNT / 4; ++i) s += p[i];
            t[ai][m] = s; }
#pragma unroll
    for (int ai = 0; ai < 2; ++ai)
#pragma unroll
        for (int m = 0; m < 4; ++m) { float s = t[ai][m]; s += __shfl_xor(s, 16); s += __shfl_xor(s, 32); rs[ai][m] = 1.0f / sqrtf(s * inv_dim + RMS_EPS); }
}
__device__ __forceinline__ float silu_mul(float g, float u) { return g * __builtin_amdgcn_rcpf(1.0f + __builtin_amdgcn_exp2f(-g * LOG2E)) * u; }

struct EpiSwiGLU {
    static constexpr bool PERM = true, AFTER_DRAIN = false;
    bf16_t* H; const float* ps;
    __device__ __forceinline__ void operator()(const f32x4 (&acc)[2][2][4][2], const Unit& u, int wr, int wc, int fr, int fq) const {
        const int row0 = u.pm * BM + wr * 64 + fr, col0 = u.pn * 128 + wc * 32 + 8 * fq;
        float rs[2][4]; rows_rstd<32>(ps, 32, 0, row0, fq, 1.0f / D_MODEL, rs);
#pragma unroll
        for (int ai = 0; ai < 2; ++ai)
#pragma unroll
            for (int m = 0; m < 4; ++m) {
                const int row = row0 + ai * HALF + m * 16;
                const float r = rs[ai][m];
                const f32x4 g0 = acc[ai][0][m][0] * r, g1 = acc[ai][0][m][1] * r, u0 = acc[ai][1][m][0] * r, u1 = acc[ai][1][m][1] * r;
                u32x4 w;
                w.x = pk2(silu_mul(g0[0], u0[0]), silu_mul(g0[1], u0[1])); w.y = pk2(silu_mul(g0[2], u0[2]), silu_mul(g0[3], u0[3]));
                w.z = pk2(silu_mul(g1[0], u1[0]), silu_mul(g1[1], u1[1])); w.w = pk2(silu_mul(g1[2], u1[2]), silu_mul(g1[3], u1[3]));
                *(u32x4*)(H + (size_t)row * D_FF + col0) = w;
            }
    }
};
struct EpiResid {
    static constexpr bool PERM = false, AFTER_DRAIN = false;
    const float* base; float* out; bf16_t* xb; float* ps; float alpha;
    __device__ __forceinline__ void operator()(const f32x4 (&acc)[2][2][4][2], const Unit& u, int wr, int wc, int fr, int fq) const {
        const int row0 = u.pm * BM + wr * 64 + fr, col0 = u.pn * BM + wc * 32 + 4 * fq;
#pragma unroll
        for (int ai = 0; ai < 2; ++ai) {
            f32x4 bv[4][2][2];
#pragma unroll
            for (int m = 0; m < 4; ++m)
#pragma unroll
                for (int bj = 0; bj < 2; ++bj)
#pragma unroll
                    for (int n = 0; n < 2; ++n) bv[m][bj][n] = *(const f32x4*)(base + (size_t)(row0 + ai * HALF + m * 16) * D_MODEL + col0 + bj * HALF + n * 16);
#pragma unroll
            for (int m = 0; m < 4; ++m) {
                const int row = row0 + ai * HALF + m * 16; const size_t off = (size_t)row * D_MODEL + col0;
                float ss = 0.f;
#pragma unroll
                for (int bj = 0; bj < 2; ++bj)
#pragma unroll
                    for (int n = 0; n < 2; ++n) {
                        const f32x4 v = bv[m][bj][n] + acc[ai][bj][m][n] * alpha;
                        *(f32x4*)(out + off + bj * HALF + n * 16) = v;
                        u32x2 w; w.x = pk2(v[0], v[1]); w.y = pk2(v[2], v[3]);
                        *(u32x2*)(xb + off + bj * HALF + n * 16) = w;
                        ss += (v[0] * v[0] + v[1] * v[1]) + (v[2] * v[2] + v[3] * v[3]);
                    }
                ss += __shfl_xor(ss, 16); ss += __shfl_xor(ss, 32);
                if (fq == 0) ps[(size_t)row * 32 + u.pn * 4 + wc] = ss;
            }
        }
    }
};
template <int CNT, bool WPS> struct EpiScale {
    static constexpr bool PERM = true, AFTER_DRAIN = false;
    bf16_t* O; int ldo; const float* ps; int ps_pitch, ps_off; float inv_dim; float* ops;
    __device__ __forceinline__ void operator()(const f32x4 (&acc)[2][2][4][2], const Unit& u, int wr, int wc, int fr, int fq) const {
        const int row0 = u.pm * BM + wr * 64 + fr, col0 = u.pn * BM + wc * 32 + 8 * fq;
        float rs[2][4]; rows_rstd<CNT>(ps, ps_pitch, ps_off, row0, fq, inv_dim, rs);
#pragma unroll
        for (int ai = 0; ai < 2; ++ai)
#pragma unroll
            for (int m = 0; m < 4; ++m) {
                const int row = row0 + ai * HALF + m * 16;
                const float r = rs[ai][m];
                float ss = 0.f;
#pragma unroll
                for (int bj = 0; bj < 2; ++bj) {
                    const f32x4 v0 = acc[ai][bj][m][0] * r, v1 = acc[ai][bj][m][1] * r;
                    if (WPS) ss += (v0[0] * v0[0] + v0[1] * v0[1]) + (v0[2] * v0[2] + v0[3] * v0[3]) + (v1[0] * v1[0] + v1[1] * v1[1]) + (v1[2] * v1[2] + v1[3] * v1[3]);
                    u32x4 w; w.x = pk2(v0[0], v0[1]); w.y = pk2(v0[2], v0[3]); w.z = pk2(v1[0], v1[1]); w.w = pk2(v1[2], v1[3]);
                    *(u32x4*)(O + (size_t)row * ldo + col0 + bj * HALF) = w;
                }
                if (WPS) { ss += __shfl_xor(ss, 16); ss += __shfl_xor(ss, 32); if (fq == 0) ops[(size_t)row * 32 + u.pn * 4 + wc] = ss; }
            }
    }
};

template <class Epi, class Sched, bool ALIGN_EPI = true>
__device__ __forceinline__ void gemm_phase(LAS unsigned char* lds, const Gemm g, const Sched& S, const Epi& E) {
    const int tid = threadIdx.x, wid = __builtin_amdgcn_readfirstlane(tid >> 6), lane = tid & 63, wr = wid >> 2, wc = wid & 3, fr = lane & 15, fq = lane >> 4;
    const int K = g.K, nt = K / BK, lda = g.lda;
    unsigned voffA[2], voffB[2];
#pragma unroll
    for (int i = 0; i < 2; ++i) { int R, C; stage_rc(tid * 16 + i * 8192, R, C); const int Rb = Epi::PERM ? ((R & ~31) + perm32(R & 31)) : R;
        voffA[i] = (unsigned)(R * lda + C) * 2u; voffB[i] = (unsigned)(Rb * K + C) * 2u; }
    const size_t kstep = (size_t)(BK * 2);
    const size_t hstepA = (size_t)HALF * lda * 2, hstepB = (size_t)HALF * K * 2;
    const size_t tstepA = 2 * hstepA, tstepB = 2 * hstepB;
    const unsigned ldsw = (unsigned)wid * 1024u;
    const int aoff = lds_byte(wr * 64 + fr, fq * 8), boff = lds_byte(wc * 32 + fr, fq * 8);
#define PG8_SA(b, h) (((b) * 2 + (h)) * HTB)
#define PG8_SB(b, h) ((4 + (b) * 2 + (h)) * HTB)
#define PG8_STAGE(bufoff, gbase, voff) do { _Pragma("unroll") for (int _i = 0; _i < 2; ++_i) \
        __builtin_amdgcn_global_load_lds((const unsigned*)((const char*)(gbase) + (voff)[_i]), (LAS unsigned*)(lds + (bufoff) + ldsw + _i * 8192), 16, 0, 0); } while (0)
#define PG8_LDA(dst, b, h) do { _Pragma("unroll") for (int m = 0; m < 4; ++m) _Pragma("unroll") for (int k = 0; k < 2; ++k) dst[m][k] = *(const LAS bf16x8*)(lds + PG8_SA(b, h) + aoff + m * 2048 + k * 1024); } while (0)
#define PG8_LDB(dst, b, h) do { _Pragma("unroll") for (int n = 0; n < 2; ++n) _Pragma("unroll") for (int k = 0; k < 2; ++k) dst[n][k] = *(const LAS bf16x8*)(lds + PG8_SB(b, h) + boff + n * 2048 + k * 1024); } while (0)
#define PG8_MMA(ai, bj, At, Bt) do { __builtin_amdgcn_s_setprio(1); _Pragma("unroll") for (int m = 0; m < 4; ++m) _Pragma("unroll") for (int n = 0; n < 2; ++n) _Pragma("unroll") for (int k = 0; k < 2; ++k) \
        acc[ai][bj][m][n] = __builtin_amdgcn_mfma_f32_16x16x32_bf16(Bt[n][k], At[m][k], acc[ai][bj][m][n], 0, 0, 0); __builtin_amdgcn_s_setprio(0); } while (0)
#define PG8_WAIT_V(n) asm volatile("s_waitcnt vmcnt(" #n ")" ::: "memory")
#define PG8_WAIT_L(n) asm volatile("s_waitcnt lgkmcnt(" #n ")" ::: "memory")
#define PG8_BAR __builtin_amdgcn_s_barrier()
#define PG8_SCHED __builtin_amdgcn_sched_barrier(0)
    Unit cur, nxt; int ui = 0;
    if (!S.next(0, cur)) return;
    f32x4 acc[2][2][4][2];
#pragma unroll
    for (int a = 0; a < 2; ++a)
#pragma unroll
        for (int b = 0; b < 2; ++b)
#pragma unroll
            for (int m = 0; m < 4; ++m)
#pragma unroll
                for (int n = 0; n < 2; ++n) acc[a][b][m][n] = (f32x4){0.f, 0.f, 0.f, 0.f};
    bf16x8 At[4][2], B0[2][2], B1[2][2];
    const char* cA = (const char*)g.A + (size_t)cur.pm * tstepA; const char* cB = (const char*)g.Bt + (size_t)cur.pn * tstepB;
    S.a_ready(cur);
    PG8_STAGE(PG8_SB(0, 0), cB, voffB); PG8_STAGE(PG8_SB(0, 1), cB + hstepB, voffB); PG8_STAGE(PG8_SA(0, 0), cA, voffA); PG8_STAGE(PG8_SA(0, 1), cA + hstepA, voffA);
    if (wr == 1) PG8_BAR;
    PG8_WAIT_V(2); PG8_BAR;
    PG8_STAGE(PG8_SB(1, 0), cB + kstep, voffB); PG8_STAGE(PG8_SA(1, 0), cA + kstep, voffA); PG8_STAGE(PG8_SB(1, 1), cB + hstepB + kstep, voffB);
    PG8_WAIT_V(6); PG8_BAR;
    for (;;) {
        const bool has_next = S.next(ui + 1, nxt);
        const char* nA = has_next ? (const char*)g.A + (size_t)nxt.pm * tstepA : cA; const char* nB = has_next ? (const char*)g.Bt + (size_t)nxt.pn * tstepB : cB;
        for (int t = 0; t < nt; t += 2) {
            const bool last = (t == nt - 2);
            const char* a1 = cA + (size_t)(t + 1) * kstep;
            const char* a2 = last ? nA : cA + (size_t)(t + 2) * kstep; const char* b2 = last ? nB : cB + (size_t)(t + 2) * kstep;
            const char* a3 = a2 + kstep; const char* b3 = b2 + kstep;
            if (last && has_next) S.a_ready(nxt);
            PG8_LDB(B0, 0, 0); PG8_LDB(B1, 0, 1); PG8_SCHED; PG8_LDA(At, 0, 0); PG8_STAGE(PG8_SA(1, 1), a1 + hstepA, voffA);
            PG8_WAIT_V(8); PG8_WAIT_L(0); PG8_BAR; PG8_MMA(0, 0, At, B0); PG8_MMA(0, 1, At, B1); PG8_BAR; PG8_SCHED;
            PG8_LDA(At, 0, 1); PG8_STAGE(PG8_SB(0, 0), b2, voffB); PG8_STAGE(PG8_SB(0, 1), b2 + hstepB, voffB); PG8_STAGE(PG8_SA(0, 0), a2, voffA);
            PG8_WAIT_V(8); PG8_WAIT_L(0); PG8_BAR; PG8_MMA(1, 0, At, B0); PG8_MMA(1, 1, At, B1); PG8_BAR; PG8_SCHED;
            PG8_LDB(B0, 1, 0); PG8_LDB(B1, 1, 1); PG8_SCHED; PG8_LDA(At, 1, 0); PG8_STAGE(PG8_SA(0, 1), a2 + hstepA, voffA);
            PG8_WAIT_V(8); PG8_WAIT_L(0); PG8_BAR; PG8_MMA(0, 0, At, B0); PG8_MMA(0, 1, At, B1); PG8_BAR; PG8_SCHED;
            PG8_LDA(At, 1, 1); PG8_STAGE(PG8_SB(1, 0), b3, voffB); PG8_STAGE(PG8_SB(1, 1), b3 + hstepB, voffB); PG8_STAGE(PG8_SA(1, 0), a3, voffA);
            PG8_WAIT_V(8); PG8_WAIT_L(0); PG8_BAR; PG8_MMA(1, 0, At, B0); PG8_MMA(1, 1, At, B1); PG8_BAR; PG8_SCHED;
        }
        if constexpr (ALIGN_EPI) { if (wr == 0) PG8_BAR; }
        E(acc, cur, wr, wc, fr, fq); S.done(cur);
        if (!has_next) break;
#pragma unroll
        for (int a = 0; a < 2; ++a)
#pragma unroll
            for (int b = 0; b < 2; ++b)
#pragma unroll
                for (int m = 0; m < 4; ++m)
#pragma unroll
                    for (int n = 0; n < 2; ++n) acc[a][b][m][n] = (f32x4){0.f, 0.f, 0.f, 0.f};
        cur = nxt; cA = nA; cB = nB; ++ui;
        if constexpr (ALIGN_EPI) { if (wr == 1) PG8_BAR; }
    }
    PG8_WAIT_V(0);
    if constexpr (!ALIGN_EPI) { if (wr == 0) PG8_BAR; }
    PG8_BAR;
#undef PG8_SA
#undef PG8_SB
#undef PG8_STAGE
#undef PG8_LDA
#undef PG8_LDB
#undef PG8_MMA
#undef PG8_WAIT_V
#undef PG8_WAIT_L
#undef PG8_BAR
#undef PG8_SCHED
}
}

struct FaArgs {
    const bf16_t* Q; int q_pitch, q_col0, q_hstride;
    const bf16_t* K; const bf16_t* Vt; int Skv, kv_group, nheads;
    bf16_t* O; int o_pitch, o_col0;
    const float* qgain; const float* bias; const float* sinks; float qscale;
};
__device__ const unsigned char T5_BUCKET[128] = {
    0, 1, 2, 3, 4, 5, 6, 7, 8, 9, 10, 11, 12, 13, 14, 15, 16, 16, 16, 17, 17, 18, 18, 18, 19, 19, 19, 20, 20, 20, 20, 21, 21, 21, 21, 22, 22, 22, 22, 22, 23, 23, 23, 23, 23, 23,
    24, 24, 24, 24, 24, 24, 25, 25, 25, 25, 25, 25, 25, 26, 26, 26, 26, 26, 26, 26, 26, 27, 27, 27, 27, 27, 27, 27, 27, 27, 27, 28, 28, 28, 28, 28, 28, 28, 28, 28, 28,
    29, 29, 29, 29, 29, 29, 29, 29, 29, 29, 29, 29, 30, 30, 30, 30, 30, 30, 30, 30, 30, 30, 30, 30, 30, 30, 31, 31, 31, 31, 31, 31, 31, 31, 31, 31, 31, 31, 31, 31, 31};

template <int DQK, int DV, int MODE>
__device__ __forceinline__ void fa_unit(LAS unsigned char* lds, const FaArgs& A, const int b, const int h, const int qb) {
    constexpr int NKS = DQK / 16, NDB = DV / 32, KP = DQK + 8, VP = 68;
    constexpr int KBYTES = 64 * KP * 2, VBYTES = DV * VP * 2;
    constexpr int OFF_K = 0, OFF_V = 2 * KBYTES, OFF_B = OFF_V + 2 * VBYTES, OFF_TAB = OFF_B + 512;
    static_assert(OFF_TAB + 512 <= 131072, "FA LDS");
    constexpr int KCH = DQK / 8, KPT = 64 * KCH / 512, VPT = DV * 8 / 512;
    static_assert(KPT * 512 == 64 * KCH && VPT * 512 == DV * 8, "FA staging");
    const int tid = threadIdx.x, lane = tid & 63, w = __builtin_amdgcn_readfirstlane(tid >> 6), r = lane & 31, hh = lane >> 5;
    const int q0 = qb * 256, qw0 = q0 + w * 32, qpos = qw0 + r;
    const int bhk = (MODE == 1) ? b * (A.nheads / A.kv_group) + h / A.kv_group : b * A.nheads + h;

    bf16x8 Qf[NKS];
    {
        int opq = 0; asm volatile("" : "+v"(opq));
        const bf16_t* Qp = A.Q + (size_t)(b * SEQ + qpos) * A.q_pitch + A.q_col0 + h * A.q_hstride + 8 * hh;
        float qf[NKS][8];
#pragma unroll
        for (int ks = 0; ks < NKS; ++ks) { const u32x4 v = *(const u32x4*)(Qp + 16 * ks); unpack8(v, qf[ks]); }
        if constexpr (MODE == 0) {
            float sn = 0.f, sr = 0.f;
#pragma unroll
            for (int ks = 0; ks < 8; ++ks)
#pragma unroll
                for (int j = 0; j < 8; ++j) sn += qf[ks][j] * qf[ks][j];
#pragma unroll
            for (int ks = 8; ks < 12; ++ks)
#pragma unroll
                for (int j = 0; j < 8; ++j) sr += qf[ks][j] * qf[ks][j];
            sn += __shfl_xor(sn, 32); sr += __shfl_xor(sr, 32);
            const float rn = 1.0f / sqrtf(sn * (1.0f / 128.0f) + RMS_EPS), rr = 1.0f / sqrtf(sr * (1.0f / 64.0f) + RMS_EPS);
#pragma unroll
            for (int ks = 0; ks < 8; ++ks) {
                const f32x4 g0 = *(const f32x4*)(A.qgain + 16 * ks + 8 * hh), g1 = *(const f32x4*)(A.qgain + 16 * ks + 8 * hh + 4);
#pragma unroll
                for (int j = 0; j < 4; ++j) { qf[ks][j] *= rn * g0[j] * A.qscale; qf[ks][4 + j] *= rn * g1[j] * A.qscale; }
            }
#pragma unroll
            for (int ks = 8; ks < 10; ++ks) {
                const int i0 = 16 * (ks - 8) + 8 * hh;
                const f32x4 ga0 = *(const f32x4*)(A.qgain + 128 + i0), ga1 = *(const f32x4*)(A.qgain + 128 + i0 + 4);
                const f32x4 gb0 = *(const f32x4*)(A.qgain + 160 + i0), gb1 = *(const f32x4*)(A.qgain + 160 + i0 + 4);
#pragma unroll
                for (int j = 0; j < 8; ++j) {
                    const float ga = j < 4 ? ga0[j & 3] : ga1[j & 3], gb = j < 4 ? gb0[j & 3] : gb1[j & 3];
                    const float t1 = qf[ks][j] * rr * ga, t2 = qf[ks + 2][j] * rr * gb;
                    float c, s; rope_cs(qpos, i0 + j + opq, c, s);
                    qf[ks][j] = (t1 * c - t2 * s) * A.qscale; qf[ks + 2][j] = (t1 * s + t2 * c) * A.qscale;
                }
            }
        } else {
            float ss = 0.f;
#pragma unroll
            for (int ks = 0; ks < NKS; ++ks)
#pragma unroll
                for (int j = 0; j < 8; ++j) ss += qf[ks][j] * qf[ks][j];
            ss += __shfl_xor(ss, 32);
            const float rs = 1.0f / sqrtf(ss * (1.0f / DQK) + RMS_EPS) * A.qscale;
#pragma unroll
            for (int ks = 0; ks < NKS; ++ks) {
                const f32x4 g0 = *(const f32x4*)(A.qgain + 16 * ks + 8 * hh), g1 = *(const f32x4*)(A.qgain + 16 * ks + 8 * hh + 4);
#pragma unroll
                for (int j = 0; j < 4; ++j) { qf[ks][j] *= rs * g0[j]; qf[ks][4 + j] *= rs * g1[j]; }
            }
        }
#pragma unroll
        for (int ks = 0; ks < NKS; ++ks) Qf[ks] = __builtin_bit_cast(bf16x8, pack8(qf[ks]));
    }
    if constexpr (MODE == 1) { if (tid < 128) *(LAS float*)(lds + OFF_TAB + 4 * tid) = A.bias[(int)T5_BUCKET[tid] * 32 + h] * LOG2E; }

    int t_lo = 0, t_hi;
    if constexpr (MODE == 3) t_hi = A.Skv / 64; else t_hi = 4 * qb + 4;
    if constexpr (MODE == 1) { const int lowk = q0 - 127; t_lo = lowk > 0 ? lowk / 64 : 0; }
    const int nt = t_hi - t_lo;
    const bf16_t* Kg = A.K + (size_t)bhk * A.Skv * DQK;
    const bf16_t* Vg = A.Vt + (size_t)bhk * DV * A.Skv;
    const float* Bg = (MODE == 2) ? A.bias + (size_t)(b * A.nheads + h) * SEQ : nullptr;
    u32x4 kst[KPT], vst[VPT]; f32x4 bst = (f32x4){0.f, 0.f, 0.f, 0.f};
    unsigned koff[KPT], voff[VPT];
#pragma unroll
    for (int i = 0; i < KPT; ++i) { const int c = tid + 512 * i, row = c / KCH, cc = c % KCH; koff[i] = (unsigned)(row * DQK + cc * 8) * 2u; }
#pragma unroll
    for (int i = 0; i < VPT; ++i) { const int c = tid + 512 * i, d = c >> 3, cc = c & 7; voff[i] = (unsigned)(d * A.Skv + cc * 8) * 2u; }
#define FA_LOAD(t) do { const GAS char* _kt = uni_ptr((const char*)Kg + (size_t)(64 * (t)) * DQK * 2); const GAS char* _vt = uni_ptr((const char*)Vg + (size_t)(64 * (t)) * 2); \
        _Pragma("unroll") for (int _i = 0; _i < KPT; ++_i) kst[_i] = *(const GAS u32x4*)(_kt + koff[_i]); \
        _Pragma("unroll") for (int _i = 0; _i < VPT; ++_i) vst[_i] = *(const GAS u32x4*)(_vt + voff[_i]); \
        if (MODE == 2) { if (tid < 16) bst = *(const f32x4*)(Bg + 64 * (t) + 4 * tid); } } while (0)
#define FA_WRITE(buf) do { \
        _Pragma("unroll") for (int _i = 0; _i < KPT; ++_i) { const int _c = tid + 512 * _i, _row = _c / KCH, _cc = _c % KCH; *(LAS u32x4*)(lds + OFF_K + (buf) * KBYTES + (_row * KP + _cc * 8) * 2) = kst[_i]; } \
        _Pragma("unroll") for (int _i = 0; _i < VPT; ++_i) { const int _c = tid + 512 * _i, _d = _c >> 3, _cc = _c & 7; LAS unsigned char* _p = lds + OFF_V + (buf) * VBYTES + (_d * VP + _cc * 8) * 2; \
            *(LAS u32x2*)_p = (u32x2){vst[_i].x, vst[_i].y}; *(LAS u32x2*)(_p + 8) = (u32x2){vst[_i].z, vst[_i].w}; } \
        if (MODE == 2) { if (tid < 16) *(LAS f32x4*)(lds + OFF_B + (buf) * 256 + 16 * tid) = bst; } } while (0)

    f32x16 O[NDB];
#pragma unroll
    for (int db = 0; db < NDB; ++db)
#pragma unroll
        for (int i = 0; i < 16; ++i) O[db][i] = 0.f;
    float m_run = -1e30f, l_run = 0.f;
    FA_LOAD(t_lo);
    for (int it = 0; it < nt; ++it) {
        const int t = t_lo + it, buf = it & 1;
        FA_WRITE(buf);
        __syncthreads();
        if (it + 1 < nt) FA_LOAD(t + 1);
#pragma unroll
        for (int sub = 0; sub < 2; ++sub) {
            const int ks0 = 64 * t + 32 * sub;
            bool active = true;
            if constexpr (MODE == 0 || MODE == 2) active = (ks0 <= qw0 + 31);
            if constexpr (MODE == 1) active = (ks0 <= qw0 + 31) && (ks0 + 31 >= qw0 - 127);
            if (!active) continue;
            f32x16 s;
            if constexpr (MODE == 2) {
#pragma unroll
                for (int g = 0; g < 4; ++g) { const f32x4 bb = *(const LAS f32x4*)(lds + OFF_B + buf * 256 + (32 * sub + 8 * g + 4 * hh) * 4); s[4 * g] = bb[0]; s[4 * g + 1] = bb[1]; s[4 * g + 2] = bb[2]; s[4 * g + 3] = bb[3]; }
            } else if constexpr (MODE == 1) {
#pragma unroll
                for (int i = 0; i < 16; ++i) { int dist = qpos - (ks0 + (i & 3) + 8 * (i >> 2) + 4 * hh); dist = dist < 0 ? 0 : (dist > 127 ? 127 : dist); s[i] = *(const LAS float*)(lds + OFF_TAB + 4 * dist); }
            } else {
#pragma unroll
                for (int i = 0; i < 16; ++i) s[i] = 0.f;
            }
#pragma unroll
            for (int ks = 0; ks < NKS; ++ks) {
                const bf16x8 a = *(const LAS bf16x8*)(lds + OFF_K + buf * KBYTES + ((32 * sub + r) * KP + 16 * ks + 8 * hh) * 2);
                s = __builtin_amdgcn_mfma_f32_32x32x16_bf16(a, Qf[ks], s, 0, 0, 0);
            }
            if constexpr (MODE == 0 || MODE == 2) {
                if (ks0 + 31 > qw0) {
#pragma unroll
                    for (int i = 0; i < 16; ++i) { const int key = ks0 + (i & 3) + 8 * (i >> 2) + 4 * hh; if (key > qpos) s[i] = -__builtin_inff(); }
                }
            }
            if constexpr (MODE == 1) {
#pragma unroll
                for (int i = 0; i < 16; ++i) { const int key = ks0 + (i & 3) + 8 * (i >> 2) + 4 * hh; if ((unsigned)(qpos - key) >= 128u) s[i] = -__builtin_inff(); }
            }
            float mx = s[0];
#pragma unroll
            for (int i = 1; i < 16; ++i) mx = fmaxf(mx, s[i]);
            mx = fmaxf(mx, __shfl_xor(mx, 32));
            const float mnew = fmaxf(m_run, mx);
            const float alpha = __builtin_amdgcn_exp2f(m_run - mnew);
            m_run = mnew;
            float psum = 0.f;
#pragma unroll
            for (int i = 0; i < 16; ++i) { s[i] = __builtin_amdgcn_exp2f(s[i] - mnew); psum += s[i]; }
            l_run = l_run * alpha + psum;
#pragma unroll
            for (int db = 0; db < NDB; ++db)
#pragma unroll
                for (int i = 0; i < 16; ++i) O[db][i] *= alpha;
            bf16x8 P[2];
#pragma unroll
            for (int s2 = 0; s2 < 2; ++s2) { u32x4 pw; pw.x = pk2(s[8 * s2], s[8 * s2 + 1]); pw.y = pk2(s[8 * s2 + 2], s[8 * s2 + 3]); pw.z = pk2(s[8 * s2 + 4], s[8 * s2 + 5]); pw.w = pk2(s[8 * s2 + 6], s[8 * s2 + 7]); P[s2] = __builtin_bit_cast(bf16x8, pw); }
#pragma unroll
            for (int db = 0; db < NDB; ++db)
#pragma unroll
                for (int s2 = 0; s2 < 2; ++s2) {
                    const LAS unsigned char* vp = lds + OFF_V + buf * VBYTES + ((32 * db + r) * VP + 32 * sub + 16 * s2 + 4 * hh) * 2;
                    const u32x2 lo = *(const LAS u32x2*)vp, hi = *(const LAS u32x2*)(vp + 16);
                    const bf16x8 a = __builtin_bit_cast(bf16x8, (u32x4){lo.x, lo.y, hi.x, hi.y});
                    O[db] = __builtin_amdgcn_mfma_f32_32x32x16_bf16(a, P[s2], O[db], 0, 0, 0);
                }
        }
    }
#undef FA_LOAD
#undef FA_WRITE
    float l_tot = l_run + __shfl_xor(l_run, 32);
    if constexpr (MODE == 1) l_tot += __builtin_amdgcn_exp2f(A.sinks[h] * LOG2E - m_run);
    const float inv_l = 1.0f / l_tot;
    bf16_t* Op = A.O + (size_t)(b * SEQ + qpos) * A.o_pitch + A.o_col0 + h * DV;
#pragma unroll
    for (int db = 0; db < NDB; ++db)
#pragma unroll
        for (int g = 0; g < 4; ++g) {
            u32x2 wv; wv.x = pk2(O[db][4 * g] * inv_l, O[db][4 * g + 1] * inv_l); wv.y = pk2(O[db][4 * g + 2] * inv_l, O[db][4 * g + 3] * inv_l);
            *(u32x2*)(Op + 32 * db + 8 * g + 4 * hh) = wv;
        }
    __syncthreads();
}

template <int D>
__device__ __forceinline__ void headnorm_items(const bf16_t* src, int src_pitch, int src_col0, int src_hstride, int H, const float* gain,
                                               bf16_t* dst, int dst_D, int dst_d0, int S, int M, int gw, int NGW, int lane) {
    constexpr int LPI = D / 8, IPW = 64 / LPI;
    const int li = lane % LPI, sub = lane / LPI;
    const f32x4 g0 = *(const f32x4*)(gain + 8 * li), g1 = *(const f32x4*)(gain + 8 * li + 4);
    const int total = M * H;
    for (int it = gw * IPW + sub; it < total; it += NGW * IPW) {
        const int m = it / H, h = it % H;
        const u32x4 v = *(const u32x4*)(src + (size_t)m * src_pitch + src_col0 + h * src_hstride + 8 * li);
        float f[8]; unpack8(v, f);
        float ss = 0.f;
#pragma unroll
        for (int j = 0; j < 8; ++j) ss += f[j] * f[j];
#pragma unroll
        for (int o = 1; o < LPI; o <<= 1) ss += __shfl_xor(ss, o);
        const float rs = 1.0f / sqrtf(ss * (1.0f / D) + RMS_EPS);
#pragma unroll
        for (int j = 0; j < 4; ++j) { f[j] *= rs * g0[j]; f[4 + j] *= rs * g1[j]; }
        const int bb = m / S, s = m % S;
        *(u32x4*)(dst + ((size_t)(bb * H + h) * S + s) * dst_D + dst_d0 + 8 * li) = pack8(f);
    }
}
__device__ __forceinline__ void mla_krope_items(const bf16_t* src, int src_pitch, int col0, const float* gain, bf16_t* Kd, int gw, int NGW, int lane) {
    const int li = lane & 7, sub = lane >> 3;
    const f32x4 ga = *(const f32x4*)(gain + 4 * li), gb = *(const f32x4*)(gain + 32 + 4 * li);
    for (int m = gw * 8 + sub; m < MTOK; m += NGW * 8) {
        const u32x2 va = *(const u32x2*)(src + (size_t)m * src_pitch + col0 + 4 * li), vb = *(const u32x2*)(src + (size_t)m * src_pitch + col0 + 32 + 4 * li);
        float a[4] = {bf_lo(va.x), bf_hi(va.x), bf_lo(va.y), bf_hi(va.y)}, bq[4] = {bf_lo(vb.x), bf_hi(vb.x), bf_lo(vb.y), bf_hi(vb.y)};
        float ss = 0.f;
#pragma unroll
        for (int j = 0; j < 4; ++j) ss += a[j] * a[j] + bq[j] * bq[j];
        ss += __shfl_xor(ss, 1); ss += __shfl_xor(ss, 2); ss += __shfl_xor(ss, 4);
        const float rs = 1.0f / sqrtf(ss * (1.0f / 64.0f) + RMS_EPS);
        const int bb = m / SEQ, s = m % SEQ;
        float o1[4], o2[4];
#pragma unroll
        for (int j = 0; j < 4; ++j) { const float t1 = a[j] * rs * ga[j], t2 = bq[j] * rs * gb[j]; float c, sn; rope_cs(s, 4 * li + j, c, sn); o1[j] = t1 * c - t2 * sn; o2[j] = t1 * sn + t2 * c; }
        const u32x2 w1 = (u32x2){pk2(o1[0], o1[1]), pk2(o1[2], o1[3])}, w2 = (u32x2){pk2(o2[0], o2[1]), pk2(o2[2], o2[3])};
#pragma unroll
        for (int h = 0; h < 16; ++h) { bf16_t* kp = Kd + ((size_t)(bb * 16 + h) * SEQ + s) * 192 + 128; *(u32x2*)(kp + 4 * li) = w1; *(u32x2*)(kp + 32 + 4 * li) = w2; }
    }
}
__device__ __forceinline__ void vtrans_items(const bf16_t* src, int pitch, int col0, int hstride, int H, int DV, bf16_t* dst, int S, int B, LAS unsigned char* scr, int gw, int NGW, int lane) {
    const int ndb = DV / 32, ntb = S / 64, total = B * H * ntb * ndb;
    for (int it = gw; it < total; it += NGW) {
        const int dbk = it % ndb, tb = (it / ndb) % ntb, bh = it / (ndb * ntb), bb = bh / H, h = bh % H;
        u32x4 v[4];
#pragma unroll
        for (int i = 0; i < 4; ++i) { const int c = lane + 64 * i, tok = c >> 2, dc = c & 3; v[i] = *(const u32x4*)(src + (size_t)(bb * S + 64 * tb + tok) * pitch + col0 + h * hstride + 32 * dbk + 8 * dc); }
#pragma unroll
        for (int i = 0; i < 4; ++i) { const int c = lane + 64 * i, tok = c >> 2, dc = c & 3; const unsigned wv[4] = {v[i].x, v[i].y, v[i].z, v[i].w};
#pragma unroll
            for (int e = 0; e < 8; ++e) *(LAS unsigned short*)(scr + ((8 * dc + e) * 66 + tok) * 2) = (unsigned short)((e & 1) ? (wv[e >> 1] >> 16) : (wv[e >> 1] & 0xffffu)); }
        asm volatile("s_waitcnt lgkmcnt(0)" ::: "memory");
        const int d = lane & 31, half = lane >> 5;
        unsigned o[16];
#pragma unroll
        for (int i = 0; i < 16; ++i) o[i] = *(const LAS unsigned*)(scr + (d * 66 + 32 * half + 2 * i) * 2);
        bf16_t* dp = dst + ((size_t)(bh * DV + 32 * dbk + d)) * S + 64 * tb + 32 * half;
#pragma unroll
        for (int i = 0; i < 4; ++i) *(u32x4*)(dp + 8 * i) = (u32x4){o[4 * i], o[4 * i + 1], o[4 * i + 2], o[4 * i + 3]};
        asm volatile("s_waitcnt lgkmcnt(0)" ::: "memory");
    }
}
__device__ __forceinline__ void conv_items(const bf16_t* u, const float* cw, bf16_t* cat, int gt, int NT) {
    const int total = MTOK * (D_MODEL / 8);
    for (int it = gt; it < total; it += NT) {
        const int m = it / (D_MODEL / 8), c8 = (it % (D_MODEL / 8)) * 8, s = m % SEQ;
        float z[3][8];
#pragma unroll
        for (int tap = 0; tap < 3; ++tap) {
            const int back = 2 - tap;
            if (s - back >= 0) { const bf16_t* p = u + (size_t)(m - back) * NIN0 + c8; float gc[8], xt[8]; unpack8(*(const u32x4*)(p + D_MODEL), gc); unpack8(*(const u32x4*)(p + 2 * D_MODEL), xt);
#pragma unroll
                for (int j = 0; j < 8; ++j) z[tap][j] = gc[j] * xt[j]; }
            else {
#pragma unroll
                for (int j = 0; j < 8; ++j) z[tap][j] = 0.f; }
        }
        float gb[8], o[8]; unpack8(*(const u32x4*)(u + (size_t)m * NIN0 + c8), gb);
#pragma unroll
        for (int j = 0; j < 8; ++j) o[j] = gb[j] * (z[0][j] * cw[c8 + j] + z[1][j] * cw[D_MODEL + c8 + j] + z[2][j] * cw[2 * D_MODEL + c8 + j]);
        *(u32x4*)(cat + (size_t)m * K_OUT + c8) = pack8(o);
    }
}
__device__ __forceinline__ void fox_scan_items(const bf16_t* u, int pitch, int fcol0, const float* bfv, float* CB, int gw, int NGW, int lane) {
    for (int it = gw; it < BATCH * 32; it += NGW) {
        const int bb = it / 32, h = it % 32; const float bias = bfv[h];
        float v[32]; float run = 0.f;
#pragma unroll
        for (int i = 0; i < 32; ++i) { const int s = lane * 32 + i; const float x = __uint_as_float(((unsigned)u[(size_t)(bb * SEQ + s) * pitch + fcol0 + h]) << 16) + bias;
            const float ls = fminf(x, 0.f) - log1pf(expf(-fabsf(x))); run += ls; v[i] = run; }
        float tot = run;
#pragma unroll
        for (int o = 1; o < 64; o <<= 1) { const float t = __shfl_up(tot, o); if (lane >= o) tot += t; }
        const float base = tot - run;
        float* cp = CB + (size_t)it * SEQ + lane * 32;
#pragma unroll
        for (int i = 0; i < 8; ++i) *(f32x4*)(cp + 4 * i) = (f32x4){-(base + v[4 * i]) * LOG2E, -(base + v[4 * i + 1]) * LOG2E, -(base + v[4 * i + 2]) * LOG2E, -(base + v[4 * i + 3]) * LOG2E};
    }
}
__device__ __forceinline__ void rowinit_items(const float* src, bf16_t* dst, float* ps, int rows, int gw, int NGW, int lane) {
    for (int m = gw; m < rows; m += NGW) {
        const f32x4* xr = (const f32x4*)(src + (size_t)m * D_MODEL); float ss = 0.f;
#pragma unroll
        for (int j = 0; j < 8; ++j) { const f32x4 v = xr[64 * j + lane]; ss += (v[0] * v[0] + v[1] * v[1]) + (v[2] * v[2] + v[3] * v[3]);
            *(u32x2*)(dst + (size_t)m * D_MODEL + 4 * (64 * j + lane)) = (u32x2){pk2(v[0], v[1]), pk2(v[2], v[3])}; }
#pragma unroll
        for (int o = 1; o < 64; o <<= 1) ss += __shfl_xor(ss, o);
        if (lane < 32) ps[(size_t)m * 32 + lane] = (lane == 0) ? ss : 0.f;
    }
}

struct Seg { int in_idx; int src_off; int K; int Nsrc; int col0; int ncols; int dst_mib; int dst_boff; int drow0; int gain_idx; int gain_off; int inter; };
#define SEG_FFN(L) \
    {I_F1G, (L) * D_MODEL * D_FF, D_MODEL, D_FF, 0, D_FF, 488 + 44 * (2 * (L)), 0, 0, I_NORM_FFN1, (L) * D_MODEL, 1}, \
    {I_F1U, (L) * D_MODEL * D_FF, D_MODEL, D_FF, 0, D_FF, 488 + 44 * (2 * (L)), 0, 128, I_NORM_FFN1, (L) * D_MODEL, 1}, \
    {I_F1D, (L) * D_MODEL * D_FF, D_FF, D_MODEL, 0, D_MODEL, 840 + 22 * (2 * (L)), 0, 0, -1, 0, 0}, \
    {I_F2G, (L) * D_MODEL * D_FF, D_MODEL, D_FF, 0, D_FF, 488 + 44 * (2 * (L) + 1), 0, 0, I_NORM_FFN2, (L) * D_MODEL, 1}, \
    {I_F2U, (L) * D_MODEL * D_FF, D_MODEL, D_FF, 0, D_FF, 488 + 44 * (2 * (L) + 1), 0, 128, I_NORM_FFN2, (L) * D_MODEL, 1}, \
    {I_F2D, (L) * D_MODEL * D_FF, D_FF, D_MODEL, 0, D_MODEL, 840 + 22 * (2 * (L) + 1), 0, 0, -1, 0, 0}, \
    {I_MEM_WKV, (L) * D_MODEL * 1024, D_MODEL, 1024, 0, 1024, 1135, 0, (L) * 1024, I_NORM_MEM, (L) * D_MODEL, 0}
__device__ const Seg SEGS[] = {
    SEG_FFN(0), SEG_FFN(1), SEG_FFN(2), SEG_FFN(3),
    {I_CONV_WIN, 0, D_MODEL, 6656, 0, 6656, 1016, 0, 0, I_NORM_MIX, 0 * D_MODEL, 0},
    {I_CONV_WOUT, 0, K_OUT, D_MODEL, 0, D_MODEL, 1088, 0, 0, -1, 0, 0},
    {I_MLA_WIN, 0, D_MODEL, 1600, 0, 1024, 1042, 0, 0, I_NORM_MIX, 1 * D_MODEL, 0},
    {I_MLA_WIN, 0, D_MODEL, 1600, 1088, 512, 1042, 0, 1024, I_NORM_MIX, 1 * D_MODEL, 0},
    {I_MLA_WIN, 0, D_MODEL, 1600, 1024, 64, 1042, 0, 1536, I_NORM_MIX, 1 * D_MODEL, 0},
    {I_MLA_WQB, 0, 512, 3072, 0, 3072, 1128, 0, 0, I_MLA_QAN, 0, 0},
    {I_MLA_WKVB, 0, 512, 4096, 0, 4096, 1131, 0, 0, I_MLA_KVAN, 0, 0},
    {I_MLA_WOUT, 0, K_OUT, D_MODEL, 0, D_MODEL, 1098, 0, 0, -1, 0, 0},
    {I_SWA_WIN, 0, D_MODEL, 3072, 0, 3072, 1049, 0, 0, I_NORM_MIX, 2 * D_MODEL, 0},
    {I_SWA_WOUT, 0, K_OUT, D_MODEL, 0, D_MODEL, 1108, 0, 0, -1, 0, 0},
    {I_FOX_WIN, 0, D_MODEL, 6688, 0, 6144, 1061, 0, 0, I_NORM_MIX, 3 * D_MODEL, 0},
    {I_FOX_WIN, 0, D_MODEL, 6688, 6176, 512, 1061, 0, 6144, I_NORM_MIX, 3 * D_MODEL, 0},
    {I_FOX_WIN, 0, D_MODEL, 6688, 6144, 32, 1061, 0, 6656, I_NORM_MIX, 3 * D_MODEL, 0},
    {I_FOX_WOUT, 0, K_OUT, D_MODEL, 0, D_MODEL, 1118, 0, 0, -1, 0, 0},
};
constexpr int NSEG = sizeof(SEGS) / sizeof(Seg);

__device__ __forceinline__ void p0_item(const float* W, int K, int Nsrc, int n0src, bf16_t* WT, int drow, const float* gain, LAS float* scr, int k0, int lane) {
    float v[32];
#pragma unroll
    for (int i = 0; i < 32; ++i) { const int kk = 2 * i + (lane >> 5); v[i] = W[(size_t)(k0 + kk) * Nsrc + n0src + (lane & 31)]; }
#pragma unroll
    for (int i = 0; i < 32; ++i) { const int kk = 2 * i + (lane >> 5); scr[kk * 33 + (lane & 31)] = v[i]; }
    asm volatile("s_waitcnt lgkmcnt(0)" ::: "memory");
    const int c = lane & 7;
    f32x4 g0 = (f32x4){1.f, 1.f, 1.f, 1.f}, g1 = g0;
    if (gain) { g0 = *(const f32x4*)(gain + k0 + 8 * c); g1 = *(const f32x4*)(gain + k0 + 8 * c + 4); }
#pragma unroll
    for (int j = 0; j < 4; ++j) { const int n = (lane >> 3) + 8 * j; const LAS float* s = scr + (8 * c) * 33 + n;
        u32x4 o; o.x = pk2(s[0 * 33] * g0[0], s[1 * 33] * g0[1]); o.y = pk2(s[2 * 33] * g0[2], s[3 * 33] * g0[3]); o.z = pk2(s[4 * 33] * g1[0], s[5 * 33] * g1[1]); o.w = pk2(s[6 * 33] * g1[2], s[7 * 33] * g1[3]);
        *(u32x4*)(WT + (size_t)(drow + n) * K + k0 + 8 * c) = o; }
    asm volatile("s_waitcnt lgkmcnt(0)" ::: "memory");
}

#define XB_TMO      128
#define XB_XCNT(j)  (256  + 64 * (j))
#define XB_XSUB(j)  (1280 + 64 * (j))
#define XB_XGEN(j)  (2304 + 64 * (j))
#define XB_TOP      3328
#define XB_TOPGEN   3392
#define XCD_BAR_WORDS 3456
#define XB_SPIN_CAP (1u << 18)
__device__ __forceinline__ unsigned xb_ld(unsigned* p)              { return __hip_atomic_load(p, __ATOMIC_RELAXED, __HIP_MEMORY_SCOPE_AGENT); }
__device__ __forceinline__ unsigned xb_add(unsigned* p, unsigned v) { return __hip_atomic_fetch_add(p, v, __ATOMIC_RELAXED, __HIP_MEMORY_SCOPE_AGENT); }
__device__ __forceinline__ unsigned xb_xcc_id() { return (unsigned)__builtin_amdgcn_s_getreg((3 << 11) | 20) & 0xFu; }
#define XB_SPIN(cond, bar) do { unsigned _sp = 0; while (cond) { __builtin_amdgcn_s_sleep(1); \
    if ((++_sp & 255u) == 0u) { if (xb_ld(&(bar)[XB_TMO])) break; if (_sp > XB_SPIN_CAP) { atomicAdd(&(bar)[XB_TMO], 1u); break; } } } } while (0)
struct XcdBarrier { unsigned* bar; unsigned x; volatile LAS unsigned* st; };
__device__ __forceinline__ XcdBarrier xcd_barrier_post(unsigned* bar, volatile LAS unsigned* st) {
    XcdBarrier b; b.bar = bar; b.x = xb_xcc_id(); b.st = st;
    if (threadIdx.x == 0) (void)xb_add(&bar[XB_XCNT(b.x)], 1u);
    return b;
}
__device__ __forceinline__ void xcd_barrier_complete(unsigned* bar, unsigned x, unsigned& nloc, unsigned& nx) {
    const unsigned G = gridDim.x * gridDim.y * gridDim.z;
    unsigned sum, cnt, mine, sp = 0u;
    for (;;) {
        sum = 0u; cnt = 0u; mine = 0u;
#pragma unroll
        for (unsigned j = 0; j < 16; ++j) { const unsigned c = xb_ld(&bar[XB_XCNT(j)]); sum += c; cnt += (c > 0u) ? 1u : 0u; mine = (j == x) ? c : mine; }
        if (sum == G) break;
        __builtin_amdgcn_s_sleep(1);
        if ((++sp & 255u) == 0u) { if (xb_ld(&bar[XB_TMO])) break; if (sp > XB_SPIN_CAP) { atomicAdd(&bar[XB_TMO], 1u); break; } }
    }
    nloc = mine > 0u ? mine : 1u; nx = cnt > 0u ? cnt : 1u;
}
__device__ __forceinline__ void xcd_barrier(const XcdBarrier& b) {
    asm volatile("s_waitcnt vmcnt(0)" ::: "memory");
    __syncthreads();
    if (threadIdx.x == 0) {
        unsigned* bar = b.bar;
        __builtin_amdgcn_s_waitcnt(0);
        unsigned nloc = b.st[0], nx = b.st[1];
        if (nloc == 0u) { xcd_barrier_complete(bar, b.x, nloc, nx); b.st[0] = nloc; b.st[1] = nx; }
        const unsigned old = xb_add(&bar[XB_XSUB(b.x)], 1u);
        const unsigned gen = old / nloc;
        if (old + 1u == (gen + 1u) * nloc) {
            __builtin_amdgcn_fence(__ATOMIC_RELEASE, "agent");
            asm volatile("s_waitcnt vmcnt(0)" ::: "memory");
            const unsigned og = xb_add(&bar[XB_TOP], 1u);
            const unsigned tg = og / nx;
            if (og + 1u == (tg + 1u) * nx) xb_add(&bar[XB_TOPGEN], 1u);
            else XB_SPIN(xb_ld(&bar[XB_TOPGEN]) == tg, bar);
            __builtin_amdgcn_fence(__ATOMIC_ACQUIRE, "agent");
            xb_add(&bar[XB_XGEN(b.x)], 1u);
            asm volatile("s_waitcnt vmcnt(0)" ::: "memory");
        } else {
            XB_SPIN(xb_ld(&bar[XB_XGEN(b.x)]) == gen, bar);
            __builtin_amdgcn_fence(__ATOMIC_ACQUIRE, "agent");
            asm volatile("s_waitcnt vmcnt(0)" ::: "memory");
        }
    }
    __syncthreads();
}

constexpr int RING_BYTES = 131072, LDSCTL_OFF = RING_BYTES, LDS_BYTES = 147456;
constexpr int CW_BAR = 4096;
constexpr int NPHASES = 35;

struct Args { const float* in[N_INPUTS]; float* out; unsigned char* ws; int ph_lo, ph_hi; };
static_assert(sizeof(Args) == N_INPUTS * 8 + 8 + 8 + 8, "Args has no padding");

__global__ void __launch_bounds__(512, 2) trunk_fwd(Args args) {
    extern __shared__ __attribute__((aligned(16))) unsigned char lds_raw[];
    LAS unsigned char* lds = (LAS unsigned char*)lds_raw;
    const int tid = threadIdx.x, wave = __builtin_amdgcn_readfirstlane(tid >> 6);
    const int G = gridDim.x, bx = blockIdx.x;
    const int vcu = (G % 8 == 0) ? (bx % 8) * (G / 8) + bx / 8 : bx;
    const int gw = vcu * 8 + wave, NGW = G * 8, NT = NGW * 64;
#define LANE_ ({ int t_ = threadIdx.x; asm volatile("" : "+v"(t_)); t_ & 63; })
#define GT_ (gw * 64 + LANE_)
    unsigned char* ws = args.ws;
    const int lo = args.ph_lo, hi = args.ph_hi;
    for (int u = tid; u < (LDS_BYTES - LDSCTL_OFF) / 4; u += 512) ((LAS unsigned*)(lds + LDSCTL_OFF))[u] = 0u;
    __syncthreads();
    XcdBarrier bar; bar.bar = (unsigned*)(ws + WS_CTL) + CW_BAR; bar.x = 0; bar.st = nullptr;
    if (hi - lo > 1) bar = xcd_barrier_post((unsigned*)(ws + WS_CTL) + CW_BAR, (volatile LAS unsigned*)(lds + LDSCTL_OFF + 64));

    float* PSUM = (float*)(ws + WS_PSUM); float* UPS = (float*)(ws + WS_UPS); float* PSMEM = (float*)(ws + WS_PSMEM); float* CB = (float*)(ws + WS_CB);
    bf16_t* XB = (bf16_t*)(ws + WS_XB); bf16_t* MEMB = (bf16_t*)(ws + WS_MEMB); bf16_t* MKV = (bf16_t*)(ws + WS_MKV); bf16_t* MK = (bf16_t*)(ws + WS_MK); bf16_t* MVT = (bf16_t*)(ws + WS_MVT);
    bf16_t* CAT = (bf16_t*)(ws + WS_CAT); bf16_t* HID = (bf16_t*)(ws + WS_HID); bf16_t* U = (bf16_t*)(ws + WS_U); bf16_t* QM = (bf16_t*)(ws + WS_QM); bf16_t* KVM = (bf16_t*)(ws + WS_KVM);
    bf16_t* KBUF = (bf16_t*)(ws + WS_KBUF); bf16_t* VTBUF = (bf16_t*)(ws + WS_VTBUF);
    float* OUT = args.out;

    int ph = 0;
#define PH_ON (lo <= ph && ph < hi)
#define PH_END do { if (lo <= ph && ph + 1 < hi) xcd_barrier(bar); ++ph; } while (0)
#define GEMM_PHASE(EPI_T, E_INIT, Aptr, Bptr, M_, N_, K_, LDA_) do { pg8::Gemm g_{(Aptr), (Bptr), (M_), (N_), (K_), (LDA_)}; pg8::StaticOrder S_; S_.init((M_), (N_), G, bx); \
        EPI_T E_ E_INIT; pg8::gemm_phase<EPI_T, pg8::StaticOrder, true>(lds, g_, S_, E_); } while (0)
#define COMMA ,

    if (PH_ON) {
        LAS float* scr = (LAS float*)(lds + wave * 8448);
        int it = gw, base = 0; const int lane_p0 = LANE_;
        for (int sg = 0; sg < NSEG; ++sg) {
            const Seg s = SEGS[sg];
            const int nbc = s.ncols / 32, n_it = (s.K / 64) * nbc;
            const float* W = args.in[s.in_idx] + s.src_off;
            bf16_t* WT = (bf16_t*)(ws + (size_t)s.dst_mib * MiB);
            const float* gain = s.gain_idx >= 0 ? args.in[s.gain_idx] + s.gain_off : nullptr;
            for (; it < base + n_it; it += NGW) {
                const int rr = it - base, kb = rr / nbc, nb = rr % nbc, n = 32 * nb;
                const int drow = s.drow0 + (s.inter ? (((n >> 7) << 8) + (n & 127)) : n);
                p0_item(W, s.K, s.Nsrc, s.col0 + n, WT, drow, gain, scr, 64 * kb, lane_p0);
            }
            base += n_it;
        }
        rowinit_items(args.in[I_X], XB, PSUM, MTOK, gw, NGW, LANE_);
        rowinit_items(args.in[I_MEM], MEMB, PSMEM, MMEM, gw, NGW, LANE_);
        { u32x4* z1 = (u32x4*)(ws + WS_WIN1 + (size_t)1600 * D_MODEL * 2); const int n1 = 192 * D_MODEL * 2 / 16; for (int i = GT_; i < n1; i += NT) z1[i] = (u32x4){0u, 0u, 0u, 0u};
          u32x4* z3 = (u32x4*)(ws + WS_WIN3 + (size_t)6688 * D_MODEL * 2); const int n3 = 224 * D_MODEL * 2 / 16; for (int i = GT_; i < n3; i += NT) z3[i] = (u32x4){0u, 0u, 0u, 0u}; }
    }
    PH_END;
    if (PH_ON) GEMM_PHASE(pg8::EpiScale<32 COMMA false>, {MKV COMMA 4096 COMMA PSMEM COMMA 32 COMMA 0 COMMA 1.0f / D_MODEL COMMA nullptr}, MEMB, (const bf16_t*)(ws + WS_WMKV), MMEM, 4096, D_MODEL, D_MODEL);
    PH_END;
    if (PH_ON) {
        for (int L = 0; L < 4; ++L) {
            headnorm_items<128>(MKV, 4096, L * 1024, 128, 4, args.in[I_MEM_KN] + L * 128, MK + (size_t)L * 16 * 256 * 128, 128, 0, MEM_LEN, MMEM, gw, NGW, LANE_);
            vtrans_items(MKV, 4096, L * 1024 + 512, 128, 4, 128, MVT + (size_t)L * 16 * 128 * 256, MEM_LEN, BATCH, lds + wave * 4352, gw, NGW, LANE_);
        }
    }
    PH_END;

#define FFN_PHASES(L, WHICH, BASEP) \
    if (PH_ON) GEMM_PHASE(pg8::EpiSwiGLU, {HID COMMA PSUM}, XB, (const bf16_t*)(ws + WS_WGU + (size_t)(2 * (L) + (WHICH)) * WGU_BYTES), MTOK, N_GU, D_MODEL, D_MODEL); \
    PH_END; \
    if (PH_ON) GEMM_PHASE(pg8::EpiResid, {(BASEP) COMMA OUT COMMA XB COMMA PSUM COMMA 0.5f}, HID, (const bf16_t*)(ws + WS_WD + (size_t)(2 * (L) + (WHICH)) * WD_BYTES), MTOK, D_MODEL, D_FF, D_FF); \
    PH_END;
#define OUT_PHASE(L) \
    if (PH_ON) GEMM_PHASE(pg8::EpiResid, {OUT COMMA OUT COMMA XB COMMA PSUM COMMA 1.0f}, CAT, (const bf16_t*)(ws + WS_WOUT + (size_t)(L) * WOUT_BYTES), MTOK, D_MODEL, K_OUT, K_OUT); \
    PH_END;
#define MEM_FA(L, UPITCH, MQCOL) do { FaArgs fa_; fa_.Q = U; fa_.q_pitch = (UPITCH); fa_.q_col0 = (MQCOL); fa_.q_hstride = 128; fa_.K = MK + (size_t)(L) * 16 * 256 * 128; fa_.Vt = MVT + (size_t)(L) * 16 * 128 * 256; \
        fa_.Skv = MEM_LEN; fa_.kv_group = 1; fa_.nheads = 4; fa_.O = CAT; fa_.o_pitch = K_OUT; fa_.o_col0 = 2048; fa_.qgain = args.in[I_MEM_QN] + (L) * 128; fa_.bias = nullptr; fa_.sinks = nullptr; \
        fa_.qscale = 0.08838834764831845f * LOG2E; \
        for (int i_ = bx; i_ < 16 * 8; i_ += G) fa_unit<128, 128, 3>(lds, fa_, (i_ >> 3) >> 2, (i_ >> 3) & 3, i_ & 7); } while (0)

    FFN_PHASES(0, 0, args.in[I_X])
    if (PH_ON) GEMM_PHASE(pg8::EpiScale<32 COMMA false>, {U COMMA NIN0 COMMA PSUM COMMA 32 COMMA 0 COMMA 1.0f / D_MODEL COMMA nullptr}, XB, (const bf16_t*)(ws + WS_WIN0), MTOK, NIN0, D_MODEL, D_MODEL);
    PH_END;
    if (PH_ON) { conv_items(U, args.in[I_CONV_W], CAT, GT_, NT); MEM_FA(0, NIN0, 6144); }
    PH_END;
    OUT_PHASE(0)
    FFN_PHASES(0, 1, OUT)

    FFN_PHASES(1, 0, OUT)
    if (PH_ON) GEMM_PHASE(pg8::EpiScale<32 COMMA true>, {U COMMA NIN1 COMMA PSUM COMMA 32 COMMA 0 COMMA 1.0f / D_MODEL COMMA UPS}, XB, (const bf16_t*)(ws + WS_WIN1), MTOK, NIN1, D_MODEL, D_MODEL);
    PH_END;
    if (PH_ON) {
        GEMM_PHASE(pg8::EpiScale<8 COMMA false>, {QM COMMA 3072 COMMA UPS COMMA 32 COMMA 0 COMMA 1.0f / 512.0f COMMA nullptr}, U, (const bf16_t*)(ws + WS_WQB), MTOK, 3072, 512, NIN1);
        GEMM_PHASE(pg8::EpiScale<8 COMMA false>, {KVM COMMA 4096 COMMA UPS COMMA 32 COMMA 8 COMMA 1.0f / 512.0f COMMA nullptr}, U + 512, (const bf16_t*)(ws + WS_WKVB), MTOK, 4096, 512, NIN1);
    }
    PH_END;
    if (PH_ON) {
        headnorm_items<128>(KVM, 4096, 0, 256, 16, args.in[I_MLA_KN], KBUF, 192, 0, SEQ, MTOK, gw, NGW, LANE_);
        mla_krope_items(U, NIN1, 1536, args.in[I_MLA_KN] + 128, KBUF, gw, NGW, LANE_);
        vtrans_items(KVM, 4096, 128, 256, 16, 128, VTBUF, SEQ, BATCH, lds + wave * 4352, gw, NGW, LANE_);
    }
    PH_END;
    if (PH_ON) {
        FaArgs fa; fa.Q = QM; fa.q_pitch = 3072; fa.q_col0 = 0; fa.q_hstride = 192; fa.K = KBUF; fa.Vt = VTBUF; fa.Skv = SEQ; fa.kv_group = 1; fa.nheads = 16;
        fa.O = CAT; fa.o_pitch = K_OUT; fa.o_col0 = 0; fa.qgain = args.in[I_MLA_QN]; fa.bias = nullptr; fa.sinks = nullptr; fa.qscale = 0.07216878364870323f * LOG2E;
        for (int j = bx; j < 64 * 4; j += G) { const int bh = j >> 2, q4 = j & 3; for (int k = 0; k < 2; ++k) fa_unit<192, 128, 0>(lds, fa, bh >> 4, bh & 15, k ? q4 : 7 - q4); }
        MEM_FA(1, NIN1, 1024);
    }
    PH_END;
    OUT_PHASE(1)
    FFN_PHASES(1, 1, OUT)

    FFN_PHASES(2, 0, OUT)
    if (PH_ON) GEMM_PHASE(pg8::EpiScale<32 COMMA false>, {U COMMA NIN2 COMMA PSUM COMMA 32 COMMA 0 COMMA 1.0f / D_MODEL COMMA nullptr}, XB, (const bf16_t*)(ws + WS_WIN2), MTOK, NIN2, D_MODEL, D_MODEL);
    PH_END;
    if (PH_ON) {
        headnorm_items<64>(U, NIN2, 2048, 64, 4, args.in[I_SWA_KN], KBUF, 64, 0, SEQ, MTOK, gw, NGW, LANE_);
        vtrans_items(U, NIN2, 2304, 64, 4, 64, VTBUF, SEQ, BATCH, lds + wave * 4352, gw, NGW, LANE_);
    }
    PH_END;
    if (PH_ON) {
        FaArgs fa; fa.Q = U; fa.q_pitch = NIN2; fa.q_col0 = 0; fa.q_hstride = 64; fa.K = KBUF; fa.Vt = VTBUF; fa.Skv = SEQ; fa.kv_group = 8; fa.nheads = 32;
        fa.O = CAT; fa.o_pitch = K_OUT; fa.o_col0 = 0; fa.qgain = args.in[I_SWA_QN]; fa.bias = args.in[I_REL_BIAS]; fa.sinks = args.in[I_SWA_SINKS]; fa.qscale = 0.125f * LOG2E;
        for (int i = bx; i < 128 * 8; i += G) { const int bh = i >> 3; fa_unit<64, 64, 1>(lds, fa, bh >> 5, bh & 31, i & 7); }
        MEM_FA(2, NIN2, 2560);
    }
    PH_END;
    OUT_PHASE(2)
    FFN_PHASES(2, 1, OUT)

    FFN_PHASES(3, 0, OUT)
    if (PH_ON) GEMM_PHASE(pg8::EpiScale<32 COMMA false>, {U COMMA NIN3 COMMA PSUM COMMA 32 COMMA 0 COMMA 1.0f / D_MODEL COMMA nullptr}, XB, (const bf16_t*)(ws + WS_WIN3), MTOK, NIN3, D_MODEL, D_MODEL);
    PH_END;
    if (PH_ON) {
        headnorm_items<64>(U, NIN3, 2048, 64, 32, args.in[I_FOX_KN], KBUF, 64, 0, SEQ, MTOK, gw, NGW, LANE_);
        vtrans_items(U, NIN3, 4096, 64, 32, 64, VTBUF, SEQ, BATCH, lds + wave * 4352, gw, NGW, LANE_);
        fox_scan_items(U, NIN3, 6656, args.in[I_FOX_BF], CB, gw, NGW, LANE_);
    }
    PH_END;
    if (PH_ON) {
        FaArgs fa; fa.Q = U; fa.q_pitch = NIN3; fa.q_col0 = 0; fa.q_hstride = 64; fa.K = KBUF; fa.Vt = VTBUF; fa.Skv = SEQ; fa.kv_group = 1; fa.nheads = 32;
        fa.O = CAT; fa.o_pitch = K_OUT; fa.o_col0 = 0; fa.qgain = args.in[I_FOX_QN]; fa.bias = CB; fa.sinks = nullptr; fa.qscale = 0.125f * LOG2E;
        for (int j = bx; j < 128 * 4; j += G) { const int bh = j >> 2, q4 = j & 3; for (int k = 0; k < 2; ++k) fa_unit<64, 64, 2>(lds, fa, bh >> 5, bh & 31, k ? q4 : 7 - q4); }
        MEM_FA(3, NIN3, 6144);
    }
    PH_END;
    OUT_PHASE(3)
    FFN_PHASES(3, 1, OUT)
}

extern "C" void kernel_launch(void* const* d_in, const int* in_sizes, int n_in, void* d_out, int out_size, void* d_ws, size_t ws_size, hipStream_t stream) {
    static int grid = 0;
    if (grid == 0) {
        if (n_in != N_INPUTS || out_size != MTOK * D_MODEL || ws_size < WS_END) { fprintf(stderr, "kernel_launch: unexpected problem: n_in %d out %d ws %zu (need %zu)\n", n_in, out_size, ws_size, (size_t)WS_END); grid = -1; return; }
        int dev = 0, cus = 0, per_cu = 0;
        if (hipGetDevice(&dev) != hipSuccess || hipDeviceGetAttribute(&cus, hipDeviceAttributeMultiprocessorCount, dev) != hipSuccess) { grid = -1; return; }
        if (hipFuncSetAttribute((const void*)trunk_fwd, hipFuncAttributeMaxDynamicSharedMemorySize, LDS_BYTES) != hipSuccess) { fprintf(stderr, "kernel_launch: hipFuncSetAttribute failed\n"); grid = -1; return; }
        if (hipOccupancyMaxActiveBlocksPerMultiprocessor(&per_cu, (const void*)trunk_fwd, 512, LDS_BYTES) != hipSuccess || per_cu < 1)
            fprintf(stderr, "kernel_launch: note: occupancy query reports %d workgroups per CU\n", per_cu);
        (void)hipGetLastError();
        grid = cus;
    }
    if (grid < 0) return;
    if (hipMemsetAsync((char*)d_ws + WS_CTL, 0, CTL_ZERO_BYTES, stream) != hipSuccess) { fprintf(stderr, "kernel_launch: memset failed\n"); return; }
    Args a{};
    for (int i = 0; i < N_INPUTS; ++i) a.in[i] = (const float*)d_in[i];
    a.out = (float*)d_out; a.ws = (unsigned char*)d_ws;
#if MK_ONE_LAUNCH
    a.ph_lo = 0; a.ph_hi = NPHASES;
    hipLaunchKernelGGL(trunk_fwd, dim3(grid), dim3(512), LDS_BYTES, stream, a);
#else
    for (int p = 0; p < NPHASES; ++p) { a.ph_lo = p; a.ph_hi = p + 1; hipLaunchKernelGGL(trunk_fwd, dim3(grid), dim3(512), LDS_BYTES, stream, a); }
#endif
    const hipError_t le = hipPeekAtLastError();
    if (le != hipSuccess) fprintf(stderr, "kernel_launch: launch failed: %s\n", hipGetErrorName(le));
}
```

```cpp
#include <hip/hip_runtime.h>
#include <cstdio>
#include <cstdint>

#ifndef MK_ONE_LAUNCH
#define MK_ONE_LAUNCH 1
#endif

#define LAS __attribute__((address_space(3)))
typedef unsigned short bf16_t;
typedef short bf16x8 __attribute__((ext_vector_type(8)));
typedef float f32x4 __attribute__((ext_vector_type(4)));
typedef float f32x16 __attribute__((ext_vector_type(16)));
typedef unsigned u32x4 __attribute__((ext_vector_type(4)));
typedef unsigned u32x2 __attribute__((ext_vector_type(2)));

constexpr int D_MODEL = 2048, BATCH = 4, SEQ = 2048, MTOK = BATCH * SEQ, D_FF = 5632, MEM_LEN = 256, MMEM = BATCH * MEM_LEN;
constexpr int N_GU = 2 * D_FF;
constexpr int NIN0 = 6656, NIN1 = 1792, NIN2 = 3072, NIN3 = 6912;
constexpr int K_OUT = 2560;
constexpr float RMS_EPS = 1e-6f;
constexpr float LOG2E = 1.4426950408889634f;

constexpr size_t MiB = 1u << 20;
constexpr size_t WS_CTL = 0, CTL_ZERO_BYTES = 1 * MiB;
constexpr size_t WS_PSUM = 1 * MiB, WS_UPS = 2 * MiB, WS_PSMEM = 3 * MiB, WS_CB = 4 * MiB;
constexpr size_t WS_XB = 8 * MiB, WS_MEMB = 40 * MiB, WS_MKV = 44 * MiB, WS_MK = 52 * MiB, WS_MVT = 56 * MiB;
constexpr size_t WS_CAT = 60 * MiB, WS_HID = 100 * MiB, WS_U = 188 * MiB, WS_QM = 296 * MiB, WS_KVM = 344 * MiB;
constexpr size_t WS_KBUF = 408 * MiB, WS_VTBUF = 456 * MiB;
constexpr size_t WS_WGU = 488 * MiB;
constexpr size_t WS_WD = 840 * MiB;
constexpr size_t WS_WIN0 = 1016 * MiB, WS_WIN1 = 1042 * MiB, WS_WIN2 = 1049 * MiB, WS_WIN3 = 1061 * MiB;
constexpr size_t WS_WOUT = 1088 * MiB;
constexpr size_t WS_WQB = 1128 * MiB, WS_WKVB = 1131 * MiB, WS_WMKV = 1135 * MiB, WS_END = 1151 * MiB;
constexpr size_t WGU_BYTES = (size_t)N_GU * D_MODEL * 2, WD_BYTES = (size_t)D_MODEL * D_FF * 2, WOUT_BYTES = (size_t)D_MODEL * K_OUT * 2;
static_assert(WGU_BYTES == 44 * MiB && WD_BYTES == 22 * MiB && WOUT_BYTES == 10 * MiB, "weight sizes");

enum { I_X = 0, I_MEM, I_NORM_FFN1, I_F1G, I_F1U, I_F1D, I_NORM_MIX, I_NORM_FFN2, I_F2G, I_F2U, I_F2D, I_NORM_MEM, I_MEM_WKV, I_MEM_QN, I_MEM_KN,
       I_CONV_WIN, I_CONV_W, I_CONV_WOUT, I_MLA_WIN, I_MLA_QAN, I_MLA_WQB, I_MLA_KVAN, I_MLA_WKVB, I_MLA_QN, I_MLA_KN, I_MLA_WOUT,
       I_SWA_WIN, I_SWA_QN, I_SWA_KN, I_SWA_SINKS, I_SWA_WOUT, I_REL_BIAS, I_FOX_WIN, I_FOX_BF, I_FOX_QN, I_FOX_KN, I_FOX_WOUT, N_INPUTS };

__device__ __forceinline__ unsigned pk2(float lo, float hi) {
    typedef __bf16 b2 __attribute__((ext_vector_type(2))); typedef float f2 __attribute__((ext_vector_type(2)));
    return __builtin_bit_cast(unsigned, __builtin_convertvector((f2){lo, hi}, b2)); }
__device__ __forceinline__ float bf_lo(unsigned w) { return __uint_as_float(w << 16); }
__device__ __forceinline__ float bf_hi(unsigned w) { return __uint_as_float(w & 0xffff0000u); }
__device__ __forceinline__ void unpack8(const u32x4 v, float (&f)[8]) {
    f[0] = bf_lo(v.x); f[1] = bf_hi(v.x); f[2] = bf_lo(v.y); f[3] = bf_hi(v.y); f[4] = bf_lo(v.z); f[5] = bf_hi(v.z); f[6] = bf_lo(v.w); f[7] = bf_hi(v.w); }
__device__ __forceinline__ u32x4 pack8(const float (&f)[8]) { u32x4 o; o.x = pk2(f[0], f[1]); o.y = pk2(f[2], f[3]); o.z = pk2(f[4], f[5]); o.w = pk2(f[6], f[7]); return o; }
#define GAS __attribute__((address_space(1)))
__device__ __forceinline__ const GAS char* uni_ptr(const char* p) {
    const unsigned long long v = (unsigned long long)p; const unsigned lo = __builtin_amdgcn_readfirstlane((unsigned)v), hi = __builtin_amdgcn_readfirstlane((unsigned)(v >> 32));
    return (const GAS char*)(((unsigned long long)hi << 32) | lo); }
__device__ __forceinline__ float rope_invf_turns(int i) {
    return __builtin_amdgcn_exp2f(-(float)i * (13.287712379549449f / 32.0f)) * 0.15915494309189535f; }
__device__ __forceinline__ void rope_cs(int pos, int i, float& c, float& s) {
    float t = (float)pos * rope_invf_turns(i); t = t - floorf(t); c = __builtin_amdgcn_cosf(t); s = __builtin_amdgcn_sinf(t); }

namespace pg8 {
constexpr int BM = 256, BK = 64, HALF = 128, HTB = HALF * BK * 2, STAGE_BYTES = 8 * HTB, NXCD = 8, WGM = 8;
__host__ __device__ __forceinline__ int lds_byte(int r, int c) { const int st = (r >> 4) * 2 + (c >> 5), rr = r & 15, cc = c & 31, ob = rr * 64 + cc * 2; return st * 1024 + (ob ^ (((ob >> 9) & 1) << 5)); }
__host__ __device__ __forceinline__ void stage_rc(int b, int& R, int& C) { const int st = b / 1024, sb = b % 1024, swz = sb ^ (((sb >> 9) & 1) << 5); R = (st >> 1) * 16 + swz / 64; C = (st & 1) * 32 + (swz % 64) / 2; }
__host__ __device__ __forceinline__ int perm32(int rho) { const int n = rho >> 4, i = rho & 15; return 8 * (i >> 2) + 4 * n + (i & 3); }
struct Unit { int pm, pn; };
struct Gemm { const bf16_t* A; const bf16_t* Bt; int M, N, K, lda; };
struct StaticOrder {
    int nM, nN, nwg, G, c;
    __host__ __device__ void init(int M, int N, int G_, int c_) { nM = M / BM; nN = N / BM; nwg = nM * nN; G = G_; c = c_; }
    __host__ __device__ bool next(int i, Unit& u) const {
        const long L = (long)i * G + c; if (L >= nwg) return false;
        int wgid = (int)L; { const int q = nwg / NXCD, r = nwg % NXCD, xcd = wgid % NXCD, off = wgid / NXCD; wgid = (xcd < r ? xcd * (q + 1) : r * (q + 1) + (xcd - r) * q) + off; }
        const int nig = WGM * nN, gid = wgid / nig, fm = gid * WGM, gsz = (nM - fm) < WGM ? (nM - fm) : WGM;
        u.pm = fm + ((wgid % nig) % gsz); u.pn = (wgid % nig) / gsz; return true;
    }
    __device__ __forceinline__ void a_ready(const Unit&) const {}
    __device__ __forceinline__ void done(const Unit&) const {}
};

template <int CNT>
__device__ __forceinline__ void rows_rstd(const float* ps, int pitch, int off, int row0, int fq, float inv_dim, float (&rs)[2][4]) {
    float t[2][4];
#pragma unroll
    for (int ai = 0; ai < 2; ++ai)
#pragma unroll
        for (int m = 0; m < 4; ++m) { const float* p = ps + (size_t)(row0 + ai * HALF + m * 16) * pitch + off + fq * (CNT / 4); float s = 0.f;
#pragma unroll
            for (int i = 0; i < CNT / 4; ++i) s += p[i];
            t[ai][m] = s; }
#pragma unroll
    for (int ai = 0; ai < 2; ++ai)
#pragma unroll
        for (int m = 0; m < 4; ++m) { float s = t[ai][m]; s += __shfl_xor(s, 16); s += __shfl_xor(s, 32); rs[ai][m] = 1.0f / sqrtf(s * inv_dim + RMS_EPS); }
}
__device__ __forceinline__ float silu_mul(float g, float u) { return g * __builtin_amdgcn_rcpf(1.0f + __builtin_amdgcn_exp2f(-g * LOG2E)) * u; }

struct EpiSwiGLU {
    static constexpr bool PERM = true, AFTER_DRAIN = false;
    bf16_t* H; const float* ps;
    __device__ __forceinline__ void operator()(const f32x4 (&acc)[2][2][4][2], const Unit& u, int wr, int wc, int fr, int fq) const {
        const int row0 = u.pm * BM + wr * 64 + fr, col0 = u.pn * 128 + wc * 32 + 8 * fq;
        float rs[2][4]; rows_rstd<32>(ps, 32, 0, row0, fq, 1.0f / D_MODEL, rs);
#pragma unroll
        for (int ai = 0; ai < 2; ++ai)
#pragma unroll
            for (int m = 0; m < 4; ++m) {
                const int row = row0 + ai * HALF + m * 16;
                const float r = rs[ai][m];
                const f32x4 g0 = acc[ai][0][m][0] * r, g1 = acc[ai][0][m][1] * r, u0 = acc[ai][1][m][0] * r, u1 = acc[ai][1][m][1] * r;
                u32x4 w;
                w.x = pk2(silu_mul(g0[0], u0[0]), silu_mul(g0[1], u0[1])); w.y = pk2(silu_mul(g0[2], u0[2]), silu_mul(g0[3], u0[3]));
                w.z = pk2(silu_mul(g1[0], u1[0]), silu_mul(g1[1], u1[1])); w.w = pk2(silu_mul(g1[2], u1[2]), silu_mul(g1[3], u1[3]));
                *(u32x4*)(H + (size_t)row * D_FF + col0) = w;
            }
    }
};
struct EpiResid {
    static constexpr bool PERM = false, AFTER_DRAIN = false;
    const float* base; float* out; bf16_t* xb; float* ps; float alpha;
    __device__ __forceinline__ void operator()(const f32x4 (&acc)[2][2][4][2], const Unit& u, int wr, int wc, int fr, int fq) const {
        const int row0 = u.pm * BM + wr * 64 + fr, col0 = u.pn * BM + wc * 32 + 4 * fq;
#pragma unroll
        for (int ai = 0; ai < 2; ++ai) {
            f32x4 bv[4][2][2];
#pragma unroll
            for (int m = 0; m < 4; ++m)
#pragma unroll
                for (int bj = 0; bj < 2; ++bj)
#pragma unroll
                    for (int n = 0; n < 2; ++n) bv[m][bj][n] = *(const f32x4*)(base + (size_t)(row0 + ai * HALF + m * 16) * D_MODEL + col0 + bj * HALF + n * 16);
#pragma unroll
            for (int m = 0; m < 4; ++m) {
                const int row = row0 + ai * HALF + m * 16; const size_t off = (size_t)row * D_MODEL + col0;
                float ss = 0.f;
#pragma unroll
                for (int bj = 0; bj < 2; ++bj)
#pragma unroll
                    for (int n = 0; n < 2; ++n) {
                        const f32x4 v = bv[m][bj][n] + acc[ai][bj][m][n] * alpha;
                        *(f32x4*)(out + off + bj * HALF + n * 16) = v;
                        u32x2 w; w.x = pk2(v[0], v[1]); w.y = pk2(v[2], v[3]);
                        *(u32x2*)(xb + off + bj * HALF + n * 16) = w;
                        ss += (v[0] * v[0] + v[1] * v[1]) + (v[2] * v[2] + v[3] * v[3]);
                    }
                ss += __shfl_xor(ss, 16); ss += __shfl_xor(ss, 32);
                if (fq == 0) ps[(size_t)row * 32 + u.pn * 4 + wc] = ss;
            }
        }
    }
};
template <int CNT, bool WPS> struct EpiScale {
    static constexpr bool PERM = true, AFTER_DRAIN = false;
    bf16_t* O; int ldo; const float* ps; int ps_pitch, ps_off; float inv_dim; float* ops;
    __device__ __forceinline__ void operator()(const f32x4 (&acc)[2][2][4][2], const Unit& u, int wr, int wc, int fr, int fq) const {
        const int row0 = u.pm * BM + wr * 64 + fr, col0 = u.pn * BM + wc * 32 + 8 * fq;
        float rs[2][4]; rows_rstd<CNT>(ps, ps_pitch, ps_off, row0, fq, inv_dim, rs);
#pragma unroll
        for (int ai = 0; ai < 2; ++ai)
#pragma unroll
            for (int m = 0; m < 4; ++m) {
                const int row = row0 + ai * HALF + m * 16;
                const float r = rs[ai][m];
                float ss = 0.f;
#pragma unroll
                for (int bj = 0; bj < 2; ++bj) {
                    const f32x4 v0 = acc[ai][bj][m][0] * r, v1 = acc[ai][bj][m][1] * r;
                    if (WPS) ss += (v0[0] * v0[0] + v0[1] * v0[1]) + (v0[2] * v0[2] + v0[3] * v0[3]) + (v1[0] * v1[0] + v1[1] * v1[1]) + (v1[2] * v1[2] + v1[3] * v1[3]);
                    u32x4 w; w.x = pk2(v0[0], v0[1]); w.y = pk2(v0[2], v0[3]); w.z = pk2(v1[0], v1[1]); w.w = pk2(v1[2], v1[3]);
                    *(u32x4*)(O + (size_t)row * ldo + col0 + bj * HALF) = w;
                }
                if (WPS) { ss += __shfl_xor(ss, 16); ss += __shfl_xor(ss, 32); if (fq == 0) ops[(size_t)row * 32 + u.pn * 4 + wc] = ss; }
            }
    }
};

template <class Epi, class Sched, bool ALIGN_EPI = true>
__device__ __forceinline__ void gemm_phase(LAS unsigned char* lds, const Gemm g, const Sched& S, const Epi& E) {
    const int tid = threadIdx.x, wid = __builtin_amdgcn_readfirstlane(tid >> 6), lane = tid & 63, wr = wid >> 2, wc = wid & 3, fr = lane & 15, fq = lane >> 4;
    const int K = g.K, nt = K / BK, lda = g.lda;
    unsigned voffA[2], voffB[2];
#pragma unroll
    for (int i = 0; i < 2; ++i) { int R, C; stage_rc(tid * 16 + i * 8192, R, C); const int Rb = Epi::PERM ? ((R & ~31) + perm32(R & 31)) : R;
        voffA[i] = (unsigned)(R * lda + C) * 2u; voffB[i] = (unsigned)(Rb * K + C) * 2u; }
    const size_t kstep = (size_t)(BK * 2);
    const size_t hstepA = (size_t)HALF * lda * 2, hstepB = (size_t)HALF * K * 2;
    const size_t tstepA = 2 * hstepA, tstepB = 2 * hstepB;
    const unsigned ldsw = (unsigned)wid * 1024u;
    const int aoff = lds_byte(wr * 64 + fr, fq * 8), boff = lds_byte(wc * 32 + fr, fq * 8);
#define PG8_SA(b, h) (((b) * 2 + (h)) * HTB)
#define PG8_SB(b, h) ((4 + (b) * 2 + (h)) * HTB)
#define PG8_STAGE(bufoff, gbase, voff) do { _Pragma("unroll") for (int _i = 0; _i < 2; ++_i) \
        __builtin_amdgcn_global_load_lds((const unsigned*)((const char*)(gbase) + (voff)[_i]), (LAS unsigned*)(lds + (bufoff) + ldsw + _i * 8192), 16, 0, 0); } while (0)
#define PG8_LDA(dst, b, h) do { _Pragma("unroll") for (int m = 0; m < 4; ++m) _Pragma("unroll") for (int k = 0; k < 2; ++k) dst[m][k] = *(const LAS bf16x8*)(lds + PG8_SA(b, h) + aoff + m * 2048 + k * 1024); } while (0)
#define PG8_LDB(dst, b, h) do { _Pragma("unroll") for (int n = 0; n < 2; ++n) _Pragma("unroll") for (int k = 0; k < 2; ++k) dst[n][k] = *(const LAS bf16x8*)(lds + PG8_SB(b, h) + boff + n * 2048 + k * 1024); } while (0)
#define PG8_MMA(ai, bj, At, Bt) do { __builtin_amdgcn_s_setprio(1); _Pragma("unroll") for (int m = 0; m < 4; ++m) _Pragma("unroll") for (int n = 0; n < 2; ++n) _Pragma("unroll") for (int k = 0; k < 2; ++k) \
        acc[ai][bj][m][n] = __builtin_amdgcn_mfma_f32_16x16x32_bf16(Bt[n][k], At[m][k], acc[ai][bj][m][n], 0, 0, 0); __builtin_amdgcn_s_setprio(0); } while (0)
#define PG8_WAIT_V(n) asm volatile("s_waitcnt vmcnt(" #n ")" ::: "memory")
#define PG8_WAIT_L(n) asm volatile("s_waitcnt lgkmcnt(" #n ")" ::: "memory")
#define PG8_BAR __builtin_amdgcn_s_barrier()
#define PG8_SCHED __builtin_amdgcn_sched_barrier(0)
    Unit cur, nxt; int ui = 0;
    if (!S.next(0, cur)) return;
    f32x4 acc[2][2][4][2];
#pragma unroll
    for (int a = 0; a < 2; ++a)
#pragma unroll
        for (int b = 0; b < 2; ++b)
#pragma unroll
            for (int m = 0; m < 4; ++m)
#pragma unroll
                for (int n = 0; n < 2; ++n) acc[a][b][m][n] = (f32x4){0.f, 0.f, 0.f, 0.f};
    bf16x8 At[4][2], B0[2][2], B1[2][2];
    const char* cA = (const char*)g.A + (size_t)cur.pm * tstepA; const char* cB = (const char*)g.Bt + (size_t)cur.pn * tstepB;
    S.a_ready(cur);
    PG8_STAGE(PG8_SB(0, 0), cB, voffB); PG8_STAGE(PG8_SB(0, 1), cB + hstepB, voffB); PG8_STAGE(PG8_SA(0, 0), cA, voffA); PG8_STAGE(PG8_SA(0, 1), cA + hstepA, voffA);
    if (wr == 1) PG8_BAR;
    PG8_WAIT_V(2); PG8_BAR;
    PG8_STAGE(PG8_SB(1, 0), cB + kstep, voffB); PG8_STAGE(PG8_SA(1, 0), cA + kstep, voffA); PG8_STAGE(PG8_SB(1, 1), cB + hstepB + kstep, voffB);
    PG8_WAIT_V(6); PG8_BAR;
    for (;;) {
        const bool has_next = S.next(ui + 1, nxt);
        const char* nA = has_next ? (const char*)g.A + (size_t)nxt.pm * tstepA : cA; const char* nB = has_next ? (const char*)g.Bt + (size_t)nxt.pn * tstepB : cB;
        for (int t = 0; t < nt; t += 2) {
            const bool last = (t == nt - 2);
            const char* a1 = cA + (size_t)(t + 1) * kstep;
            const char* a2 = last ? nA : cA + (size_t)(t + 2) * kstep; const char* b2 = last ? nB : cB + (size_t)(t + 2) * kstep;
            const char* a3 = a2 + kstep; const char* b3 = b2 + kstep;
            if (last && has_next) S.a_ready(nxt);
            PG8_LDB(B0, 0, 0); PG8_LDB(B1, 0, 1); PG8_SCHED; PG8_LDA(At, 0, 0); PG8_STAGE(PG8_SA(1, 1), a1 + hstepA, voffA);
            PG8_WAIT_V(8); PG8_WAIT_L(0); PG8_BAR; PG8_MMA(0, 0, At, B0); PG8_MMA(0, 1, At, B1); PG8_BAR; PG8_SCHED;
            PG8_LDA(At, 0, 1); PG8_STAGE(PG8_SB(0, 0), b2, voffB); PG8_STAGE(PG8_SB(0, 1), b2 + hstepB, voffB); PG8_STAGE(PG8_SA(0, 0), a2, voffA);
            PG8_WAIT_V(8); PG8_WAIT_L(0); PG8_BAR; PG8_MMA(1, 0, At, B0); PG8_MMA(1, 1, At, B1); PG8_BAR; PG8_SCHED;
            PG8_LDB(B0, 1, 0); PG8_LDB(B1, 1, 1); PG8_SCHED; PG8_LDA(At, 1, 0); PG8_STAGE(PG8_SA(0, 1), a2 + hstepA, voffA);
            PG8_WAIT_V(8); PG8_WAIT_L(0); PG8_BAR; PG8_MMA(0, 0, At, B0); PG8_MMA(0, 1, At, B1); PG8_BAR; PG8_SCHED;
            PG8_LDA(At, 1, 1); PG8_STAGE(PG8_SB(1, 0), b3, voffB); PG8_STAGE(PG8_SB(1, 1), b3 + hstepB, voffB); PG8_STAGE(PG8_SA(1, 0), a3, voffA);
            PG8_WAIT_V(8); PG8_WAIT_L(0); PG8_BAR; PG8_MMA(1, 0, At, B0); PG8_MMA(1, 1, At, B1); PG8_BAR; PG8_SCHED;
        }
        if constexpr (ALIGN_EPI) { if (wr == 0) PG8_BAR; }
        E(acc, cur, wr, wc, fr, fq); S.done(cur);
        if (!has_next) break;
#pragma unroll
        for (int a = 0; a < 2; ++a)
#pragma unroll
            for (int b = 0; b < 2; ++b)
#pragma unroll
                for (int m = 0; m < 4; ++m)
#pragma unroll
                    for (int n = 0; n < 2; ++n) acc[a][b][m][n] = (f32x4){0.f, 0.f, 0.f, 0.f};
        cur = nxt; cA = nA; cB = nB; ++ui;
        if constexpr (ALIGN_EPI) { if (wr == 1) PG8_BAR; }
    }
    PG8_WAIT_V(0);
    if constexpr (!ALIGN_EPI) { if (wr == 0) PG8_BAR; }
    PG8_BAR;
#undef PG8_SA
#undef PG8_SB
#undef PG8_STAGE
#undef PG8_LDA
#undef PG8_LDB
#undef PG8_MMA
#undef PG8_WAIT_V
#undef PG8_WAIT_L
#undef PG8_BAR
#undef PG8_SCHED
}
}

struct FaArgs {
    const bf16_t* Q; int q_pitch, q_col0, q_hstride;
    const bf16_t* K; const bf16_t* Vt; int Skv, kv_group, nheads;
    bf16_t* O; int o_pitch, o_col0;
    const float* qgain; const float* bias; const float* sinks; float qscale;
};
__device__ const unsigned char T5_BUCKET[128] = {
    0, 1, 2, 3, 4, 5, 6, 7, 8, 9, 10, 11, 12, 13, 14, 15, 16, 16, 16, 17, 17, 18, 18, 18, 19, 19, 19, 20, 20, 20, 20, 21, 21, 21, 21, 22, 22, 22, 22, 22, 23, 23, 23, 23, 23, 23,
    24, 24, 24, 24, 24, 24, 25, 25, 25, 25, 25, 25, 25, 26, 26, 26, 26, 26, 26, 26, 26, 27, 27, 27, 27, 27, 27, 27, 27, 27, 27, 28, 28, 28, 28, 28, 28, 28, 28, 28, 28,
    29, 29, 29, 29, 29, 29, 29, 29, 29, 29, 29, 29, 30, 30, 30, 30, 30, 30, 30, 30, 30, 30, 30, 30, 30, 30, 31, 31, 31, 31, 31, 31, 31, 31, 31, 31, 31, 31, 31, 31, 31};

template <int DQK, int DV, int MODE>
__device__ __forceinline__ void fa_unit(LAS unsigned char* lds, const FaArgs& A, const int b, const int h, const int qb) {
    constexpr int NKS = DQK / 16, NDB = DV / 32, KP = DQK + 8, VP = 68;
    constexpr int KBYTES = 64 * KP * 2, VBYTES = DV * VP * 2;
    constexpr int OFF_K = 0, OFF_V = 2 * KBYTES, OFF_B = OFF_V + 2 * VBYTES, OFF_TAB = OFF_B + 512;
    static_assert(OFF_TAB + 512 <= 131072, "FA LDS");
    constexpr int KCH = DQK / 8, KPT = 64 * KCH / 512, VPT = DV * 8 / 512;
    static_assert(KPT * 512 == 64 * KCH && VPT * 512 == DV * 8, "FA staging");
    const int tid = threadIdx.x, lane = tid & 63, w = __builtin_amdgcn_readfirstlane(tid >> 6), r = lane & 31, hh = lane >> 5;
    const int q0 = qb * 256, qw0 = q0 + w * 32, qpos = qw0 + r;
    const int bhk = (MODE == 1) ? b * (A.nheads / A.kv_group) + h / A.kv_group : b * A.nheads + h;

    bf16x8 Qf[NKS];
    {
        int opq = 0; asm volatile("" : "+v"(opq));
        const bf16_t* Qp = A.Q + (size_t)(b * SEQ + qpos) * A.q_pitch + A.q_col0 + h * A.q_hstride + 8 * hh;
        float qf[NKS][8];
#pragma unroll
        for (int ks = 0; ks < NKS; ++ks) { const u32x4 v = *(const u32x4*)(Qp + 16 * ks); unpack8(v, qf[ks]); }
        if constexpr (MODE == 0) {
            float sn = 0.f, sr = 0.f;
#pragma unroll
            for (int ks = 0; ks < 8; ++ks)
#pragma unroll
                for (int j = 0; j < 8; ++j) sn += qf[ks][j] * qf[ks][j];
#pragma unroll
            for (int ks = 8; ks < 12; ++ks)
#pragma unroll
                for (int j = 0; j < 8; ++j) sr += qf[ks][j] * qf[ks][j];
            sn += __shfl_xor(sn, 32); sr += __shfl_xor(sr, 32);
            const float rn = 1.0f / sqrtf(sn * (1.0f / 128.0f) + RMS_EPS), rr = 1.0f / sqrtf(sr * (1.0f / 64.0f) + RMS_EPS);
#pragma unroll
            for (int ks = 0; ks < 8; ++ks) {
                const f32x4 g0 = *(const f32x4*)(A.qgain + 16 * ks + 8 * hh), g1 = *(const f32x4*)(A.qgain + 16 * ks + 8 * hh + 4);
#pragma unroll
                for (int j = 0; j < 4; ++j) { qf[ks][j] *= rn * g0[j] * A.qscale; qf[ks][4 + j] *= rn * g1[j] * A.qscale; }
            }
#pragma unroll
            for (int ks = 8; ks < 10; ++ks) {
                const int i0 = 16 * (ks - 8) + 8 * hh;
                const f32x4 ga0 = *(const f32x4*)(A.qgain + 128 + i0), ga1 = *(const f32x4*)(A.qgain + 128 + i0 + 4);
                const f32x4 gb0 = *(const f32x4*)(A.qgain + 160 + i0), gb1 = *(const f32x4*)(A.qgain + 160 + i0 + 4);
#pragma unroll
                for (int j = 0; j < 8; ++j) {
                    const float ga = j < 4 ? ga0[j & 3] : ga1[j & 3], gb = j < 4 ? gb0[j & 3] : gb1[j & 3];
                    const float t1 = qf[ks][j] * rr * ga, t2 = qf[ks + 2][j] * rr * gb;
                    float c, s; rope_cs(qpos, i0 + j + opq, c, s);
                    qf[ks][j] = (t1 * c - t2 * s) * A.qscale; qf[ks + 2][j] = (t1 * s + t2 * c) * A.qscale;
                }
            }
        } else {
            float ss = 0.f;
#pragma unroll
            for (int ks = 0; ks < NKS; ++ks)
#pragma unroll
                for (int j = 0; j < 8; ++j) ss += qf[ks][j] * qf[ks][j];
            ss += __shfl_xor(ss, 32);
            const float rs = 1.0f / sqrtf(ss * (1.0f / DQK) + RMS_EPS) * A.qscale;
#pragma unroll
            for (int ks = 0; ks < NKS; ++ks) {
                const f32x4 g0 = *(const f32x4*)(A.qgain + 16 * ks + 8 * hh), g1 = *(const f32x4*)(A.qgain + 16 * ks + 8 * hh + 4);
#pragma unroll
                for (int j = 0; j < 4; ++j) { qf[ks][j] *= rs * g0[j]; qf[ks][4 + j] *= rs * g1[j]; }
            }
        }
#pragma unroll
        for (int ks = 0; ks < NKS; ++ks) Qf[ks] = __builtin_bit_cast(bf16x8, pack8(qf[ks]));
    }
    if constexpr (MODE == 1) { if (tid < 128) *(LAS float*)(lds + OFF_TAB + 4 * tid) = A.bias[(int)T5_BUCKET[tid] * 32 + h] * LOG2E; }

    int t_lo = 0, t_hi;
    if constexpr (MODE == 3) t_hi = A.Skv / 64; else t_hi = 4 * qb + 4;
    if constexpr (MODE == 1) { const int lowk = q0 - 127; t_lo = lowk > 0 ? lowk / 64 : 0; }
    const int nt = t_hi - t_lo;
    const bf16_t* Kg = A.K + (size_t)bhk * A.Skv * DQK;
    const bf16_t* Vg = A.Vt + (size_t)bhk * DV * A.Skv;
    const float* Bg = (MODE == 2) ? A.bias + (size_t)(b * A.nheads + h) * SEQ : nullptr;
    u32x4 kst[KPT], vst[VPT]; f32x4 bst = (f32x4){0.f, 0.f, 0.f, 0.f};
    unsigned koff[KPT], voff[VPT];
#pragma unroll
    for (int i = 0; i < KPT; ++i) { const int c = tid + 512 * i, row = c / KCH, cc = c % KCH; koff[i] = (unsigned)(row * DQK + cc * 8) * 2u; }
#pragma unroll
    for (int i = 0; i < VPT; ++i) { const int c = tid + 512 * i, d = c >> 3, cc = c & 7; voff[i] = (unsigned)(d * A.Skv + cc * 8) * 2u; }
#define FA_LOAD(t) do { const GAS char* _kt = uni_ptr((const char*)Kg + (size_t)(64 * (t)) * DQK * 2); const GAS char* _vt = uni_ptr((const char*)Vg + (size_t)(64 * (t)) * 2); \
        _Pragma("unroll") for (int _i = 0; _i < KPT; ++_i) kst[_i] = *(const GAS u32x4*)(_kt + koff[_i]); \
        _Pragma("unroll") for (int _i = 0; _i < VPT; ++_i) vst[_i] = *(const GAS u32x4*)(_vt + voff[_i]); \
        if (MODE == 2) { if (tid < 16) bst = *(const f32x4*)(Bg + 64 * (t) + 4 * tid); } } while (0)
#define FA_WRITE(buf) do { \
        _Pragma("unroll") for (int _i = 0; _i < KPT; ++_i) { const int _c = tid + 512 * _i, _row = _c / KCH, _cc = _c % KCH; *(LAS u32x4*)(lds + OFF_K + (buf) * KBYTES + (_row * KP + _cc * 8) * 2) = kst[_i]; } \
        _Pragma("unroll") for (int _i = 0; _i < VPT; ++_i) { const int _c = tid + 512 * _i, _d = _c >> 3, _cc = _c & 7; LAS unsigned char* _p = lds + OFF_V + (buf) * VBYTES + (_d * VP + _cc * 8) * 2; \
            *(LAS u32x2*)_p = (u32x2){vst[_i].x, vst[_i].y}; *(LAS u32x2*)(_p + 8) = (u32x2){vst[_i].z, vst[_i].w}; } \
        if (MODE == 2) { if (tid < 16) *(LAS f32x4*)(lds + OFF_B + (buf) * 256 + 16 * tid) = bst; } } while (0)

    f32x16 O[NDB];
#pragma unroll
    for (int db = 0; db < NDB; ++db)
#pragma unroll
        for (int i = 0; i < 16; ++i) O[db][i] = 0.f;
    float m_run = -1e30f, l_run = 0.f;
    FA_LOAD(t_lo);
    for (int it = 0; it < nt; ++it) {
        const int t = t_lo + it, buf = it & 1;
        FA_WRITE(buf);
        __syncthreads();
        if (it + 1 < nt) FA_LOAD(t + 1);
#pragma unroll
        for (int sub = 0; sub < 2; ++sub) {
            const int ks0 = 64 * t + 32 * sub;
            bool active = true;
            if constexpr (MODE == 0 || MODE == 2) active = (ks0 <= qw0 + 31);
            if constexpr (MODE == 1) active = (ks0 <= qw0 + 31) && (ks0 + 31 >= qw0 - 127);
            if (!active) continue;
            f32x16 s;
            if constexpr (MODE == 2) {
#pragma unroll
                for (int g = 0; g < 4; ++g) { const f32x4 bb = *(const LAS f32x4*)(lds + OFF_B + buf * 256 + (32 * sub + 8 * g + 4 * hh) * 4); s[4 * g] = bb[0]; s[4 * g + 1] = bb[1]; s[4 * g + 2] = bb[2]; s[4 * g + 3] = bb[3]; }
            } else if constexpr (MODE == 1) {
#pragma unroll
                for (int i = 0; i < 16; ++i) { int dist = qpos - (ks0 + (i & 3) + 8 * (i >> 2) + 4 * hh); dist = dist < 0 ? 0 : (dist > 127 ? 127 : dist); s[i] = *(const LAS float*)(lds + OFF_TAB + 4 * dist); }
            } else {
#pragma unroll
                for (int i = 0; i < 16; ++i) s[i] = 0.f;
            }
#pragma unroll
            for (int ks = 0; ks < NKS; ++ks) {
                const bf16x8 a = *(const LAS bf16x8*)(lds + OFF_K + buf * KBYTES + ((32 * sub + r) * KP + 16 * ks + 8 * hh) * 2);
                s = __builtin_amdgcn_mfma_f32_32x32x16_bf16(a, Qf[ks], s, 0, 0, 0);
            }
            if constexpr (MODE == 0 || MODE == 2) {
                if (ks0 + 31 > qw0) {
#pragma unroll
                    for (int i = 0; i < 16; ++i) { const int key = ks0 + (i & 3) + 8 * (i >> 2) + 4 * hh; if (key > qpos) s[i] = -__builtin_inff(); }
                }
            }
            if constexpr (MODE == 1) {
#pragma unroll
                for (int i = 0; i < 16; ++i) { const int key = ks0 + (i & 3) + 8 * (i >> 2) + 4 * hh; if ((unsigned)(qpos - key) >= 128u) s[i] = -__builtin_inff(); }
            }
            float mx = s[0];
#pragma unroll
            for (int i = 1; i < 16; ++i) mx = fmaxf(mx, s[i]);
            mx = fmaxf(mx, __shfl_xor(mx, 32));
            const float mnew = fmaxf(m_run, mx);
            const float alpha = __builtin_amdgcn_exp2f(m_run - mnew);
            m_run = mnew;
            float psum = 0.f;
#pragma unroll
            for (int i = 0; i < 16; ++i) { s[i] = __builtin_amdgcn_exp2f(s[i] - mnew); psum += s[i]; }
            l_run = l_run * alpha + psum;
#pragma unroll
            for (int db = 0; db < NDB; ++db)
#pragma unroll
                for (int i = 0; i < 16; ++i) O[db][i] *= alpha;
            bf16x8 P[2];
#pragma unroll
            for (int s2 = 0; s2 < 2; ++s2) { u32x4 pw; pw.x = pk2(s[8 * s2], s[8 * s2 + 1]); pw.y = pk2(s[8 * s2 + 2], s[8 * s2 + 3]); pw.z = pk2(s[8 * s2 + 4], s[8 * s2 + 5]); pw.w = pk2(s[8 * s2 + 6], s[8 * s2 + 7]); P[s2] = __builtin_bit_cast(bf16x8, pw); }
#pragma unroll
            for (int db = 0; db < NDB; ++db)
#pragma unroll
                for (int s2 = 0; s2 < 2; ++s2) {
                    const LAS unsigned char* vp = lds + OFF_V + buf * VBYTES + ((32 * db + r) * VP + 32 * sub + 16 * s2 + 4 * hh) * 2;
                    const u32x2 lo = *(const LAS u32x2*)vp, hi = *(const LAS u32x2*)(vp + 16);
                    const bf16x8 a = __builtin_bit_cast(bf16x8, (u32x4){lo.x, lo.y, hi.x, hi.y});
                    O[db] = __builtin_amdgcn_mfma_f32_32x32x16_bf16(a, P[s2], O[db], 0, 0, 0);
                }
        }
    }
#undef FA_LOAD
#undef FA_WRITE
    float l_tot = l_run + __shfl_xor(l_run, 32);
    if constexpr (MODE == 1) l_tot += __builtin_amdgcn_exp2f(A.sinks[h] * LOG2E - m_run);
    const float inv_l = 1.0f / l_tot;
    bf16_t* Op = A.O + (size_t)(b * SEQ + qpos) * A.o_pitch + A.o_col0 + h * DV;
#pragma unroll
    for (int db = 0; db < NDB; ++db)
#pragma unroll
        for (int g = 0; g < 4; ++g) {
            u32x2 wv; wv.x = pk2(O[db][4 * g] * inv_l, O[db][4 * g + 1] * inv_l); wv.y = pk2(O[db][4 * g + 2] * inv_l, O[db][4 * g + 3] * inv_l);
            *(u32x2*)(Op + 32 * db + 8 * g + 4 * hh) = wv;
        }
    __syncthreads();
}

template <int D>
__device__ __forceinline__ void headnorm_items(const bf16_t* src, int src_pitch, int src_col0, int src_hstride, int H, const float* gain,
                                               bf16_t* dst, int dst_D, int dst_d0, int S, int M, int gw, int NGW, int lane) {
    constexpr int LPI = D / 8, IPW = 64 / LPI;
    const int li = lane % LPI, sub = lane / LPI;
    const f32x4 g0 = *(const f32x4*)(gain + 8 * li), g1 = *(const f32x4*)(gain + 8 * li + 4);
    const int total = M * H;
    for (int it = gw * IPW + sub; it < total; it += NGW * IPW) {
        const int m = it / H, h = it % H;
        const u32x4 v = *(const u32x4*)(src + (size_t)m * src_pitch + src_col0 + h * src_hstride + 8 * li);
        float f[8]; unpack8(v, f);
        float ss = 0.f;
#pragma unroll
        for (int j = 0; j < 8; ++j) ss += f[j] * f[j];
#pragma unroll
        for (int o = 1; o < LPI; o <<= 1) ss += __shfl_xor(ss, o);
        const float rs = 1.0f / sqrtf(ss * (1.0f / D) + RMS_EPS);
#pragma unroll
        for (int j = 0; j < 4; ++j) { f[j] *= rs * g0[j]; f[4 + j] *= rs * g1[j]; }
        const int bb = m / S, s = m % S;
        *(u32x4*)(dst + ((size_t)(bb * H + h) * S + s) * dst_D + dst_d0 + 8 * li) = pack8(f);
    }
}
__device__ __forceinline__ void mla_krope_items(const bf16_t* src, int src_pitch, int col0, const float* gain, bf16_t* Kd, int gw, int NGW, int lane) {
    const int li = lane & 7, sub = lane >> 3;
    const f32x4 ga = *(const f32x4*)(gain + 4 * li), gb = *(const f32x4*)(gain + 32 + 4 * li);
    for (int m = gw * 8 + sub; m < MTOK; m += NGW * 8) {
        const u32x2 va = *(const u32x2*)(src + (size_t)m * src_pitch + col0 + 4 * li), vb = *(const u32x2*)(src + (size_t)m * src_pitch + col0 + 32 + 4 * li);
        float a[4] = {bf_lo(va.x), bf_hi(va.x), bf_lo(va.y), bf_hi(va.y)}, bq[4] = {bf_lo(vb.x), bf_hi(vb.x), bf_lo(vb.y), bf_hi(vb.y)};
        float ss = 0.f;
#pragma unroll
        for (int j = 0; j < 4; ++j) ss += a[j] * a[j] + bq[j] * bq[j];
        ss += __shfl_xor(ss, 1); ss += __shfl_xor(ss, 2); ss += __shfl_xor(ss, 4);
        const float rs = 1.0f / sqrtf(ss * (1.0f / 64.0f) + RMS_EPS);
        const int bb = m / SEQ, s = m % SEQ;
        float o1[4], o2[4];
#pragma unroll
        for (int j = 0; j < 4; ++j) { const float t1 = a[j] * rs * ga[j], t2 = bq[j] * rs * gb[j]; float c, sn; rope_cs(s, 4 * li + j, c, sn); o1[j] = t1 * c - t2 * sn; o2[j] = t1 * sn + t2 * c; }
        const u32x2 w1 = (u32x2){pk2(o1[0], o1[1]), pk2(o1[2], o1[3])}, w2 = (u32x2){pk2(o2[0], o2[1]), pk2(o2[2], o2[3])};
#pragma unroll
        for (int h = 0; h < 16; ++h) { bf16_t* kp = Kd + ((size_t)(bb * 16 + h) * SEQ + s) * 192 + 128; *(u32x2*)(kp + 4 * li) = w1; *(u32x2*)(kp + 32 + 4 * li) = w2; }
    }
}
__device__ __forceinline__ void vtrans_items(const bf16_t* src, int pitch, int col0, int hstride, int H, int DV, bf16_t* dst, int S, int B, LAS unsigned char* scr, int gw, int NGW, int lane) {
    const int ndb = DV / 32, ntb = S / 64, total = B * H * ntb * ndb;
    for (int it = gw; it < total; it += NGW) {
        const int dbk = it % ndb, tb = (it / ndb) % ntb, bh = it / (ndb * ntb), bb = bh / H, h = bh % H;
        u32x4 v[4];
#pragma unroll
        for (int i = 0; i < 4; ++i) { const int c = lane + 64 * i, tok = c >> 2, dc = c & 3; v[i] = *(const u32x4*)(src + (size_t)(bb * S + 64 * tb + tok) * pitch + col0 + h * hstride + 32 * dbk + 8 * dc); }
#pragma unroll
        for (int i = 0; i < 4; ++i) { const int c = lane + 64 * i, tok = c >> 2, dc = c & 3; const unsigned wv[4] = {v[i].x, v[i].y, v[i].z, v[i].w};
#pragma unroll
            for (int e = 0; e < 8; ++e) *(LAS unsigned short*)(scr + ((8 * dc + e) * 66 + tok) * 2) = (unsigned short)((e & 1) ? (wv[e >> 1] >> 16) : (wv[e >> 1] & 0xffffu)); }
        asm volatile("s_waitcnt lgkmcnt(0)" ::: "memory");
        const int d = lane & 31, half = lane >> 5;
        unsigned o[16];
#pragma unroll
        for (int i = 0; i < 16; ++i) o[i] = *(const LAS unsigned*)(scr + (d * 66 + 32 * half + 2 * i) * 2);
        bf16_t* dp = dst + ((size_t)(bh * DV + 32 * dbk + d)) * S + 64 * tb + 32 * half;
#pragma unroll
        for (int i = 0; i < 4; ++i) *(u32x4*)(dp + 8 * i) = (u32x4){o[4 * i], o[4 * i + 1], o[4 * i + 2], o[4 * i + 3]};
        asm volatile("s_waitcnt lgkmcnt(0)" ::: "memory");
    }
}
__device__ __forceinline__ void conv_items(const bf16_t* u, const float* cw, bf16_t* cat, int gt, int NT) {
    const int total = MTOK * (D_MODEL / 8);
    for (int it = gt; it < total; it += NT) {
        const int m = it / (D_MODEL / 8), c8 = (it % (D_MODEL / 8)) * 8, s = m % SEQ;
        float z[3][8];
#pragma unroll
        for (int tap = 0; tap < 3; ++tap) {
            const int back = 2 - tap;
            if (s - back >= 0) { const bf16_t* p = u + (size_t)(m - back) * NIN0 + c8; float gc[8], xt[8]; unpack8(*(const u32x4*)(p + D_MODEL), gc); unpack8(*(const u32x4*)(p + 2 * D_MODEL), xt);
#pragma unroll
                for (int j = 0; j < 8; ++j) z[tap][j] = gc[j] * xt[j]; }
            else {
#pragma unroll
                for (int j = 0; j < 8; ++j) z[tap][j] = 0.f; }
        }
        float gb[8], o[8]; unpack8(*(const u32x4*)(u + (size_t)m * NIN0 + c8), gb);
#pragma unroll
        for (int j = 0; j < 8; ++j) o[j] = gb[j] * (z[0][j] * cw[c8 + j] + z[1][j] * cw[D_MODEL + c8 + j] + z[2][j] * cw[2 * D_MODEL + c8 + j]);
        *(u32x4*)(cat + (size_t)m * K_OUT + c8) = pack8(o);
    }
}
__device__ __forceinline__ void fox_scan_items(const bf16_t* u, int pitch, int fcol0, const float* bfv, float* CB, int gw, int NGW, int lane) {
    for (int it = gw; it < BATCH * 32; it += NGW) {
        const int bb = it / 32, h = it % 32; const float bias = bfv[h];
        float v[32]; float run = 0.f;
#pragma unroll
        for (int i = 0; i < 32; ++i) { const int s = lane * 32 + i; const float x = __uint_as_float(((unsigned)u[(size_t)(bb * SEQ + s) * pitch + fcol0 + h]) << 16) + bias;
            const float ls = fminf(x, 0.f) - log1pf(expf(-fabsf(x))); run += ls; v[i] = run; }
        float tot = run;
#pragma unroll
        for (int o = 1; o < 64; o <<= 1) { const float t = __shfl_up(tot, o); if (lane >= o) tot += t; }
        const float base = tot - run;
        float* cp = CB + (size_t)it * SEQ + lane * 32;
#pragma unroll
        for (int i = 0; i < 8; ++i) *(f32x4*)(cp + 4 * i) = (f32x4){-(base + v[4 * i]) * LOG2E, -(base + v[4 * i + 1]) * LOG2E, -(base + v[4 * i + 2]) * LOG2E, -(base + v[4 * i + 3]) * LOG2E};
    }
}
__device__ __forceinline__ void rowinit_items(const float* src, bf16_t* dst, float* ps, int rows, int gw, int NGW, int lane) {
    for (int m = gw; m < rows; m += NGW) {
        const f32x4* xr = (const f32x4*)(src + (size_t)m * D_MODEL); float ss = 0.f;
#pragma unroll
        for (int j = 0; j < 8; ++j) { const f32x4 v = xr[64 * j + lane]; ss += (v[0] * v[0] + v[1] * v[1]) + (v[2] * v[2] + v[3] * v[3]);
            *(u32x2*)(dst + (size_t)m * D_MODEL + 4 * (64 * j + lane)) = (u32x2){pk2(v[0], v[1]), pk2(v[2], v[3])}; }
#pragma unroll
        for (int o = 1; o < 64; o <<= 1) ss += __shfl_xor(ss, o);
        if (lane < 32) ps[(size_t)m * 32 + lane] = (lane == 0) ? ss : 0.f;
    }
}

struct Seg { int in_idx; int src_off; int K; int Nsrc; int col0; int ncols; int dst_mib; int dst_boff; int drow0; int gain_idx; int gain_off; int inter; };
#define SEG_FFN(L) \
    {I_F1G, (L) * D_MODEL * D_FF, D_MODEL, D_FF, 0, D_FF, 488 + 44 * (2 * (L)), 0, 0, I_NORM_FFN1, (L) * D_MODEL, 1}, \
    {I_F1U, (L) * D_MODEL * D_FF, D_MODEL, D_FF, 0, D_FF, 488 + 44 * (2 * (L)), 0, 128, I_NORM_FFN1, (L) * D_MODEL, 1}, \
    {I_F1D, (L) * D_MODEL * D_FF, D_FF, D_MODEL, 0, D_MODEL, 840 + 22 * (2 * (L)), 0, 0, -1, 0, 0}, \
    {I_F2G, (L) * D_MODEL * D_FF, D_MODEL, D_FF, 0, D_FF, 488 + 44 * (2 * (L) + 1), 0, 0, I_NORM_FFN2, (L) * D_MODEL, 1}, \
    {I_F2U, (L) * D_MODEL * D_FF, D_MODEL, D_FF, 0, D_FF, 488 + 44 * (2 * (L) + 1), 0, 128, I_NORM_FFN2, (L) * D_MODEL, 1}, \
    {I_F2D, (L) * D_MODEL * D_FF, D_FF, D_MODEL, 0, D_MODEL, 840 + 22 * (2 * (L) + 1), 0, 0, -1, 0, 0}, \
    {I_MEM_WKV, (L) * D_MODEL * 1024, D_MODEL, 1024, 0, 1024, 1135, 0, (L) * 1024, I_NORM_MEM, (L) * D_MODEL, 0}
__device__ const Seg SEGS[] = {
    SEG_FFN(0), SEG_FFN(1), SEG_FFN(2), SEG_FFN(3),
    {I_CONV_WIN, 0, D_MODEL, 6656, 0, 6656, 1016, 0, 0, I_NORM_MIX, 0 * D_MODEL, 0},
    {I_CONV_WOUT, 0, K_OUT, D_MODEL, 0, D_MODEL, 1088, 0, 0, -1, 0, 0},
    {I_MLA_WIN, 0, D_MODEL, 1600, 0, 1024, 1042, 0, 0, I_NORM_MIX, 1 * D_MODEL, 0},
    {I_MLA_WIN, 0, D_MODEL, 1600, 1088, 512, 1042, 0, 1024, I_NORM_MIX, 1 * D_MODEL, 0},
    {I_MLA_WIN, 0, D_MODEL, 1600, 1024, 64, 1042, 0, 1536, I_NORM_MIX, 1 * D_MODEL, 0},
    {I_MLA_WQB, 0, 512, 3072, 0, 3072, 1128, 0, 0, I_MLA_QAN, 0, 0},
    {I_MLA_WKVB, 0, 512, 4096, 0, 4096, 1131, 0, 0, I_MLA_KVAN, 0, 0},
    {I_MLA_WOUT, 0, K_OUT, D_MODEL, 0, D_MODEL, 1098, 0, 0, -1, 0, 0},
    {I_SWA_WIN, 0, D_MODEL, 3072, 0, 3072, 1049, 0, 0, I_NORM_MIX, 2 * D_MODEL, 0},
    {I_SWA_WOUT, 0, K_OUT, D_MODEL, 0, D_MODEL, 1108, 0, 0, -1, 0, 0},
    {I_FOX_WIN, 0, D_MODEL, 6688, 0, 6144, 1061, 0, 0, I_NORM_MIX, 3 * D_MODEL, 0},
    {I_FOX_WIN, 0, D_MODEL, 6688, 6176, 512, 1061, 0, 6144, I_NORM_MIX, 3 * D_MODEL, 0},
    {I_FOX_WIN, 0, D_MODEL, 6688, 6144, 32, 1061, 0, 6656, I_NORM_MIX, 3 * D_MODEL, 0},
    {I_FOX_WOUT, 0, K_OUT, D_MODEL, 0, D_MODEL, 1118, 0, 0, -1, 0, 0},
};
constexpr int NSEG = sizeof(SEGS) / sizeof(Seg);

__device__ __forceinline__ void p0_item(const float* W, int K, int Nsrc, int n0src, bf16_t* WT, int drow, const float* gain, LAS float* scr, int k0, int lane) {
    float v[32];
#pragma unroll
    for (int i = 0; i < 32; ++i) { const int kk = 2 * i + (lane >> 5); v[i] = W[(size_t)(k0 + kk) * Nsrc + n0src + (lane & 31)]; }
#pragma unroll
    for (int i = 0; i < 32; ++i) { const int kk = 2 * i + (lane >> 5); scr[kk * 33 + (lane & 31)] = v[i]; }
    asm volatile("s_waitcnt lgkmcnt(0)" ::: "memory");
    const int c = lane & 7;
    f32x4 g0 = (f32x4){1.f, 1.f, 1.f, 1.f}, g1 = g0;
    if (gain) { g0 = *(const f32x4*)(gain + k0 + 8 * c); g1 = *(const f32x4*)(gain + k0 + 8 * c + 4); }
#pragma unroll
    for (int j = 0; j < 4; ++j) { const int n = (lane >> 3) + 8 * j; const LAS float* s = scr + (8 * c) * 33 + n;
        u32x4 o; o.x = pk2(s[0 * 33] * g0[0], s[1 * 33] * g0[1]); o.y = pk2(s[2 * 33] * g0[2], s[3 * 33] * g0[3]); o.z = pk2(s[4 * 33] * g1[0], s[5 * 33] * g1[1]); o.w = pk2(s[6 * 33] * g1[2], s[7 * 33] * g1[3]);
        *(u32x4*)(WT + (size_t)(drow + n) * K + k0 + 8 * c) = o; }
    asm volatile("s_waitcnt lgkmcnt(0)" ::: "memory");
}

#define XB_TMO      128
#define XB_XCNT(j)  (256  + 64 * (j))
#define XB_XSUB(j)  (1280 + 64 * (j))
#define XB_XGEN(j)  (2304 + 64 * (j))
#define XB_TOP      3328
#define XB_TOPGEN   3392
#define XCD_BAR_WORDS 3456
#define XB_SPIN_CAP (1u << 18)
__device__ __forceinline__ unsigned xb_ld(unsigned* p)              { return __hip_atomic_load(p, __ATOMIC_RELAXED, __HIP_MEMORY_SCOPE_AGENT); }
__device__ __forceinline__ unsigned xb_add(unsigned* p, unsigned v) { return __hip_atomic_fetch_add(p, v, __ATOMIC_RELAXED, __HIP_MEMORY_SCOPE_AGENT); }
__device__ __forceinline__ unsigned xb_xcc_id() { return (unsigned)__builtin_amdgcn_s_getreg((3 << 11) | 20) & 0xFu; }
#define XB_SPIN(cond, bar) do { unsigned _sp = 0; while (cond) { __builtin_amdgcn_s_sleep(1); \
    if ((++_sp & 255u) == 0u) { if (xb_ld(&(bar)[XB_TMO])) break; if (_sp > XB_SPIN_CAP) { atomicAdd(&(bar)[XB_TMO], 1u); break; } } } } while (0)
struct XcdBarrier { unsigned* bar; unsigned x; volatile LAS unsigned* st; };
__device__ __forceinline__ XcdBarrier xcd_barrier_post(unsigned* bar, volatile LAS unsigned* st) {
    XcdBarrier b; b.bar = bar; b.x = xb_xcc_id(); b.st = st;
    if (threadIdx.x == 0) (void)xb_add(&bar[XB_XCNT(b.x)], 1u);
    return b;
}
__device__ __forceinline__ void xcd_barrier_complete(unsigned* bar, unsigned x, unsigned& nloc, unsigned& nx) {
    const unsigned G = gridDim.x * gridDim.y * gridDim.z;
    unsigned sum, cnt, mine, sp = 0u;
    for (;;) {
        sum = 0u; cnt = 0u; mine = 0u;
#pragma unroll
        for (unsigned j = 0; j < 16; ++j) { const unsigned c = xb_ld(&bar[XB_XCNT(j)]); sum += c; cnt += (c > 0u) ? 1u : 0u; mine = (j == x) ? c : mine; }
        if (sum == G) break;
        __builtin_amdgcn_s_sleep(1);
        if ((++sp & 255u) == 0u) { if (xb_ld(&bar[XB_TMO])) break; if (sp > XB_SPIN_CAP) { atomicAdd(&bar[XB_TMO], 1u); break; } }
    }
    nloc = mine > 0u ? mine : 1u; nx = cnt > 0u ? cnt : 1u;
}
__device__ __forceinline__ void xcd_barrier(const XcdBarrier& b) {
    asm volatile("s_waitcnt vmcnt(0)" ::: "memory");
    __syncthreads();
    if (threadIdx.x == 0) {
        unsigned* bar = b.bar;
        __builtin_amdgcn_s_waitcnt(0);
        unsigned nloc = b.st[0], nx = b.st[1];
        if (nloc == 0u) { xcd_barrier_complete(bar, b.x, nloc, nx); b.st[0] = nloc; b.st[1] = nx; }
        const unsigned old = xb_add(&bar[XB_XSUB(b.x)], 1u);
        const unsigned gen = old / nloc;
        if (old + 1u == (gen + 1u) * nloc) {
            __builtin_amdgcn_fence(__ATOMIC_RELEASE, "agent");
            asm volatile("s_waitcnt vmcnt(0)" ::: "memory");
            const unsigned og = xb_add(&bar[XB_TOP], 1u);
            const unsigned tg = og / nx;
            if (og + 1u == (tg + 1u) * nx) xb_add(&bar[XB_TOPGEN], 1u);
            else XB_SPIN(xb_ld(&bar[XB_TOPGEN]) == tg, bar);
            __builtin_amdgcn_fence(__ATOMIC_ACQUIRE, "agent");
            xb_add(&bar[XB_XGEN(b.x)], 1u);
            asm volatile("s_waitcnt vmcnt(0)" ::: "memory");
        } else {
            XB_SPIN(xb_ld(&bar[XB_XGEN(b.x)]) == gen, bar);
            __builtin_amdgcn_fence(__ATOMIC_ACQUIRE, "agent");
            asm volatile("s_waitcnt vmcnt(0)" ::: "memory");
        }
    }
    __syncthreads();
}

constexpr int RING_BYTES = 131072, LDSCTL_OFF = RING_BYTES, LDS_BYTES = 147456;
constexpr int CW_BAR = 4096;
constexpr int NPHASES = 35;

struct Args { const float* in[N_INPUTS]; float* out; unsigned char* ws; int ph_lo, ph_hi; };
static_assert(sizeof(Args) == N_INPUTS * 8 + 8 + 8 + 8, "Args has no padding");

__global__ void __launch_bounds__(512, 2) trunk_fwd(Args args) {
    extern __shared__ __attribute__((aligned(16))) unsigned char lds_raw[];
    LAS unsigned char* lds = (LAS unsigned char*)lds_raw;
    const int tid = threadIdx.x, wave = __builtin_amdgcn_readfirstlane(tid >> 6);
    const int G = gridDim.x, bx = blockIdx.x;
    const int vcu = (G % 8 == 0) ? (bx % 8) * (G / 8) + bx / 8 : bx;
    const int gw = vcu * 8 + wave, NGW = G * 8, NT = NGW * 64;
#define LANE_ ({ int t_ = threadIdx.x; asm volatile("" : "+v"(t_)); t_ & 63; })
#define GT_ (gw * 64 + LANE_)
    unsigned char* ws = args.ws;
    const int lo = args.ph_lo, hi = args.ph_hi;
    for (int u = tid; u < (LDS_BYTES - LDSCTL_OFF) / 4; u += 512) ((LAS unsigned*)(lds + LDSCTL_OFF))[u] = 0u;
    __syncthreads();
    XcdBarrier bar; bar.bar = (unsigned*)(ws + WS_CTL) + CW_BAR; bar.x = 0; bar.st = nullptr;
    if (hi - lo > 1) bar = xcd_barrier_post((unsigned*)(ws + WS_CTL) + CW_BAR, (volatile LAS unsigned*)(lds + LDSCTL_OFF + 64));

    float* PSUM = (float*)(ws + WS_PSUM); float* UPS = (float*)(ws + WS_UPS); float* PSMEM = (float*)(ws + WS_PSMEM); float* CB = (float*)(ws + WS_CB);
    bf16_t* XB = (bf16_t*)(ws + WS_XB); bf16_t* MEMB = (bf16_t*)(ws + WS_MEMB); bf16_t* MKV = (bf16_t*)(ws + WS_MKV); bf16_t* MK = (bf16_t*)(ws + WS_MK); bf16_t* MVT = (bf16_t*)(ws + WS_MVT);
    bf16_t* CAT = (bf16_t*)(ws + WS_CAT); bf16_t* HID = (bf16_t*)(ws + WS_HID); bf16_t* U = (bf16_t*)(ws + WS_U); bf16_t* QM = (bf16_t*)(ws + WS_QM); bf16_t* KVM = (bf16_t*)(ws + WS_KVM);
    bf16_t* KBUF = (bf16_t*)(ws + WS_KBUF); bf16_t* VTBUF = (bf16_t*)(ws + WS_VTBUF);
    float* OUT = args.out;

    int ph = 0;
#define PH_ON (lo <= ph && ph < hi)
#define PH_END do { if (lo <= ph && ph + 1 < hi) xcd_barrier(bar); ++ph; } while (0)
#define GEMM_PHASE(EPI_T, E_INIT, Aptr, Bptr, M_, N_, K_, LDA_) do { pg8::Gemm g_{(Aptr), (Bptr), (M_), (N_), (K_), (LDA_)}; pg8::StaticOrder S_; S_.init((M_), (N_), G, bx); \
        EPI_T E_ E_INIT; pg8::gemm_phase<EPI_T, pg8::StaticOrder, true>(lds, g_, S_, E_); } while (0)
#define COMMA ,

    if (PH_ON) {
        LAS float* scr = (LAS float*)(lds + wave * 8448);
        int it = gw, base = 0; const int lane_p0 = LANE_;
        for (int sg = 0; sg < NSEG; ++sg) {
            const Seg s = SEGS[sg];
            const int nbc = s.ncols / 32, n_it = (s.K / 64) * nbc;
            const float* W = args.in[s.in_idx] + s.src_off;
            bf16_t* WT = (bf16_t*)(ws + (size_t)s.dst_mib * MiB);
            const float* gain = s.gain_idx >= 0 ? args.in[s.gain_idx] + s.gain_off : nullptr;
            for (; it < base + n_it; it += NGW) {
                const int rr = it - base, kb = rr / nbc, nb = rr % nbc, n = 32 * nb;
                const int drow = s.drow0 + (s.inter ? (((n >> 7) << 8) + (n & 127)) : n);
                p0_item(W, s.K, s.Nsrc, s.col0 + n, WT, drow, gain, scr, 64 * kb, lane_p0);
            }
            base += n_it;
        }
        rowinit_items(args.in[I_X], XB, PSUM, MTOK, gw, NGW, LANE_);
        rowinit_items(args.in[I_MEM], MEMB, PSMEM, MMEM, gw, NGW, LANE_);
        { u32x4* z1 = (u32x4*)(ws + WS_WIN1 + (size_t)1600 * D_MODEL * 2); const int n1 = 192 * D_MODEL * 2 / 16; for (int i = GT_; i < n1; i += NT) z1[i] = (u32x4){0u, 0u, 0u, 0u};
          u32x4* z3 = (u32x4*)(ws + WS_WIN3 + (size_t)6688 * D_MODEL * 2); const int n3 = 224 * D_MODEL * 2 / 16; for (int i = GT_; i < n3; i += NT) z3[i] = (u32x4){0u, 0u, 0u, 0u}; }
    }
    PH_END;
    if (PH_ON) GEMM_PHASE(pg8::EpiScale<32 COMMA false>, {MKV COMMA 4096 COMMA PSMEM COMMA 32 COMMA 0 COMMA 1.0f / D_MODEL COMMA nullptr}, MEMB, (const bf16_t*)(ws + WS_WMKV), MMEM, 4096, D_MODEL, D_MODEL);
    PH_END;
    if (PH_ON) {
        for (int L = 0; L < 4; ++L) {
            headnorm_items<128>(MKV, 4096, L * 1024, 128, 4, args.in[I_MEM_KN] + L * 128, MK + (size_t)L * 16 * 256 * 128, 128, 0, MEM_LEN, MMEM, gw, NGW, LANE_);
            vtrans_items(MKV, 4096, L * 1024 + 512, 128, 4, 128, MVT + (size_t)L * 16 * 128 * 256, MEM_LEN, BATCH, lds + wave * 4352, gw, NGW, LANE_);
        }
    }
    PH_END;

#define FFN_PHASES(L, WHICH, BASEP) \
    if (PH_ON) GEMM_PHASE(pg8::EpiSwiGLU, {HID COMMA PSUM}, XB, (const bf16_t*)(ws + WS_WGU + (size_t)(2 * (L) + (WHICH)) * WGU_BYTES), MTOK, N_GU, D_MODEL, D_MODEL); \
    PH_END; \
    if (PH_ON) GEMM_PHASE(pg8::EpiResid, {(BASEP) COMMA OUT COMMA XB COMMA PSUM COMMA 0.5f}, HID, (const bf16_t*)(ws + WS_WD + (size_t)(2 * (L) + (WHICH)) * WD_BYTES), MTOK, D_MODEL, D_FF, D_FF); \
    PH_END;
#define OUT_PHASE(L) \
    if (PH_ON) GEMM_PHASE(pg8::EpiResid, {OUT COMMA OUT COMMA XB COMMA PSUM COMMA 1.0f}, CAT, (const bf16_t*)(ws + WS_WOUT + (size_t)(L) * WOUT_BYTES), MTOK, D_MODEL, K_OUT, K_OUT); \
    PH_END;
#define MEM_FA(L, UPITCH, MQCOL) do { FaArgs fa_; fa_.Q = U; fa_.q_pitch = (UPITCH); fa_.q_col0 = (MQCOL); fa_.q_hstride = 128; fa_.K = MK + (size_t)(L) * 16 * 256 * 128; fa_.Vt = MVT + (size_t)(L) * 16 * 128 * 256; \
        fa_.Skv = MEM_LEN; fa_.kv_group = 1; fa_.nheads = 4; fa_.O = CAT; fa_.o_pitch = K_OUT; fa_.o_col0 = 2048; fa_.qgain = args.in[I_MEM_QN] + (L) * 128; fa_.bias = nullptr; fa_.sinks = nullptr; \
        fa_.qscale = 0.08838834764831845f * LOG2E; \
        for (int i_ = bx; i_ < 16 * 8; i_ += G) fa_unit<128, 128, 3>(lds, fa_, (i_ >> 3) >> 2, (i_ >> 3) & 3, i_ & 7); } while (0)

    FFN_PHASES(0, 0, args.in[I_X])
    if (PH_ON) GEMM_PHASE(pg8::EpiScale<32 COMMA false>, {U COMMA NIN0 COMMA PSUM COMMA 32 COMMA 0 COMMA 1.0f / D_MODEL COMMA nullptr}, XB, (const bf16_t*)(ws + WS_WIN0), MTOK, NIN0, D_MODEL, D_MODEL);
    PH_END;
    if (PH_ON) { conv_items(U, args.in[I_CONV_W], CAT, GT_, NT); MEM_FA(0, NIN0, 6144); }
    PH_END;
    OUT_PHASE(0)
    FFN_PHASES(0, 1, OUT)

    FFN_PHASES(1, 0, OUT)
    if (PH_ON) GEMM_PHASE(pg8::EpiScale<32 COMMA true>, {U COMMA NIN1 COMMA PSUM COMMA 32 COMMA 0 COMMA 1.0f / D_MODEL COMMA UPS}, XB, (const bf16_t*)(ws + WS_WIN1), MTOK, NIN1, D_MODEL, D_MODEL);
    PH_END;
    if (PH_ON) {
        GEMM_PHASE(pg8::EpiScale<8 COMMA false>, {QM COMMA 3072 COMMA UPS COMMA 32 COMMA 0 COMMA 1.0f / 512.0f COMMA nullptr}, U, (const bf16_t*)(ws + WS_WQB), MTOK, 3072, 512, NIN1);
        GEMM_PHASE(pg8::EpiScale<8 COMMA false>, {KVM COMMA 4096 COMMA UPS COMMA 32 COMMA 8 COMMA 1.0f / 512.0f COMMA nullptr}, U + 512, (const bf16_t*)(ws + WS_WKVB), MTOK, 4096, 512, NIN1);
    }
    PH_END;
    if (PH_ON) {
        headnorm_items<128>(KVM, 4096, 0, 256, 16, args.in[I_MLA_KN], KBUF, 192, 0, SEQ, MTOK, gw, NGW, LANE_);
        mla_krope_items(U, NIN1, 1536, args.in[I_MLA_KN] + 128, KBUF, gw, NGW, LANE_);
        vtrans_items(KVM, 4096, 128, 256, 16, 128, VTBUF, SEQ, BATCH, lds + wave * 4352, gw, NGW, LANE_);
    }
    PH_END;
    if (PH_ON) {
        FaArgs fa; fa.Q = QM; fa.q_pitch = 3072; fa.q_col0 = 0; fa.q_hstride = 192; fa.K = KBUF; fa.Vt = VTBUF; fa.Skv = SEQ; fa.kv_group = 1; fa.nheads = 16;
        fa.O = CAT; fa.o_pitch = K_OUT; fa.o_col0 = 0; fa.qgain = args.in[I_MLA_QN]; fa.bias = nullptr; fa.sinks = nullptr; fa.qscale = 0.07216878364870323f * LOG2E;
        for (int j = bx; j < 64 * 4; j += G) { const int bh = j >> 2, q4 = j & 3; for (int k = 0; k < 2; ++k) fa_unit<192, 128, 0>(lds, fa, bh >> 4, bh & 15, k ? q4 : 7 - q4); }
        MEM_FA(1, NIN1, 1024);
    }
    PH_END;
    OUT_PHASE(1)
    FFN_PHASES(1, 1, OUT)

    FFN_PHASES(2, 0, OUT)
    if (PH_ON) GEMM_PHASE(pg8::EpiScale<32 COMMA false>, {U COMMA NIN2 COMMA PSUM COMMA 32 COMMA 0 COMMA 1.0f / D_MODEL COMMA nullptr}, XB, (const bf16_t*)(ws + WS_WIN2), MTOK, NIN2, D_MODEL, D_MODEL);
    PH_END;
    if (PH_ON) {
        headnorm_items<64>(U, NIN2, 2048, 64, 4, args.in[I_SWA_KN], KBUF, 64, 0, SEQ, MTOK, gw, NGW, LANE_);
        vtrans_items(U, NIN2, 2304, 64, 4, 64, VTBUF, SEQ, BATCH, lds + wave * 4352, gw, NGW, LANE_);
    }
    PH_END;
    if (PH_ON) {
        FaArgs fa; fa.Q = U; fa.q_pitch = NIN2; fa.q_col0 = 0; fa.q_hstride = 64; fa.K = KBUF; fa.Vt = VTBUF; fa.Skv = SEQ; fa.kv_group = 8; fa.nheads = 32;
        fa.O = CAT; fa.o_pitch = K_OUT; fa.o_col0 = 0; fa.qgain = args.in[I_SWA_QN]; fa.bias = args.in[I_REL_BIAS]; fa.sinks = args.in[I_SWA_SINKS]; fa.qscale = 0.125f * LOG2E;
        for (int i = bx; i < 128 * 8; i += G) { const int bh = i >> 3; fa_unit<64, 64, 1>(lds, fa, bh >> 5, bh & 31, i & 7); }
        MEM_FA(2, NIN2, 2560);
    }
    PH_END;
    OUT_PHASE(2)
    FFN_PHASES(2, 1, OUT)

    FFN_PHASES(3, 0, OUT)
    if (PH_ON) GEMM_PHASE(pg8::EpiScale<32 COMMA false>, {U COMMA NIN3 COMMA PSUM COMMA 32 COMMA 0 COMMA 1.0f / D_MODEL COMMA nullptr}, XB, (const bf16_t*)(ws + WS_WIN3), MTOK, NIN3, D_MODEL, D_MODEL);
    PH_END;
    if (PH_ON) {
        headnorm_items<64>(U, NIN3, 2048, 64, 32, args.in[I_FOX_KN], KBUF, 64, 0, SEQ, MTOK, gw, NGW, LANE_);
        vtrans_items(U, NIN3, 4096, 64, 32, 64, VTBUF, SEQ, BATCH, lds + wave * 4352, gw, NGW, LANE_);
        fox_scan_items(U, NIN3, 6656, args.in[I_FOX_BF], CB, gw, NGW, LANE_);
    }
    PH_END;
    if (PH_ON) {
        FaArgs fa; fa.Q = U; fa.q_pitch = NIN3; fa.q_col0 = 0; fa.q_hstride = 64; fa.K = KBUF; fa.Vt = VTBUF; fa.Skv = SEQ; fa.kv_group = 1; fa.nheads = 32;
        fa.O = CAT; fa.o_pitch = K_OUT; fa.o_col0 = 0; fa.qgain = args.in[I_FOX_QN]; fa.bias = CB; fa.sinks = nullptr; fa.qscale = 0.125f * LOG2E;
        for (int j = bx; j < 128 * 4; j += G) { const int bh = j >> 2, q4 = j & 3; for (int k = 0; k < 2; ++k) fa_unit<64, 64, 2>(lds, fa, bh >> 5, bh & 31, k ? q4 : 7 - q4); }
        MEM_FA(3, NIN3, 6144);
    }
    PH_END;
    OUT_PHASE(3)
    FFN_PHASES(3, 1, OUT)
}

extern "C" void kernel_launch(void* const* d_in, const int* in_sizes, int n_in, void* d_out, int out_size, void* d_ws, size_t ws_size, hipStream_t stream) {
    static int grid = 0;
    if (grid == 0) {
        if (n_in != N_INPUTS || out_size != MTOK * D_MODEL || ws_size < WS_END) { fprintf(stderr, "kernel_launch: unexpected problem: n_in %d out %d ws %zu (need %zu)\n", n_in, out_size, ws_size, (size_t)WS_END); grid = -1; return; }
        int dev = 0, cus = 0, per_cu = 0;
        if (hipGetDevice(&dev) != hipSuccess || hipDeviceGetAttribute(&cus, hipDeviceAttributeMultiprocessorCount, dev) != hipSuccess) { grid = -1; return; }
        if (hipFuncSetAttribute((const void*)trunk_fwd, hipFuncAttributeMaxDynamicSharedMemorySize, LDS_BYTES) != hipSuccess) { fprintf(stderr, "kernel_launch: hipFuncSetAttribute failed\n"); grid = -1; return; }
        if (hipOccupancyMaxActiveBlocksPerMultiprocessor(&per_cu, (const void*)trunk_fwd, 512, LDS_BYTES) != hipSuccess || per_cu < 1)
            fprintf(stderr, "kernel_launch: note: occupancy query reports %d workgroups per CU\n", per_cu);
        (void)hipGetLastError();
        grid = cus;
    }
    if (grid < 0) return;
    if (hipMemsetAsync((char*)d_ws + WS_CTL, 0, CTL_ZERO_BYTES, stream) != hipSuccess) { fprintf(stderr, "kernel_launch: memset failed\n"); return; }
    Args a{};
    for (int i = 0; i < N_INPUTS; ++i) a.in[i] = (const float*)d_in[i];
    a.out = (float*)d_out; a.ws = (unsigned char*)d_ws;
#if MK_ONE_LAUNCH
    a.ph_lo = 0; a.ph_hi = NPHASES;
    hipLaunchKernelGGL(trunk_fwd, dim3(grid), dim3(512), LDS_BYTES, stream, a);
#else
    for (int p = 0; p < NPHASES; ++p) { a.ph_lo = p; a.ph_hi = p + 1; hipLaunchKernelGGL(trunk_fwd, dim3(grid), dim3(512), LDS_BYTES, stream, a); }
#endif
    const hipError_t le = hipPeekAtLastError();
    if (le != hipSuccess) fprintf(stderr, "kernel_launch: launch failed: %s\n", hipGetErrorName(le));
}
```

```cpp
#include <hip/hip_runtime.h>
#include <cstdio>
#include <cstdint>

#ifndef MK_ONE_LAUNCH
#define MK_ONE_LAUNCH 1
#endif

#define LAS __attribute__((address_space(3)))
typedef unsigned short bf16_t;
typedef short bf16x8 __attribute__((ext_vector_type(8)));
typedef float f32x4 __attribute__((ext_vector_type(4)));
typedef float f32x16 __attribute__((ext_vector_type(16)));
typedef unsigned u32x4 __attribute__((ext_vector_type(4)));
typedef unsigned u32x2 __attribute__((ext_vector_type(2)));

constexpr int D_MODEL = 2048, BATCH = 4, SEQ = 2048, MTOK = BATCH * SEQ, D_FF = 5632, MEM_LEN = 256, MMEM = BATCH * MEM_LEN;
constexpr int N_GU = 2 * D_FF;
constexpr int NIN0 = 6656, NIN1 = 1792, NIN2 = 3072, NIN3 = 6912;
constexpr int K_OUT = 2560;
constexpr float RMS_EPS = 1e-6f;
constexpr float LOG2E = 1.4426950408889634f;

constexpr size_t MiB = 1u << 20;
constexpr size_t WS_CTL = 0, CTL_ZERO_BYTES = 1 * MiB;
constexpr size_t WS_PSUM = 1 * MiB, WS_UPS = 2 * MiB, WS_PSMEM = 3 * MiB, WS_CB = 4 * MiB;
constexpr size_t WS_XB = 8 * MiB, WS_MEMB = 40 * MiB, WS_MKV = 44 * MiB, WS_MK = 52 * MiB, WS_MVT = 56 * MiB;
constexpr size_t WS_CAT = 60 * MiB, WS_HID = 100 * MiB, WS_U = 188 * MiB, WS_QM = 296 * MiB, WS_KVM = 344 * MiB;
constexpr size_t WS_KBUF = 408 * MiB, WS_VTBUF = 456 * MiB;
constexpr size_t WS_WGU = 488 * MiB;
constexpr size_t WS_WD = 840 * MiB;
constexpr size_t WS_WIN0 = 1016 * MiB, WS_WIN1 = 1042 * MiB, WS_WIN2 = 1049 * MiB, WS_WIN3 = 1061 * MiB;
constexpr size_t WS_WOUT = 1088 * MiB;
constexpr size_t WS_WQB = 1128 * MiB, WS_WKVB = 1131 * MiB, WS_WMKV = 1135 * MiB, WS_END = 1151 * MiB;
constexpr size_t WGU_BYTES = (size_t)N_GU * D_MODEL * 2, WD_BYTES = (size_t)D_MODEL * D_FF * 2, WOUT_BYTES = (size_t)D_MODEL * K_OUT * 2;
static_assert(WGU_BYTES == 44 * MiB && WD_BYTES == 22 * MiB && WOUT_BYTES == 10 * MiB, "weight sizes");

enum { I_X = 0, I_MEM, I_NORM_FFN1, I_F1G, I_F1U, I_F1D, I_NORM_MIX, I_NORM_FFN2, I_F2G, I_F2U, I_F2D, I_NORM_MEM, I_MEM_WKV, I_MEM_QN, I_MEM_KN,
       I_CONV_WIN, I_CONV_W, I_CONV_WOUT, I_MLA_WIN, I_MLA_QAN, I_MLA_WQB, I_MLA_KVAN, I_MLA_WKVB, I_MLA_QN, I_MLA_KN, I_MLA_WOUT,
       I_SWA_WIN, I_SWA_QN, I_SWA_KN, I_SWA_SINKS, I_SWA_WOUT, I_REL_BIAS, I_FOX_WIN, I_FOX_BF, I_FOX_QN, I_FOX_KN, I_FOX_WOUT, N_INPUTS };

__device__ __forceinline__ unsigned pk2(float lo, float hi) {
    typedef __bf16 b2 __attribute__((ext_vector_type(2))); typedef float f2 __attribute__((ext_vector_type(2)));
    return __builtin_bit_cast(unsigned, __builtin_convertvector((f2){lo, hi}, b2)); }
__device__ __forceinline__ float bf_lo(unsigned w) { return __uint_as_float(w << 16); }
__device__ __forceinline__ float bf_hi(unsigned w) { return __uint_as_float(w & 0xffff0000u); }
__device__ __forceinline__ void unpack8(const u32x4 v, float (&f)[8]) {
    f[0] = bf_lo(v.x); f[1] = bf_hi(v.x); f[2] = bf_lo(v.y); f[3] = bf_hi(v.y); f[4] = bf_lo(v.z); f[5] = bf_hi(v.z); f[6] = bf_lo(v.w); f[7] = bf_hi(v.w); }
__device__ __forceinline__ u32x4 pack8(const float (&f)[8]) { u32x4 o; o.x = pk2(f[0], f[1]); o.y = pk2(f[2], f[3]); o.z = pk2(f[4], f[5]); o.w = pk2(f[6], f[7]); return o; }
#define GAS __attribute__((address_space(1)))
__device__ __forceinline__ const GAS char* uni_ptr(const char* p) {
    const unsigned long long v = (unsigned long long)p; const unsigned lo = __builtin_amdgcn_readfirstlane((unsigned)v), hi = __builtin_amdgcn_readfirstlane((unsigned)(v >> 32));
    return (const GAS char*)(((unsigned long long)hi << 32) | lo); }
__device__ __forceinline__ float rope_invf_turns(int i) {
    return __builtin_amdgcn_exp2f(-(float)i * (13.287712379549449f / 32.0f)) * 0.15915494309189535f; }
__device__ __forceinline__ void rope_cs(int pos, int i, float& c, float& s) {
    float t = (float)pos * rope_invf_turns(i); t = t - floorf(t); c = __builtin_amdgcn_cosf(t); s = __builtin_amdgcn_sinf(t); }

namespace pg8 {
constexpr int BM = 256, BK = 64, HALF = 128, HTB = HALF * BK * 2, STAGE_BYTES = 8 * HTB, NXCD = 8, WGM = 8;
__host__ __device__ __forceinline__ int lds_byte(int r, int c) { const int st = (r >> 4) * 2 + (c >> 5), rr = r & 15, cc = c & 31, ob = rr * 64 + cc * 2; return st * 1024 + (ob ^ (((ob >> 9) & 1) << 5)); }
__host__ __device__ __forceinline__ void stage_rc(int b, int& R, int& C) { const int st = b / 1024, sb = b % 1024, swz = sb ^ (((sb >> 9) & 1) << 5); R = (st >> 1) * 16 + swz / 64; C = (st & 1) * 32 + (swz % 64) / 2; }
__host__ __device__ __forceinline__ int perm32(int rho) { const int n = rho >> 4, i = rho & 15; return 8 * (i >> 2) + 4 * n + (i & 3); }
struct Unit { int pm, pn; };
struct Gemm { const bf16_t* A; const bf16_t* Bt; int M, N, K, lda; };
struct StaticOrder {
    int nM, nN, nwg, G, c;
    __host__ __device__ void init(int M, int N, int G_, int c_) { nM = M / BM; nN = N / BM; nwg = nM * nN; G = G_; c = c_; }
    __host__ __device__ bool next(int i, Unit& u) const {
        const long L = (long)i * G + c; if (L >= nwg) return false;
        int wgid = (int)L; { const int q = nwg / NXCD, r = nwg % NXCD, xcd = wgid % NXCD, off = wgid / NXCD; wgid = (xcd < r ? xcd * (q + 1) : r * (q + 1) + (xcd - r) * q) + off; }
        const int nig = WGM * nN, gid = wgid / nig, fm = gid * WGM, gsz = (nM - fm) < WGM ? (nM - fm) : WGM;
        u.pm = fm + ((wgid % nig) % gsz); u.pn = (wgid % nig) / gsz; return true;
    }
    __device__ __forceinline__ void a_ready(const Unit&) const {}
    __device__ __forceinline__ void done(const Unit&) const {}
};

template <int CNT>
__device__ __forceinline__ void rows_rstd(const float* ps, int pitch, int off, int row0, int fq, float inv_dim, float (&rs)[2][4]) {
    float t[2][4];
#pragma unroll
    for (int ai = 0; ai < 2; ++ai)
#pragma unroll
        for (int m = 0; m < 4; ++m) { const float* p = ps + (size_t)(row0 + ai * HALF + m * 16) * pitch + off + fq * (CNT / 4); float s = 0.f;
#pragma unroll
            for (int i = 0; i < CNT / 4; ++i) s += p[i];
            t[ai][m] = s; }
#pragma unroll
    for (int ai = 0; ai < 2; ++ai)
#pragma unroll
        for (int m = 0; m < 4; ++m) { float s = t[ai][m]; s += __shfl_xor(s, 16); s += __shfl_xor(s, 32); rs[ai][m] = 1.0f / sqrtf(s * inv_dim + RMS_EPS); }
}
__device__ __forceinline__ float silu_mul(float g, float u) { return g * __builtin_amdgcn_rcpf(1.0f + __builtin_amdgcn_exp2f(-g * LOG2E)) * u; }

struct EpiSwiGLU {
    static constexpr bool PERM = true, AFTER_DRAIN = false;
    bf16_t* H; const float* ps;
    __device__ __forceinline__ void operator()(const f32x4 (&acc)[2][2][4][2], const Unit& u, int wr, int wc, int fr, int fq) const {
        const int row0 = u.pm * BM + wr * 64 + fr, col0 = u.pn * 128 + wc * 32 + 8 * fq;
        float rs[2][4]; rows_rstd<32>(ps, 32, 0, row0, fq, 1.0f / D_MODEL, rs);
#pragma unroll
        for (int ai = 0; ai < 2; ++ai)
#pragma unroll
            for (int m = 0; m < 4; ++m) {
                const int row = row0 + ai * HALF + m * 16;
                const float r = rs[ai][m];
                const f32x4 g0 = acc[ai][0][m][0] * r, g1 = acc[ai][0][m][1] * r, u0 = acc[ai][1][m][0] * r, u1 = acc[ai][1][m][1] * r;
                u32x4 w;
                w.x = pk2(silu_mul(g0[0], u0[0]), silu_mul(g0[1], u0[1])); w.y = pk2(silu_mul(g0[2], u0[2]), silu_mul(g0[3], u0[3]));
                w.z = pk2(silu_mul(g1[0], u1[0]), silu_mul(g1[1], u1[1])); w.w = pk2(silu_mul(g1[2], u1[2]), silu_mul(g1[3], u1[3]));
                *(u32x4*)(H + (size_t)row * D_FF + col0) = w;
            }
    }
};
struct EpiResid {
    static constexpr bool PERM = false, AFTER_DRAIN = false;
    const float* base; float* out; bf16_t* xb; float* ps; float alpha;
    __device__ __forceinline__ void operator()(const f32x4 (&acc)[2][2][4][2], const Unit& u, int wr, int wc, int fr, int fq) const {
        const int row0 = u.pm * BM + wr * 64 + fr, col0 = u.pn * BM + wc * 32 + 4 * fq;
#pragma unroll
        for (int ai = 0; ai < 2; ++ai) {
            f32x4 bv[4][2][2];
#pragma unroll
            for (int m = 0; m < 4; ++m)
#pragma unroll
                for (int bj = 0; bj < 2; ++bj)
#pragma unroll
                    for (int n = 0; n < 2; ++n) bv[m][bj][n] = *(const f32x4*)(base + (size_t)(row0 + ai * HALF + m * 16) * D_MODEL + col0 + bj * HALF + n * 16);
#pragma unroll
            for (int m = 0; m < 4; ++m) {
                const int row = row0 + ai * HALF + m * 16; const size_t off = (size_t)row * D_MODEL + col0;
                float ss = 0.f;
#pragma unroll
                for (int bj = 0; bj < 2; ++bj)
#pragma unroll
                    for (int n = 0; n < 2; ++n) {
                        const f32x4 v = bv[m][bj][n] + acc[ai][bj][m][n] * alpha;
                        *(f32x4*)(out + off + bj * HALF + n * 16) = v;
                        u32x2 w; w.x = pk2(v[0], v[1]); w.y = pk2(v[2], v[3]);
                        *(u32x2*)(xb + off + bj * HALF + n * 16) = w;
                        ss += (v[0] * v[0] + v[1] * v[1]) + (v[2] * v[2] + v[3] * v[3]);
                    }
                ss += __shfl_xor(ss, 16); ss += __shfl_xor(ss, 32);
                if (fq == 0) ps[(size_t)row * 32 + u.pn * 4 + wc] = ss;
            }
        }
    }
};
template <int CNT, bool WPS> struct EpiScale {
    static constexpr bool PERM = true, AFTER_DRAIN = false;
    bf16_t* O; int ldo; const float* ps; int ps_pitch, ps_off; float inv_dim; float* ops;
    __device__ __forceinline__ void operator()(const f32x4 (&acc)[2][2][4][2], const Unit& u, int wr, int wc, int fr, int fq) const {
        const int row0 = u.pm * BM + wr * 64 + fr, col0 = u.pn * BM + wc * 32 + 8 * fq;
        float rs[2][4]; rows_rstd<CNT>(ps, ps_pitch, ps_off, row0, fq, inv_dim, rs);
#pragma unroll
        for (int ai = 0; ai < 2; ++ai)
#pragma unroll
            for (int m = 0; m < 4; ++m) {
                const int row = row0 + ai * HALF + m * 16;
                const float r = rs[ai][m];
                float ss = 0.f;
#pragma unroll
                for (int bj = 0; bj < 2; ++bj) {
                    const f32x4 v0 = acc[ai][bj][m][0] * r, v1 = acc[ai][bj][m][1] * r;
                    if (WPS) ss += (v0[0] * v0[0] + v0[1] * v0[1]) + (v0[2] * v0[2] + v0[3] * v0[3]) + (v1[0] * v1[0] + v1[1] * v1[1]) + (v1[2] * v1[2] + v1[3] * v1[3]);
                    u32x4 w; w.x = pk2(v0[0], v0[1]); w.y = pk2(v0[2], v0[3]); w.z = pk2(v1[0], v1[1]); w.w = pk2(v1[2], v1[3]);
                    *(u32x4*)(O + (size_t)row * ldo + col0 + bj * HALF) = w;
                }
                if (WPS) { ss += __shfl_xor(ss, 16); ss += __shfl_xor(ss, 32); if (fq == 0) ops[(size_t)row * 32 + u.pn * 4 + wc] = ss; }
            }
    }
};

template <class Epi, class Sched, bool ALIGN_EPI = true>
__device__ __forceinline__ void gemm_phase(LAS unsigned char* lds, const Gemm g, const Sched& S, const Epi& E) {
    int tid = threadIdx.x; asm volatile("" : "+v"(tid));
    const int wid = __builtin_amdgcn_readfirstlane(tid >> 6), lane = tid & 63, wr = wid >> 2, wc = wid & 3, fr = lane & 15, fq = lane >> 4;
    const int K = g.K, nt = K / BK, lda = g.lda;
    unsigned voffA[2], voffB[2];
#pragma unroll
    for (int i = 0; i < 2; ++i) { int R, C; stage_rc(tid * 16 + i * 8192, R, C); const int Rb = Epi::PERM ? ((R & ~31) + perm32(R & 31)) : R;
        voffA[i] = (unsigned)(R * lda + C) * 2u; voffB[i] = (unsigned)(Rb * K + C) * 2u; }
    const size_t kstep = (size_t)(BK * 2);
    const size_t hstepA = (size_t)HALF * lda * 2, hstepB = (size_t)HALF * K * 2;
    const size_t tstepA = 2 * hstepA, tstepB = 2 * hstepB;
    const unsigned ldsw = (unsigned)wid * 1024u;
    const int aoff = lds_byte(wr * 64 + fr, fq * 8), boff = lds_byte(wc * 32 + fr, fq * 8);
#define PG8_SA(b, h) (((b) * 2 + (h)) * HTB)
#define PG8_SB(b, h) ((4 + (b) * 2 + (h)) * HTB)
#define PG8_STAGE(bufoff, gbase, voff) do { _Pragma("unroll") for (int _i = 0; _i < 2; ++_i) \
        __builtin_amdgcn_global_load_lds((const unsigned*)((const char*)(gbase) + (voff)[_i]), (LAS unsigned*)(lds + (bufoff) + ldsw + _i * 8192), 16, 0, 0); } while (0)
#define PG8_LDA(dst, b, h) do { _Pragma("unroll") for (int m = 0; m < 4; ++m) _Pragma("unroll") for (int k = 0; k < 2; ++k) dst[m][k] = *(const LAS bf16x8*)(lds + PG8_SA(b, h) + aoff + m * 2048 + k * 1024); } while (0)
#define PG8_LDB(dst, b, h) do { _Pragma("unroll") for (int n = 0; n < 2; ++n) _Pragma("unroll") for (int k = 0; k < 2; ++k) dst[n][k] = *(const LAS bf16x8*)(lds + PG8_SB(b, h) + boff + n * 2048 + k * 1024); } while (0)
#define PG8_MMA(ai, bj, At, Bt) do { __builtin_amdgcn_s_setprio(1); _Pragma("unroll") for (int m = 0; m < 4; ++m) _Pragma("unroll") for (int n = 0; n < 2; ++n) _Pragma("unroll") for (int k = 0; k < 2; ++k) \
        acc[ai][bj][m][n] = __builtin_amdgcn_mfma_f32_16x16x32_bf16(Bt[n][k], At[m][k], acc[ai][bj][m][n], 0, 0, 0); __builtin_amdgcn_s_setprio(0); } while (0)
#define PG8_WAIT_V(n) asm volatile("s_waitcnt vmcnt(" #n ")" ::: "memory")
#define PG8_WAIT_L(n) asm volatile("s_waitcnt lgkmcnt(" #n ")" ::: "memory")
#define PG8_BAR __builtin_amdgcn_s_barrier()
#define PG8_SCHED __builtin_amdgcn_sched_barrier(0)
    Unit cur, nxt; int ui = 0;
    if (!S.next(0, cur)) return;
    f32x4 acc[2][2][4][2];
#pragma unroll
    for (int a = 0; a < 2; ++a)
#pragma unroll
        for (int b = 0; b < 2; ++b)
#pragma unroll
            for (int m = 0; m < 4; ++m)
#pragma unroll
                for (int n = 0; n < 2; ++n) acc[a][b][m][n] = (f32x4){0.f, 0.f, 0.f, 0.f};
    bf16x8 At[4][2], B0[2][2], B1[2][2];
    const char* cA = (const char*)g.A + (size_t)cur.pm * tstepA; const char* cB = (const char*)g.Bt + (size_t)cur.pn * tstepB;
    S.a_ready(cur);
    PG8_STAGE(PG8_SB(0, 0), cB, voffB); PG8_STAGE(PG8_SB(0, 1), cB + hstepB, voffB); PG8_STAGE(PG8_SA(0, 0), cA, voffA); PG8_STAGE(PG8_SA(0, 1), cA + hstepA, voffA);
    if (wr == 1) PG8_BAR;
    PG8_WAIT_V(2); PG8_BAR;
    PG8_STAGE(PG8_SB(1, 0), cB + kstep, voffB); PG8_STAGE(PG8_SA(1, 0), cA + kstep, voffA); PG8_STAGE(PG8_SB(1, 1), cB + hstepB + kstep, voffB);
    PG8_WAIT_V(6); PG8_BAR;
    for (;;) {
        const bool has_next = S.next(ui + 1, nxt);
        const char* nA = has_next ? (const char*)g.A + (size_t)nxt.pm * tstepA : cA; const char* nB = has_next ? (const char*)g.Bt + (size_t)nxt.pn * tstepB : cB;
        for (int t = 0; t < nt; t += 2) {
            const bool last = (t == nt - 2);
            const char* a1 = cA + (size_t)(t + 1) * kstep;
            const char* a2 = last ? nA : cA + (size_t)(t + 2) * kstep; const char* b2 = last ? nB : cB + (size_t)(t + 2) * kstep;
            const char* a3 = a2 + kstep; const char* b3 = b2 + kstep;
            if (last && has_next) S.a_ready(nxt);
            PG8_LDB(B0, 0, 0); PG8_LDB(B1, 0, 1); PG8_SCHED; PG8_LDA(At, 0, 0); PG8_STAGE(PG8_SA(1, 1), a1 + hstepA, voffA);
            PG8_WAIT_V(8); PG8_WAIT_L(0); PG8_BAR; PG8_MMA(0, 0, At, B0); PG8_MMA(0, 1, At, B1); PG8_BAR; PG8_SCHED;
            PG8_LDA(At, 0, 1); PG8_STAGE(PG8_SB(0, 0), b2, voffB); PG8_STAGE(PG8_SB(0, 1), b2 + hstepB, voffB); PG8_STAGE(PG8_SA(0, 0), a2, voffA);
            PG8_WAIT_V(8); PG8_WAIT_L(0); PG8_BAR; PG8_MMA(1, 0, At, B0); PG8_MMA(1, 1, At, B1); PG8_BAR; PG8_SCHED;
            PG8_LDB(B0, 1, 0); PG8_LDB(B1, 1, 1); PG8_SCHED; PG8_LDA(At, 1, 0); PG8_STAGE(PG8_SA(0, 1), a2 + hstepA, voffA);
            PG8_WAIT_V(8); PG8_WAIT_L(0); PG8_BAR; PG8_MMA(0, 0, At, B0); PG8_MMA(0, 1, At, B1); PG8_BAR; PG8_SCHED;
            PG8_LDA(At, 1, 1); PG8_STAGE(PG8_SB(1, 0), b3, voffB); PG8_STAGE(PG8_SB(1, 1), b3 + hstepB, voffB); PG8_STAGE(PG8_SA(1, 0), a3, voffA);
            PG8_WAIT_V(8); PG8_WAIT_L(0); PG8_BAR; PG8_MMA(1, 0, At, B0); PG8_MMA(1, 1, At, B1); PG8_BAR; PG8_SCHED;
        }
        if constexpr (ALIGN_EPI) { if (wr == 0) PG8_BAR; }
        E(acc, cur, wr, wc, fr, fq); S.done(cur);
        if (!has_next) break;
#pragma unroll
        for (int a = 0; a < 2; ++a)
#pragma unroll
            for (int b = 0; b < 2; ++b)
#pragma unroll
                for (int m = 0; m < 4; ++m)
#pragma unroll
                    for (int n = 0; n < 2; ++n) acc[a][b][m][n] = (f32x4){0.f, 0.f, 0.f, 0.f};
        cur = nxt; cA = nA; cB = nB; ++ui;
        if constexpr (ALIGN_EPI) { if (wr == 1) PG8_BAR; }
    }
    PG8_WAIT_V(0);
    if constexpr (!ALIGN_EPI) { if (wr == 0) PG8_BAR; }
    PG8_BAR;
#undef PG8_SA
#undef PG8_SB
#undef PG8_STAGE
#undef PG8_LDA
#undef PG8_LDB
#undef PG8_MMA
#undef PG8_WAIT_V
#undef PG8_WAIT_L
#undef PG8_BAR
#undef PG8_SCHED
}
}

struct FaArgs {
    const bf16_t* Q; int q_pitch, q_col0, q_hstride;
    const bf16_t* K; const bf16_t* Vt; int Skv, kv_group, nheads;
    bf16_t* O; int o_pitch, o_col0;
    const float* qgain; const float* bias; const float* sinks; float qscale;
};
__device__ const unsigned char T5_BUCKET[128] = {
    0, 1, 2, 3, 4, 5, 6, 7, 8, 9, 10, 11, 12, 13, 14, 15, 16, 16, 16, 17, 17, 18, 18, 18, 19, 19, 19, 20, 20, 20, 20, 21, 21, 21, 21, 22, 22, 22, 22, 22, 23, 23, 23, 23, 23, 23,
    24, 24, 24, 24, 24, 24, 25, 25, 25, 25, 25, 25, 25, 26, 26, 26, 26, 26, 26, 26, 26, 27, 27, 27, 27, 27, 27, 27, 27, 27, 27, 28, 28, 28, 28, 28, 28, 28, 28, 28, 28,
    29, 29, 29, 29, 29, 29, 29, 29, 29, 29, 29, 29, 30, 30, 30, 30, 30, 30, 30, 30, 30, 30, 30, 30, 30, 30, 31, 31, 31, 31, 31, 31, 31, 31, 31, 31, 31, 31, 31, 31, 31};

template <int DQK, int DV, int MODE>
__device__ __forceinline__ void fa_unit(LAS unsigned char* lds, const FaArgs& A, const int b, const int h, const int qb) {
    constexpr int NKS = DQK / 16, NDB = DV / 32, KP = DQK + 8, VP = 68;
    constexpr int KBYTES = 64 * KP * 2, VBYTES = DV * VP * 2;
    constexpr int OFF_K = 0, OFF_V = 2 * KBYTES, OFF_B = OFF_V + 2 * VBYTES, OFF_TAB = OFF_B + 512;
    static_assert(OFF_TAB + 512 <= 131072, "FA LDS");
    constexpr int KCH = DQK / 8, KPT = 64 * KCH / 512, VPT = DV * 8 / 512;
    static_assert(KPT * 512 == 64 * KCH && VPT * 512 == DV * 8, "FA staging");
    int tid = threadIdx.x; asm volatile("" : "+v"(tid));
    const int lane = tid & 63, w = __builtin_amdgcn_readfirstlane(tid >> 6), r = lane & 31, hh = lane >> 5;
    const int q0 = qb * 256, qw0 = q0 + w * 32, qpos = qw0 + r;
    const int bhk = (MODE == 1) ? b * (A.nheads / A.kv_group) + h / A.kv_group : b * A.nheads + h;

    bf16x8 Qf[NKS];
    {
        int opq = 0; asm volatile("" : "+v"(opq));
        const bf16_t* Qp = A.Q + (size_t)(b * SEQ + qpos) * A.q_pitch + A.q_col0 + h * A.q_hstride + 8 * hh;
        float qf[NKS][8];
#pragma unroll
        for (int ks = 0; ks < NKS; ++ks) { const u32x4 v = *(const u32x4*)(Qp + 16 * ks); unpack8(v, qf[ks]); }
        if constexpr (MODE == 0) {
            float sn = 0.f, sr = 0.f;
#pragma unroll
            for (int ks = 0; ks < 8; ++ks)
#pragma unroll
                for (int j = 0; j < 8; ++j) sn += qf[ks][j] * qf[ks][j];
#pragma unroll
            for (int ks = 8; ks < 12; ++ks)
#pragma unroll
                for (int j = 0; j < 8; ++j) sr += qf[ks][j] * qf[ks][j];
            sn += __shfl_xor(sn, 32); sr += __shfl_xor(sr, 32);
            const float rn = 1.0f / sqrtf(sn * (1.0f / 128.0f) + RMS_EPS), rr = 1.0f / sqrtf(sr * (1.0f / 64.0f) + RMS_EPS);
#pragma unroll
            for (int ks = 0; ks < 8; ++ks) {
                const f32x4 g0 = *(const f32x4*)(A.qgain + 16 * ks + 8 * hh), g1 = *(const f32x4*)(A.qgain + 16 * ks + 8 * hh + 4);
#pragma unroll
                for (int j = 0; j < 4; ++j) { qf[ks][j] *= rn * g0[j] * A.qscale; qf[ks][4 + j] *= rn * g1[j] * A.qscale; }
            }
#pragma unroll
            for (int ks = 8; ks < 10; ++ks) {
                const int i0 = 16 * (ks - 8) + 8 * hh;
                const f32x4 ga0 = *(const f32x4*)(A.qgain + 128 + i0), ga1 = *(const f32x4*)(A.qgain + 128 + i0 + 4);
                const f32x4 gb0 = *(const f32x4*)(A.qgain + 160 + i0), gb1 = *(const f32x4*)(A.qgain + 160 + i0 + 4);
#pragma unroll
                for (int j = 0; j < 8; ++j) {
                    const float ga = j < 4 ? ga0[j & 3] : ga1[j & 3], gb = j < 4 ? gb0[j & 3] : gb1[j & 3];
                    const float t1 = qf[ks][j] * rr * ga, t2 = qf[ks + 2][j] * rr * gb;
                    float c, s; rope_cs(qpos, i0 + j + opq, c, s);
                    qf[ks][j] = (t1 * c - t2 * s) * A.qscale; qf[ks + 2][j] = (t1 * s + t2 * c) * A.qscale;
                }
            }
        } else {
            float ss = 0.f;
#pragma unroll
            for (int ks = 0; ks < NKS; ++ks)
#pragma unroll
                for (int j = 0; j < 8; ++j) ss += qf[ks][j] * qf[ks][j];
            ss += __shfl_xor(ss, 32);
            const float rs = 1.0f / sqrtf(ss * (1.0f / DQK) + RMS_EPS) * A.qscale;
#pragma unroll
            for (int ks = 0; ks < NKS; ++ks) {
                const f32x4 g0 = *(const f32x4*)(A.qgain + 16 * ks + 8 * hh), g1 = *(const f32x4*)(A.qgain + 16 * ks + 8 * hh + 4);
#pragma unroll
                for (int j = 0; j < 4; ++j) { qf[ks][j] *= rs * g0[j]; qf[ks][4 + j] *= rs * g1[j]; }
            }
        }
#pragma unroll
        for (int ks = 0; ks < NKS; ++ks) Qf[ks] = __builtin_bit_cast(bf16x8, pack8(qf[ks]));
    }
    if constexpr (MODE == 1) { if (tid < 128) *(LAS float*)(lds + OFF_TAB + 4 * tid) = A.bias[(int)T5_BUCKET[tid] * 32 + h] * LOG2E; }

    int t_lo = 0, t_hi;
    if constexpr (MODE == 3) t_hi = A.Skv / 64; else t_hi = 4 * qb + 4;
    if constexpr (MODE == 1) { const int lowk = q0 - 127; t_lo = lowk > 0 ? lowk / 64 : 0; }
    const int nt = t_hi - t_lo;
    const bf16_t* Kg = A.K + (size_t)bhk * A.Skv * DQK;
    const bf16_t* Vg = A.Vt + (size_t)bhk * DV * A.Skv;
    const float* Bg = (MODE == 2) ? A.bias + (size_t)(b * A.nheads + h) * SEQ : nullptr;
    u32x4 kst[KPT], vst[VPT]; f32x4 bst = (f32x4){0.f, 0.f, 0.f, 0.f};
    unsigned koff[KPT], voff[VPT];
#pragma unroll
    for (int i = 0; i < KPT; ++i) { const int c = tid + 512 * i, row = c / KCH, cc = c % KCH; koff[i] = (unsigned)(row * DQK + cc * 8) * 2u; }
#pragma unroll
    for (int i = 0; i < VPT; ++i) { const int c = tid + 512 * i, d = c >> 3, cc = c & 7; voff[i] = (unsigned)(d * A.Skv + cc * 8) * 2u; }
#define FA_LOAD(t) do { const GAS char* _kt = uni_ptr((const char*)Kg + (size_t)(64 * (t)) * DQK * 2); const GAS char* _vt = uni_ptr((const char*)Vg + (size_t)(64 * (t)) * 2); \
        _Pragma("unroll") for (int _i = 0; _i < KPT; ++_i) kst[_i] = *(const GAS u32x4*)(_kt + koff[_i]); \
        _Pragma("unroll") for (int _i = 0; _i < VPT; ++_i) vst[_i] = *(const GAS u32x4*)(_vt + voff[_i]); \
        if (MODE == 2) { if (tid < 16) bst = *(const f32x4*)(Bg + 64 * (t) + 4 * tid); } } while (0)
#define FA_WRITE(buf) do { \
        _Pragma("unroll") for (int _i = 0; _i < KPT; ++_i) { const int _c = tid + 512 * _i, _row = _c / KCH, _cc = _c % KCH; *(LAS u32x4*)(lds + OFF_K + (buf) * KBYTES + (_row * KP + _cc * 8) * 2) = kst[_i]; } \
        _Pragma("unroll") for (int _i = 0; _i < VPT; ++_i) { const int _c = tid + 512 * _i, _d = _c >> 3, _cc = _c & 7; LAS unsigned char* _p = lds + OFF_V + (buf) * VBYTES + (_d * VP + _cc * 8) * 2; \
            *(LAS u32x2*)_p = (u32x2){vst[_i].x, vst[_i].y}; *(LAS u32x2*)(_p + 8) = (u32x2){vst[_i].z, vst[_i].w}; } \
        if (MODE == 2) { if (tid < 16) *(LAS f32x4*)(lds + OFF_B + (buf) * 256 + 16 * tid) = bst; } } while (0)

    f32x16 O[NDB];
#pragma unroll
    for (int db = 0; db < NDB; ++db)
#pragma unroll
        for (int i = 0; i < 16; ++i) O[db][i] = 0.f;
    float m_run = -1e30f, l_run = 0.f;
    FA_LOAD(t_lo);
    for (int it = 0; it < nt; ++it) {
        const int t = t_lo + it, buf = it & 1;
        FA_WRITE(buf);
        __syncthreads();
        if (it + 1 < nt) FA_LOAD(t + 1);
#pragma unroll
        for (int sub = 0; sub < 2; ++sub) {
            const int ks0 = 64 * t + 32 * sub;
            bool active = true;
            if constexpr (MODE == 0 || MODE == 2) active = (ks0 <= qw0 + 31);
            if constexpr (MODE == 1) active = (ks0 <= qw0 + 31) && (ks0 + 31 >= qw0 - 127);
            if (!active) continue;
            f32x16 s;
            if constexpr (MODE == 2) {
#pragma unroll
                for (int g = 0; g < 4; ++g) { const f32x4 bb = *(const LAS f32x4*)(lds + OFF_B + buf * 256 + (32 * sub + 8 * g + 4 * hh) * 4); s[4 * g] = bb[0]; s[4 * g + 1] = bb[1]; s[4 * g + 2] = bb[2]; s[4 * g + 3] = bb[3]; }
            } else if constexpr (MODE == 1) {
#pragma unroll
                for (int i = 0; i < 16; ++i) { int dist = qpos - (ks0 + (i & 3) + 8 * (i >> 2) + 4 * hh); dist = dist < 0 ? 0 : (dist > 127 ? 127 : dist); s[i] = *(const LAS float*)(lds + OFF_TAB + 4 * dist); }
            } else {
#pragma unroll
                for (int i = 0; i < 16; ++i) s[i] = 0.f;
            }
#pragma unroll
            for (int ks = 0; ks < NKS; ++ks) {
                const bf16x8 a = *(const LAS bf16x8*)(lds + OFF_K + buf * KBYTES + ((32 * sub + r) * KP + 16 * ks + 8 * hh) * 2);
                s = __builtin_amdgcn_mfma_f32_32x32x16_bf16(a, Qf[ks], s, 0, 0, 0);
            }
            if constexpr (MODE == 0 || MODE == 2) {
                if (ks0 + 31 > qw0) {
#pragma unroll
                    for (int i = 0; i < 16; ++i) { const int key = ks0 + (i & 3) + 8 * (i >> 2) + 4 * hh; if (key > qpos) s[i] = -__builtin_inff(); }
                }
            }
            if constexpr (MODE == 1) {
#pragma unroll
                for (int i = 0; i < 16; ++i) { const int key = ks0 + (i & 3) + 8 * (i >> 2) + 4 * hh; if ((unsigned)(qpos - key) >= 128u) s[i] = -__builtin_inff(); }
            }
            float mx = s[0];
#pragma unroll
            for (int i = 1; i < 16; ++i) mx = fmaxf(mx, s[i]);
            mx = fmaxf(mx, __shfl_xor(mx, 32));
            const float mnew = fmaxf(m_run, mx);
            const float alpha = __builtin_amdgcn_exp2f(m_run - mnew);
            m_run = mnew;
            float psum = 0.f;
#pragma unroll
            for (int i = 0; i < 16; ++i) { s[i] = __builtin_amdgcn_exp2f(s[i] - mnew); psum += s[i]; }
            l_run = l_run * alpha + psum;
#pragma unroll
            for (int db = 0; db < NDB; ++db)
#pragma unroll
                for (int i = 0; i < 16; ++i) O[db][i] *= alpha;
            bf16x8 P[2];
#pragma unroll
            for (int s2 = 0; s2 < 2; ++s2) { u32x4 pw; pw.x = pk2(s[8 * s2], s[8 * s2 + 1]); pw.y = pk2(s[8 * s2 + 2], s[8 * s2 + 3]); pw.z = pk2(s[8 * s2 + 4], s[8 * s2 + 5]); pw.w = pk2(s[8 * s2 + 6], s[8 * s2 + 7]); P[s2] = __builtin_bit_cast(bf16x8, pw); }
#pragma unroll
            for (int db = 0; db < NDB; ++db)
#pragma unroll
                for (int s2 = 0; s2 < 2; ++s2) {
                    const LAS unsigned char* vp = lds + OFF_V + buf * VBYTES + ((32 * db + r) * VP + 32 * sub + 16 * s2 + 4 * hh) * 2;
                    const u32x2 lo = *(const LAS u32x2*)vp, hi = *(const LAS u32x2*)(vp + 16);
                    const bf16x8 a = __builtin_bit_cast(bf16x8, (u32x4){lo.x, lo.y, hi.x, hi.y});
                    O[db] = __builtin_amdgcn_mfma_f32_32x32x16_bf16(a, P[s2], O[db], 0, 0, 0);
                }
        }
    }
#undef FA_LOAD
#undef FA_WRITE
    float l_tot = l_run + __shfl_xor(l_run, 32);
    if constexpr (MODE == 1) l_tot += __builtin_amdgcn_exp2f(A.sinks[h] * LOG2E - m_run);
    const float inv_l = 1.0f / l_tot;
    bf16_t* Op = A.O + (size_t)(b * SEQ + qpos) * A.o_pitch + A.o_col0 + h * DV;
#pragma unroll
    for (int db = 0; db < NDB; ++db)
#pragma unroll
        for (int g = 0; g < 4; ++g) {
            u32x2 wv; wv.x = pk2(O[db][4 * g] * inv_l, O[db][4 * g + 1] * inv_l); wv.y = pk2(O[db][4 * g + 2] * inv_l, O[db][4 * g + 3] * inv_l);
            *(u32x2*)(Op + 32 * db + 8 * g + 4 * hh) = wv;
        }
    __syncthreads();
}

template <int D>
__device__ __forceinline__ void headnorm_items(const bf16_t* src, int src_pitch, int src_col0, int src_hstride, int H, const float* gain,
                                               bf16_t* dst, int dst_D, int dst_d0, int S, int M, int gw, int NGW, int lane) {
    constexpr int LPI = D / 8, IPW = 64 / LPI;
    const int li = lane % LPI, sub = lane / LPI;
    const f32x4 g0 = *(const f32x4*)(gain + 8 * li), g1 = *(const f32x4*)(gain + 8 * li + 4);
    const int total = M * H;
    for (int it = gw * IPW + sub; it < total; it += NGW * IPW) {
        const int m = it / H, h = it % H;
        const u32x4 v = *(const u32x4*)(src + (size_t)m * src_pitch + src_col0 + h * src_hstride + 8 * li);
        float f[8]; unpack8(v, f);
        float ss = 0.f;
#pragma unroll
        for (int j = 0; j < 8; ++j) ss += f[j] * f[j];
#pragma unroll
        for (int o = 1; o < LPI; o <<= 1) ss += __shfl_xor(ss, o);
        const float rs = 1.0f / sqrtf(ss * (1.0f / D) + RMS_EPS);
#pragma unroll
        for (int j = 0; j < 4; ++j) { f[j] *= rs * g0[j]; f[4 + j] *= rs * g1[j]; }
        const int bb = m / S, s = m % S;
        *(u32x4*)(dst + ((size_t)(bb * H + h) * S + s) * dst_D + dst_d0 + 8 * li) = pack8(f);
    }
}
__device__ __forceinline__ void mla_krope_items(const bf16_t* src, int src_pitch, int col0, const float* gain, bf16_t* Kd, int gw, int NGW, int lane) {
    const int li = lane & 7, sub = lane >> 3;
    const f32x4 ga = *(const f32x4*)(gain + 4 * li), gb = *(const f32x4*)(gain + 32 + 4 * li);
    for (int m = gw * 8 + sub; m < MTOK; m += NGW * 8) {
        const u32x2 va = *(const u32x2*)(src + (size_t)m * src_pitch + col0 + 4 * li), vb = *(const u32x2*)(src + (size_t)m * src_pitch + col0 + 32 + 4 * li);
        float a[4] = {bf_lo(va.x), bf_hi(va.x), bf_lo(va.y), bf_hi(va.y)}, bq[4] = {bf_lo(vb.x), bf_hi(vb.x), bf_lo(vb.y), bf_hi(vb.y)};
        float ss = 0.f;
#pragma unroll
        for (int j = 0; j < 4; ++j) ss += a[j] * a[j] + bq[j] * bq[j];
        ss += __shfl_xor(ss, 1); ss += __shfl_xor(ss, 2); ss += __shfl_xor(ss, 4);
        const float rs = 1.0f / sqrtf(ss * (1.0f / 64.0f) + RMS_EPS);
        const int bb = m / SEQ, s = m % SEQ;
        float o1[4], o2[4];
#pragma unroll
        for (int j = 0; j < 4; ++j) { const float t1 = a[j] * rs * ga[j], t2 = bq[j] * rs * gb[j]; float c, sn; rope_cs(s, 4 * li + j, c, sn); o1[j] = t1 * c - t2 * sn; o2[j] = t1 * sn + t2 * c; }
        const u32x2 w1 = (u32x2){pk2(o1[0], o1[1]), pk2(o1[2], o1[3])}, w2 = (u32x2){pk2(o2[0], o2[1]), pk2(o2[2], o2[3])};
#pragma unroll
        for (int h = 0; h < 16; ++h) { bf16_t* kp = Kd + ((size_t)(bb * 16 + h) * SEQ + s) * 192 + 128; *(u32x2*)(kp + 4 * li) = w1; *(u32x2*)(kp + 32 + 4 * li) = w2; }
    }
}
__device__ __forceinline__ void vtrans_items(const bf16_t* src, int pitch, int col0, int hstride, int H, int DV, bf16_t* dst, int S, int B, LAS unsigned char* scr, int gw, int NGW, int lane) {
    const int ndb = DV / 32, ntb = S / 64, total = B * H * ntb * ndb;
    for (int it = gw; it < total; it += NGW) {
        const int dbk = it % ndb, tb = (it / ndb) % ntb, bh = it / (ndb * ntb), bb = bh / H, h = bh % H;
        u32x4 v[4];
#pragma unroll
        for (int i = 0; i < 4; ++i) { const int c = lane + 64 * i, tok = c >> 2, dc = c & 3; v[i] = *(const u32x4*)(src + (size_t)(bb * S + 64 * tb + tok) * pitch + col0 + h * hstride + 32 * dbk + 8 * dc); }
#pragma unroll
        for (int i = 0; i < 4; ++i) { const int c = lane + 64 * i, tok = c >> 2, dc = c & 3; const unsigned wv[4] = {v[i].x, v[i].y, v[i].z, v[i].w};
#pragma unroll
            for (int e = 0; e < 8; ++e) *(LAS unsigned short*)(scr + ((8 * dc + e) * 66 + tok) * 2) = (unsigned short)((e & 1) ? (wv[e >> 1] >> 16) : (wv[e >> 1] & 0xffffu)); }
        asm volatile("s_waitcnt lgkmcnt(0)" ::: "memory");
        const int d = lane & 31, half = lane >> 5;
        unsigned o[16];
#pragma unroll
        for (int i = 0; i < 16; ++i) o[i] = *(const LAS unsigned*)(scr + (d * 66 + 32 * half + 2 * i) * 2);
        bf16_t* dp = dst + ((size_t)(bh * DV + 32 * dbk + d)) * S + 64 * tb + 32 * half;
#pragma unroll
        for (int i = 0; i < 4; ++i) *(u32x4*)(dp + 8 * i) = (u32x4){o[4 * i], o[4 * i + 1], o[4 * i + 2], o[4 * i + 3]};
        asm volatile("s_waitcnt lgkmcnt(0)" ::: "memory");
    }
}
__device__ __forceinline__ void conv_items(const bf16_t* u, const float* cw, bf16_t* cat, int gt, int NT) {
    const int total = MTOK * (D_MODEL / 8);
    for (int it = gt; it < total; it += NT) {
        const int m = it / (D_MODEL / 8), c8 = (it % (D_MODEL / 8)) * 8, s = m % SEQ;
        float z[3][8];
#pragma unroll
        for (int tap = 0; tap < 3; ++tap) {
            const int back = 2 - tap;
            if (s - back >= 0) { const bf16_t* p = u + (size_t)(m - back) * NIN0 + c8; float gc[8], xt[8]; unpack8(*(const u32x4*)(p + D_MODEL), gc); unpack8(*(const u32x4*)(p + 2 * D_MODEL), xt);
#pragma unroll
                for (int j = 0; j < 8; ++j) z[tap][j] = gc[j] * xt[j]; }
            else {
#pragma unroll
                for (int j = 0; j < 8; ++j) z[tap][j] = 0.f; }
        }
        float gb[8], o[8]; unpack8(*(const u32x4*)(u + (size_t)m * NIN0 + c8), gb);
#pragma unroll
        for (int j = 0; j < 8; ++j) o[j] = gb[j] * (z[0][j] * cw[c8 + j] + z[1][j] * cw[D_MODEL + c8 + j] + z[2][j] * cw[2 * D_MODEL + c8 + j]);
        *(u32x4*)(cat + (size_t)m * K_OUT + c8) = pack8(o);
    }
}
__device__ __forceinline__ void fox_scan_items(const bf16_t* u, int pitch, int fcol0, const float* bfv, float* CB, int gw, int NGW, int lane) {
    for (int it = gw; it < BATCH * 32; it += NGW) {
        const int bb = it / 32, h = it % 32; const float bias = bfv[h];
        float v[32]; float run = 0.f;
#pragma unroll
        for (int i = 0; i < 32; ++i) { const int s = lane * 32 + i; const float x = __uint_as_float(((unsigned)u[(size_t)(bb * SEQ + s) * pitch + fcol0 + h]) << 16) + bias;
            const float ls = fminf(x, 0.f) - log1pf(expf(-fabsf(x))); run += ls; v[i] = run; }
        float tot = run;
#pragma unroll
        for (int o = 1; o < 64; o <<= 1) { const float t = __shfl_up(tot, o); if (lane >= o) tot += t; }
        const float base = tot - run;
        float* cp = CB + (size_t)it * SEQ + lane * 32;
#pragma unroll
        for (int i = 0; i < 8; ++i) *(f32x4*)(cp + 4 * i) = (f32x4){-(base + v[4 * i]) * LOG2E, -(base + v[4 * i + 1]) * LOG2E, -(base + v[4 * i + 2]) * LOG2E, -(base + v[4 * i + 3]) * LOG2E};
    }
}
__device__ __forceinline__ void rowinit_items(const float* src, bf16_t* dst, float* ps, int rows, int gw, int NGW, int lane) {
    for (int m = gw; m < rows; m += NGW) {
        const f32x4* xr = (const f32x4*)(src + (size_t)m * D_MODEL); float ss = 0.f;
#pragma unroll
        for (int j = 0; j < 8; ++j) { const f32x4 v = xr[64 * j + lane]; ss += (v[0] * v[0] + v[1] * v[1]) + (v[2] * v[2] + v[3] * v[3]);
            *(u32x2*)(dst + (size_t)m * D_MODEL + 4 * (64 * j + lane)) = (u32x2){pk2(v[0], v[1]), pk2(v[2], v[3])}; }
#pragma unroll
        for (int o = 1; o < 64; o <<= 1) ss += __shfl_xor(ss, o);
        if (lane < 32) ps[(size_t)m * 32 + lane] = (lane == 0) ? ss : 0.f;
    }
}

struct Seg { int in_idx; int src_off; int K; int Nsrc; int col0; int ncols; int dst_mib; int drow0; int gain_idx; int gain_off; int inter; int start; };
__device__ const Seg SEGS[] = {
    {I_F1G, 0, 2048, 5632, 0, 5632, 488, 0, I_NORM_FFN1, 0, 1, 0},
    {I_F1U, 0, 2048, 5632, 0, 5632, 488, 128, I_NORM_FFN1, 0, 1, 5632},
    {I_MEM_WKV, 0, 2048, 1024, 0, 1024, 1135, 0, I_NORM_MEM, 0, 0, 11264},
    {I_MEM_WKV, 2097152, 2048, 1024, 0, 1024, 1135, 1024, I_NORM_MEM, 2048, 0, 12288},
    {I_MEM_WKV, 4194304, 2048, 1024, 0, 1024, 1135, 2048, I_NORM_MEM, 4096, 0, 13312},
    {I_MEM_WKV, 6291456, 2048, 1024, 0, 1024, 1135, 3072, I_NORM_MEM, 6144, 0, 14336},
    {I_F1D, 0, 5632, 2048, 0, 2048, 840, 0, -1, 0, 0, 15360},
    {I_CONV_WIN, 0, 2048, 6656, 0, 6656, 1016, 0, I_NORM_MIX, 0, 0, 20992},
    {I_CONV_WOUT, 0, 2560, 2048, 0, 2048, 1088, 0, -1, 0, 0, 27648},
    {I_F2G, 0, 2048, 5632, 0, 5632, 532, 0, I_NORM_FFN2, 0, 1, 30208},
    {I_F2U, 0, 2048, 5632, 0, 5632, 532, 128, I_NORM_FFN2, 0, 1, 35840},
    {I_F2D, 0, 5632, 2048, 0, 2048, 862, 0, -1, 0, 0, 41472},
    {I_F1G, 11534336, 2048, 5632, 0, 5632, 576, 0, I_NORM_FFN1, 2048, 1, 47104},
    {I_F1U, 11534336, 2048, 5632, 0, 5632, 576, 128, I_NORM_FFN1, 2048, 1, 52736},
    {I_F1D, 11534336, 5632, 2048, 0, 2048, 884, 0, -1, 0, 0, 58368},
    {I_MLA_WIN, 0, 2048, 1600, 0, 1024, 1042, 0, I_NORM_MIX, 2048, 0, 64000},
    {I_MLA_WIN, 0, 2048, 1600, 1088, 512, 1042, 1024, I_NORM_MIX, 2048, 0, 65024},
    {I_MLA_WIN, 0, 2048, 1600, 1024, 64, 1042, 1536, I_NORM_MIX, 2048, 0, 65536},
    {I_MLA_WQB, 0, 512, 3072, 0, 3072, 1128, 0, I_MLA_QAN, 0, 0, 65600},
    {I_MLA_WKVB, 0, 512, 4096, 0, 4096, 1131, 0, I_MLA_KVAN, 0, 0, 66368},
    {I_MLA_WOUT, 0, 2560, 2048, 0, 2048, 1098, 0, -1, 0, 0, 67392},
    {I_F2G, 11534336, 2048, 5632, 0, 5632, 620, 0, I_NORM_FFN2, 2048, 1, 69952},
    {I_F2U, 11534336, 2048, 5632, 0, 5632, 620, 128, I_NORM_FFN2, 2048, 1, 75584},
    {I_F2D, 11534336, 5632, 2048, 0, 2048, 906, 0, -1, 0, 0, 81216},
    {I_F1G, 23068672, 2048, 5632, 0, 5632, 664, 0, I_NORM_FFN1, 4096, 1, 86848},
    {I_F1U, 23068672, 2048, 5632, 0, 5632, 664, 128, I_NORM_FFN1, 4096, 1, 92480},
    {I_F1D, 23068672, 5632, 2048, 0, 2048, 928, 0, -1, 0, 0, 98112},
    {I_SWA_WIN, 0, 2048, 3072, 0, 3072, 1049, 0, I_NORM_MIX, 4096, 0, 103744},
    {I_SWA_WOUT, 0, 2560, 2048, 0, 2048, 1108, 0, -1, 0, 0, 106816},
    {I_F2G, 23068672, 2048, 5632, 0, 5632, 708, 0, I_NORM_FFN2, 4096, 1, 109376},
    {I_F2U, 23068672, 2048, 5632, 0, 5632, 708, 128, I_NORM_FFN2, 4096, 1, 115008},
    {I_F2D, 23068672, 5632, 2048, 0, 2048, 950, 0, -1, 0, 0, 120640},
    {I_F1G, 34603008, 2048, 5632, 0, 5632, 752, 0, I_NORM_FFN1, 6144, 1, 126272},
    {I_F1U, 34603008, 2048, 5632, 0, 5632, 752, 128, I_NORM_FFN1, 6144, 1, 131904},
    {I_F1D, 34603008, 5632, 2048, 0, 2048, 972, 0, -1, 0, 0, 137536},
    {I_FOX_WIN, 0, 2048, 6688, 0, 6144, 1061, 0, I_NORM_MIX, 6144, 0, 143168},
    {I_FOX_WIN, 0, 2048, 6688, 6176, 512, 1061, 6144, I_NORM_MIX, 6144, 0, 149312},
    {I_FOX_WIN, 0, 2048, 6688, 6144, 32, 1061, 6656, I_NORM_MIX, 6144, 0, 149824},
    {I_FOX_WOUT, 0, 2560, 2048, 0, 2048, 1118, 0, -1, 0, 0, 149856},
    {I_F2G, 34603008, 2048, 5632, 0, 5632, 796, 0, I_NORM_FFN2, 6144, 1, 152416},
    {I_F2U, 34603008, 2048, 5632, 0, 5632, 796, 128, I_NORM_FFN2, 6144, 1, 158048},
    {I_F2D, 34603008, 5632, 2048, 0, 2048, 994, 0, -1, 0, 0, 163680},
};
constexpr int NSEG = 42, NITEMS = 169312, P0_ITEMS = 36192;
struct Slot { int phase, blk0, nblk, it0, it1; };
constexpr Slot SLOTS[] = {{1, 192, 64, 36192, 42336}, {3, 64, 192, 42336, 60768}, {6, 128, 128, 60768, 73056}, {8, 128, 128, 73056, 85344}, {10, 224, 32, 85344, 88416}, {15, 128, 128, 88416, 100704}, {17, 128, 128, 100704, 112992}, {19, 128, 128, 112992, 125280}, {23, 128, 128, 125280, 137568}, {25, 128, 128, 137568, 149856}, {27, 96, 160, 149856, 165216}, {31, 128, 128, 165216, 169312}};
constexpr int NSLOT = 12;

__device__ __forceinline__ void p0_item(const float* W, int K, int Nsrc, int n0src, bf16_t* WT, int drow, const float* gain, LAS float* scr, int k0, int lane) {
    float v[32];
#pragma unroll
    for (int i = 0; i < 32; ++i) { const int kk = 2 * i + (lane >> 5); v[i] = W[(size_t)(k0 + kk) * Nsrc + n0src + (lane & 31)]; }
#pragma unroll
    for (int i = 0; i < 32; ++i) { const int kk = 2 * i + (lane >> 5); scr[kk * 33 + (lane & 31)] = v[i]; }
    asm volatile("s_waitcnt lgkmcnt(0)" ::: "memory");
    const int c = lane & 7;
    f32x4 g0 = (f32x4){1.f, 1.f, 1.f, 1.f}, g1 = g0;
    if (gain) { g0 = *(const f32x4*)(gain + k0 + 8 * c); g1 = *(const f32x4*)(gain + k0 + 8 * c + 4); }
#pragma unroll
    for (int j = 0; j < 4; ++j) { const int n = (lane >> 3) + 8 * j; const LAS float* s = scr + (8 * c) * 33 + n;
        u32x4 o; o.x = pk2(s[0 * 33] * g0[0], s[1 * 33] * g0[1]); o.y = pk2(s[2 * 33] * g0[2], s[3 * 33] * g0[3]); o.z = pk2(s[4 * 33] * g1[0], s[5 * 33] * g1[1]); o.w = pk2(s[6 * 33] * g1[2], s[7 * 33] * g1[3]);
        *(u32x4*)(WT + (size_t)(drow + n) * K + k0 + 8 * c) = o; }
    asm volatile("s_waitcnt lgkmcnt(0)" ::: "memory");
}

#define XB_TMO      128
#define XB_XCNT(j)  (256  + 64 * (j))
#define XB_XSUB(j)  (1280 + 64 * (j))
#define XB_XGEN(j)  (2304 + 64 * (j))
#define XB_TOP      3328
#define XB_TOPGEN   3392
#define XCD_BAR_WORDS 3456
#define XB_SPIN_CAP (1u << 18)
__device__ __forceinline__ unsigned xb_ld(unsigned* p)              { return __hip_atomic_load(p, __ATOMIC_RELAXED, __HIP_MEMORY_SCOPE_AGENT); }
__device__ __forceinline__ unsigned xb_add(unsigned* p, unsigned v) { return __hip_atomic_fetch_add(p, v, __ATOMIC_RELAXED, __HIP_MEMORY_SCOPE_AGENT); }
__device__ __forceinline__ unsigned xb_xcc_id() { return (unsigned)__builtin_amdgcn_s_getreg((3 << 11) | 20) & 0xFu; }
#define XB_SPIN(cond, bar) do { unsigned _sp = 0; while (cond) { __builtin_amdgcn_s_sleep(1); \
    if ((++_sp & 255u) == 0u) { if (xb_ld(&(bar)[XB_TMO])) break; if (_sp > XB_SPIN_CAP) { atomicAdd(&(bar)[XB_TMO], 1u); break; } } } } while (0)
struct XcdBarrier { unsigned* bar; unsigned x; volatile LAS unsigned* st; };
__device__ __forceinline__ XcdBarrier xcd_barrier_post(unsigned* bar, volatile LAS unsigned* st) {
    XcdBarrier b; b.bar = bar; b.x = xb_xcc_id(); b.st = st;
    if (threadIdx.x == 0) (void)xb_add(&bar[XB_XCNT(b.x)], 1u);
    return b;
}
__device__ __forceinline__ void xcd_barrier_complete(unsigned* bar, unsigned x, unsigned& nloc, unsigned& nx) {
    const unsigned G = gridDim.x * gridDim.y * gridDim.z;
    unsigned sum, cnt, mine, sp = 0u;
    for (;;) {
        sum = 0u; cnt = 0u; mine = 0u;
#pragma unroll
        for (unsigned j = 0; j < 16; ++j) { const unsigned c = xb_ld(&bar[XB_XCNT(j)]); sum += c; cnt += (c > 0u) ? 1u : 0u; mine = (j == x) ? c : mine; }
        if (sum == G) break;
        __builtin_amdgcn_s_sleep(1);
        if ((++sp & 255u) == 0u) { if (xb_ld(&bar[XB_TMO])) break; if (sp > XB_SPIN_CAP) { atomicAdd(&bar[XB_TMO], 1u); break; } }
    }
    nloc = mine > 0u ? mine : 1u; nx = cnt > 0u ? cnt : 1u;
}
__device__ __forceinline__ void xcd_barrier(const XcdBarrier& b) {
    asm volatile("s_waitcnt vmcnt(0)" ::: "memory");
    __syncthreads();
    if (threadIdx.x == 0) {
        unsigned* bar = b.bar;
        __builtin_amdgcn_s_waitcnt(0);
        unsigned nloc = b.st[0], nx = b.st[1];
        if (nloc == 0u) { xcd_barrier_complete(bar, b.x, nloc, nx); b.st[0] = nloc; b.st[1] = nx; }
        const unsigned old = xb_add(&bar[XB_XSUB(b.x)], 1u);
        const unsigned gen = old / nloc;
        if (old + 1u == (gen + 1u) * nloc) {
            __builtin_amdgcn_fence(__ATOMIC_RELEASE, "agent");
            asm volatile("s_waitcnt vmcnt(0)" ::: "memory");
            const unsigned og = xb_add(&bar[XB_TOP], 1u);
            const unsigned tg = og / nx;
            if (og + 1u == (tg + 1u) * nx) xb_add(&bar[XB_TOPGEN], 1u);
            else XB_SPIN(xb_ld(&bar[XB_TOPGEN]) == tg, bar);
            __builtin_amdgcn_fence(__ATOMIC_ACQUIRE, "agent");
            xb_add(&bar[XB_XGEN(b.x)], 1u);
            asm volatile("s_waitcnt vmcnt(0)" ::: "memory");
        } else {
            XB_SPIN(xb_ld(&bar[XB_XGEN(b.x)]) == gen, bar);
            __builtin_amdgcn_fence(__ATOMIC_ACQUIRE, "agent");
            asm volatile("s_waitcnt vmcnt(0)" ::: "memory");
        }
    }
    __syncthreads();
}

constexpr int RING_BYTES = 131072, LDSCTL_OFF = RING_BYTES, LDS_BYTES = 147456;
constexpr int CW_BAR = 4096;
constexpr int NPHASES = 33;

struct Args { const float* in[N_INPUTS]; float* out; unsigned char* ws; int ph_lo, ph_hi; };
static_assert(sizeof(Args) == N_INPUTS * 8 + 8 + 8 + 8, "Args has no padding");

__device__ __forceinline__ void convert_range(const Args& args, unsigned char* ws, LAS float* scr, int it0, int it1, int widx, int nw, int lane) {
    int sg = 0;
    for (int it = it0 + widx; it < it1; it += nw) {
        while (sg + 1 < NSEG && it >= SEGS[sg + 1].start) ++sg;
        const Seg s = SEGS[sg];
        const int nbc = s.ncols / 32, rr = it - s.start, kb = rr / nbc, nb = rr % nbc, n = 32 * nb;
        const int drow = s.drow0 + (s.inter ? (((n >> 7) << 8) + (n & 127)) : n);
        const float* gain = s.gain_idx >= 0 ? args.in[s.gain_idx] + s.gain_off : nullptr;
        p0_item(args.in[s.in_idx] + s.src_off, s.K, s.Nsrc, s.col0 + n, (bf16_t*)(ws + (size_t)s.dst_mib * MiB), drow, gain, scr, 64 * kb, lane);
    }
}

__global__ void __launch_bounds__(512, 2) trunk_fwd(Args args) {
    extern __shared__ __attribute__((aligned(16))) unsigned char lds_raw[];
    LAS unsigned char* lds = (LAS unsigned char*)lds_raw;
    const int tid = threadIdx.x, wave = __builtin_amdgcn_readfirstlane(tid >> 6);
    const int G = gridDim.x, bx = blockIdx.x;
    const int vcu = (G % 8 == 0) ? (bx % 8) * (G / 8) + bx / 8 : bx;
    const int gw = vcu * 8 + wave, NGW = G * 8, NT = NGW * 64;
    const bool plan_ok = (G == 256);
#define LANE_ ({ int t_ = threadIdx.x; asm volatile("" : "+v"(t_)); t_ & 63; })
#define GT_ (gw * 64 + LANE_)
    unsigned char* ws = args.ws;
    const int lo = args.ph_lo, hi = args.ph_hi;
    for (int u = tid; u < (LDS_BYTES - LDSCTL_OFF) / 4; u += 512) ((LAS unsigned*)(lds + LDSCTL_OFF))[u] = 0u;
    __syncthreads();
    XcdBarrier bar; bar.bar = (unsigned*)(ws + WS_CTL) + CW_BAR; bar.x = 0; bar.st = nullptr;
    if (hi - lo > 1) bar = xcd_barrier_post((unsigned*)(ws + WS_CTL) + CW_BAR, (volatile LAS unsigned*)(lds + LDSCTL_OFF + 64));

    float* PSUM = (float*)(ws + WS_PSUM); float* UPS = (float*)(ws + WS_UPS); float* PSMEM = (float*)(ws + WS_PSMEM); float* CB = (float*)(ws + WS_CB);
    bf16_t* XB = (bf16_t*)(ws + WS_XB); bf16_t* MEMB = (bf16_t*)(ws + WS_MEMB); bf16_t* MKV = (bf16_t*)(ws + WS_MKV); bf16_t* MK = (bf16_t*)(ws + WS_MK); bf16_t* MVT = (bf16_t*)(ws + WS_MVT);
    bf16_t* CAT = (bf16_t*)(ws + WS_CAT); bf16_t* HID = (bf16_t*)(ws + WS_HID); bf16_t* U = (bf16_t*)(ws + WS_U); bf16_t* QM = (bf16_t*)(ws + WS_QM); bf16_t* KVM = (bf16_t*)(ws + WS_KVM);
    bf16_t* KBUF = (bf16_t*)(ws + WS_KBUF); bf16_t* VTBUF = (bf16_t*)(ws + WS_VTBUF);
    float* OUT = args.out;

#define PH(id) if (lo <= (id) && (id) < hi)
#define BAR(id) do { if (lo <= (id) && (id) + 1 < hi) xcd_barrier(bar); } while (0)
#define GEMM_PHASE_C(EPI_T, E_INIT, Aptr, Bptr, M_, N_, K_, LDA_, C_) do { pg8::Gemm g_{(Aptr), (Bptr), (M_), (N_), (K_), (LDA_)}; pg8::StaticOrder S_; S_.init((M_), (N_), G, (C_)); \
        EPI_T E_ E_INIT; pg8::gemm_phase<EPI_T, pg8::StaticOrder, true>(lds, g_, S_, E_); } while (0)
#define GEMM_PHASE(EPI_T, E_INIT, Aptr, Bptr, M_, N_, K_, LDA_) do { pg8::Gemm g_{(Aptr), (Bptr), (M_), (N_), (K_), (LDA_)}; pg8::StaticOrder S_; S_.init((M_), (N_), G, bx); \
        EPI_T E_ E_INIT; pg8::gemm_phase<EPI_T, pg8::StaticOrder, true>(lds, g_, S_, E_); } while (0)
#define COMMA ,
#define TAIL_SLOT(k, id) do { static_assert(SLOTS[k].phase == (id), "slot/phase"); if (plan_ok && bx >= SLOTS[k].blk0) \
        convert_range(args, ws, (LAS float*)(lds + wave * 8448), SLOTS[k].it0, SLOTS[k].it1, (bx - SLOTS[k].blk0) * 8 + wave, SLOTS[k].nblk * 8, LANE_); } while (0)

    PH(0) {
        convert_range(args, ws, (LAS float*)(lds + wave * 8448), 0, plan_ok ? P0_ITEMS : NITEMS, gw, NGW, LANE_);
        rowinit_items(args.in[I_X], XB, PSUM, MTOK, gw, NGW, LANE_);
        rowinit_items(args.in[I_MEM], MEMB, PSMEM, MMEM, gw, NGW, LANE_);
        { u32x4* z1 = (u32x4*)(ws + WS_WIN1 + (size_t)1600 * D_MODEL * 2); const int n1 = 192 * D_MODEL * 2 / 16; for (int i = GT_; i < n1; i += NT) z1[i] = (u32x4){0u, 0u, 0u, 0u};
          u32x4* z3 = (u32x4*)(ws + WS_WIN3 + (size_t)6688 * D_MODEL * 2); const int n3 = 224 * D_MODEL * 2 / 16; for (int i = GT_; i < n3; i += NT) z3[i] = (u32x4){0u, 0u, 0u, 0u}; }
    }
    BAR(0);

#define GU_PHASE(id, L, WHICH) PH(id) GEMM_PHASE(pg8::EpiSwiGLU, {HID COMMA PSUM}, XB, (const bf16_t*)(ws + WS_WGU + (size_t)(2 * (L) + (WHICH)) * WGU_BYTES), MTOK, N_GU, D_MODEL, D_MODEL)
#define DN_PHASE(id, L, WHICH, BASEP) PH(id) GEMM_PHASE(pg8::EpiResid, {(BASEP) COMMA OUT COMMA XB COMMA PSUM COMMA 0.5f}, HID, (const bf16_t*)(ws + WS_WD + (size_t)(2 * (L) + (WHICH)) * WD_BYTES), MTOK, D_MODEL, D_FF, D_FF); BAR(id)
#define OUT_PHASE(id, L) PH(id) GEMM_PHASE(pg8::EpiResid, {OUT COMMA OUT COMMA XB COMMA PSUM COMMA 1.0f}, CAT, (const bf16_t*)(ws + WS_WOUT + (size_t)(L) * WOUT_BYTES), MTOK, D_MODEL, K_OUT, K_OUT); BAR(id)
#define MEM_FA(L, UPITCH, MQCOL) do { FaArgs fa_; fa_.Q = U; fa_.q_pitch = (UPITCH); fa_.q_col0 = (MQCOL); fa_.q_hstride = 128; fa_.K = MK + (size_t)(L) * 16 * 256 * 128; fa_.Vt = MVT + (size_t)(L) * 16 * 128 * 256; \
        fa_.Skv = MEM_LEN; fa_.kv_group = 1; fa_.nheads = 4; fa_.O = CAT; fa_.o_pitch = K_OUT; fa_.o_col0 = 2048; fa_.qgain = args.in[I_MEM_QN] + (L) * 128; fa_.bias = nullptr; fa_.sinks = nullptr; \
        fa_.qscale = 0.08838834764831845f * LOG2E; \
        for (int i_ = bx; i_ < 16 * 8; i_ += G) fa_unit<128, 128, 3>(lds, fa_, (i_ >> 3) >> 2, (i_ >> 3) & 3, i_ & 7); } while (0)

    PH(1) {
        GEMM_PHASE(pg8::EpiSwiGLU, {HID COMMA PSUM}, XB, (const bf16_t*)(ws + WS_WGU), MTOK, N_GU, D_MODEL, D_MODEL);
        GEMM_PHASE_C(pg8::EpiScale<32 COMMA false>, {MKV COMMA 4096 COMMA PSMEM COMMA 32 COMMA 0 COMMA 1.0f / D_MODEL COMMA nullptr}, MEMB, (const bf16_t*)(ws + WS_WMKV), MMEM, 4096, D_MODEL, D_MODEL, plan_ok ? ((bx + 128) & 255) : bx);
        TAIL_SLOT(0, 1);
    }
    BAR(1);
    DN_PHASE(2, 0, 0, args.in[I_X]);
    PH(3) {
        GEMM_PHASE(pg8::EpiScale<32 COMMA false>, {U COMMA NIN0 COMMA PSUM COMMA 32 COMMA 0 COMMA 1.0f / D_MODEL COMMA nullptr}, XB, (const bf16_t*)(ws + WS_WIN0), MTOK, NIN0, D_MODEL, D_MODEL);
        if (!plan_ok || bx >= 64) {
            const int widx = plan_ok ? (bx - 64) * 8 + wave : gw, nw = plan_ok ? 192 * 8 : NGW;
            for (int L = 0; L < 4; ++L) {
                headnorm_items<128>(MKV, 4096, L * 1024, 128, 4, args.in[I_MEM_KN] + L * 128, MK + (size_t)L * 16 * 256 * 128, 128, 0, MEM_LEN, MMEM, widx, nw, LANE_);
                vtrans_items(MKV, 4096, L * 1024 + 512, 128, 4, 128, MVT + (size_t)L * 16 * 128 * 256, MEM_LEN, BATCH, lds + wave * 8448, widx, nw, LANE_);
            }
        }
        TAIL_SLOT(1, 3);
    }
    BAR(3);
    PH(4) { conv_items(U, args.in[I_CONV_W], CAT, GT_, NT); MEM_FA(0, NIN0, 6144); }
    BAR(4);
    OUT_PHASE(5, 0);
    PH(6) { GEMM_PHASE(pg8::EpiSwiGLU, {HID COMMA PSUM}, XB, (const bf16_t*)(ws + WS_WGU + (size_t)1 * WGU_BYTES), MTOK, N_GU, D_MODEL, D_MODEL); TAIL_SLOT(2, 6); }
    BAR(6);
    DN_PHASE(7, 0, 1, OUT);

    PH(8) { GEMM_PHASE(pg8::EpiSwiGLU, {HID COMMA PSUM}, XB, (const bf16_t*)(ws + WS_WGU + (size_t)2 * WGU_BYTES), MTOK, N_GU, D_MODEL, D_MODEL); TAIL_SLOT(3, 8); }
    BAR(8);
    DN_PHASE(9, 1, 0, OUT);
    PH(10) { GEMM_PHASE(pg8::EpiScale<32 COMMA true>, {U COMMA NIN1 COMMA PSUM COMMA 32 COMMA 0 COMMA 1.0f / D_MODEL COMMA UPS}, XB, (const bf16_t*)(ws + WS_WIN1), MTOK, NIN1, D_MODEL, D_MODEL); TAIL_SLOT(4, 10); }
    BAR(10);
    PH(11) {
        GEMM_PHASE(pg8::EpiScale<8 COMMA false>, {QM COMMA 3072 COMMA UPS COMMA 32 COMMA 0 COMMA 1.0f / 512.0f COMMA nullptr}, U, (const bf16_t*)(ws + WS_WQB), MTOK, 3072, 512, NIN1);
        GEMM_PHASE(pg8::EpiScale<8 COMMA false>, {KVM COMMA 4096 COMMA UPS COMMA 32 COMMA 8 COMMA 1.0f / 512.0f COMMA nullptr}, U + 512, (const bf16_t*)(ws + WS_WKVB), MTOK, 4096, 512, NIN1);
    }
    BAR(11);
    PH(12) {
        headnorm_items<128>(KVM, 4096, 0, 256, 16, args.in[I_MLA_KN], KBUF, 192, 0, SEQ, MTOK, gw, NGW, LANE_);
        mla_krope_items(U, NIN1, 1536, args.in[I_MLA_KN] + 128, KBUF, gw, NGW, LANE_);
        vtrans_items(KVM, 4096, 128, 256, 16, 128, VTBUF, SEQ, BATCH, lds + wave * 8448, gw, NGW, LANE_);
    }
    BAR(12);
    PH(13) {
        FaArgs fa; fa.Q = QM; fa.q_pitch = 3072; fa.q_col0 = 0; fa.q_hstride = 192; fa.K = KBUF; fa.Vt = VTBUF; fa.Skv = SEQ; fa.kv_group = 1; fa.nheads = 16;
        fa.O = CAT; fa.o_pitch = K_OUT; fa.o_col0 = 0; fa.qgain = args.in[I_MLA_QN]; fa.bias = nullptr; fa.sinks = nullptr; fa.qscale = 0.07216878364870323f * LOG2E;
        for (int j = bx; j < 64 * 4; j += G) { const int bh = j >> 2, q4 = j & 3; for (int k = 0; k < 2; ++k) fa_unit<192, 128, 0>(lds, fa, bh >> 4, bh & 15, k ? q4 : 7 - q4); }
        MEM_FA(1, NIN1, 1024);
    }
    BAR(13);
    OUT_PHASE(14, 1);
    PH(15) { GEMM_PHASE(pg8::EpiSwiGLU, {HID COMMA PSUM}, XB, (const bf16_t*)(ws + WS_WGU + (size_t)3 * WGU_BYTES), MTOK, N_GU, D_MODEL, D_MODEL); TAIL_SLOT(5, 15); }
    BAR(15);
    DN_PHASE(16, 1, 1, OUT);

    PH(17) { GEMM_PHASE(pg8::EpiSwiGLU, {HID COMMA PSUM}, XB, (const bf16_t*)(ws + WS_WGU + (size_t)4 * WGU_BYTES), MTOK, N_GU, D_MODEL, D_MODEL); TAIL_SLOT(6, 17); }
    BAR(17);
    DN_PHASE(18, 2, 0, OUT);
    PH(19) { GEMM_PHASE(pg8::EpiScale<32 COMMA false>, {U COMMA NIN2 COMMA PSUM COMMA 32 COMMA 0 COMMA 1.0f / D_MODEL COMMA nullptr}, XB, (const bf16_t*)(ws + WS_WIN2), MTOK, NIN2, D_MODEL, D_MODEL); TAIL_SLOT(7, 19); }
    BAR(19);
    PH(20) {
        headnorm_items<64>(U, NIN2, 2048, 64, 4, args.in[I_SWA_KN], KBUF, 64, 0, SEQ, MTOK, gw, NGW, LANE_);
        vtrans_items(U, NIN2, 2304, 64, 4, 64, VTBUF, SEQ, BATCH, lds + wave * 8448, gw, NGW, LANE_);
    }
    BAR(20);
    PH(21) {
        FaArgs fa; fa.Q = U; fa.q_pitch = NIN2; fa.q_col0 = 0; fa.q_hstride = 64; fa.K = KBUF; fa.Vt = VTBUF; fa.Skv = SEQ; fa.kv_group = 8; fa.nheads = 32;
        fa.O = CAT; fa.o_pitch = K_OUT; fa.o_col0 = 0; fa.qgain = args.in[I_SWA_QN]; fa.bias = args.in[I_REL_BIAS]; fa.sinks = args.in[I_SWA_SINKS]; fa.qscale = 0.125f * LOG2E;
        for (int i = bx; i < 128 * 8; i += G) { const int bh = i >> 3; fa_unit<64, 64, 1>(lds, fa, bh >> 5, bh & 31, i & 7); }
        MEM_FA(2, NIN2, 2560);
    }
    BAR(21);
    OUT_PHASE(22, 2);
    PH(23) { GEMM_PHASE(pg8::EpiSwiGLU, {HID COMMA PSUM}, XB, (const bf16_t*)(ws + WS_WGU + (size_t)5 * WGU_BYTES), MTOK, N_GU, D_MODEL, D_MODEL); TAIL_SLOT(8, 23); }
    BAR(23);
    DN_PHASE(24, 2, 1, OUT);

    PH(25) { GEMM_PHASE(pg8::EpiSwiGLU, {HID COMMA PSUM}, XB, (const bf16_t*)(ws + WS_WGU + (size_t)6 * WGU_BYTES), MTOK, N_GU, D_MODEL, D_MODEL); TAIL_SLOT(9, 25); }
    BAR(25);
    DN_PHASE(26, 3, 0, OUT);
    PH(27) { GEMM_PHASE(pg8::EpiScale<32 COMMA false>, {U COMMA NIN3 COMMA PSUM COMMA 32 COMMA 0 COMMA 1.0f / D_MODEL COMMA nullptr}, XB, (const bf16_t*)(ws + WS_WIN3), MTOK, NIN3, D_MODEL, D_MODEL); TAIL_SLOT(10, 27); }
    BAR(27);
    PH(28) {
        headnorm_items<64>(U, NIN3, 2048, 64, 32, args.in[I_FOX_KN], KBUF, 64, 0, SEQ, MTOK, gw, NGW, LANE_);
        vtrans_items(U, NIN3, 4096, 64, 32, 64, VTBUF, SEQ, BATCH, lds + wave * 8448, gw, NGW, LANE_);
        fox_scan_items(U, NIN3, 6656, args.in[I_FOX_BF], CB, gw, NGW, LANE_);
    }
    BAR(28);
    PH(29) {
        FaArgs fa; fa.Q = U; fa.q_pitch = NIN3; fa.q_col0 = 0; fa.q_hstride = 64; fa.K = KBUF; fa.Vt = VTBUF; fa.Skv = SEQ; fa.kv_group = 1; fa.nheads = 32;
        fa.O = CAT; fa.o_pitch = K_OUT; fa.o_col0 = 0; fa.qgain = args.in[I_FOX_QN]; fa.bias = CB; fa.sinks = nullptr; fa.qscale = 0.125f * LOG2E;
        for (int j = bx; j < 128 * 4; j += G) { const int bh = j >> 2, q4 = j & 3; for (int k = 0; k < 2; ++k) fa_unit<64, 64, 2>(lds, fa, bh >> 5, bh & 31, k ? q4 : 7 - q4); }
        MEM_FA(3, NIN3, 6144);
    }
    BAR(29);
    OUT_PHASE(30, 3);
    PH(31) { GEMM_PHASE(pg8::EpiSwiGLU, {HID COMMA PSUM}, XB, (const bf16_t*)(ws + WS_WGU + (size_t)7 * WGU_BYTES), MTOK, N_GU, D_MODEL, D_MODEL); TAIL_SLOT(11, 31); }
    BAR(31);
    DN_PHASE(32, 3, 1, OUT);
}

extern "C" void kernel_launch(void* const* d_in, const int* in_sizes, int n_in, void* d_out, int out_size, void* d_ws, size_t ws_size, hipStream_t stream) {
    static int grid = 0;
    if (grid == 0) {
        if (n_in != N_INPUTS || out_size != MTOK * D_MODEL || ws_size < WS_END) { fprintf(stderr, "kernel_launch: unexpected problem: n_in %d out %d ws %zu (need %zu)\n", n_in, out_size, ws_size, (size_t)WS_END); grid = -1; return; }
        int dev = 0, cus = 0, per_cu = 0;
        if (hipGetDevice(&dev) != hipSuccess || hipDeviceGetAttribute(&cus, hipDeviceAttributeMultiprocessorCount, dev) != hipSuccess) { grid = -1; return; }
        if (hipFuncSetAttribute((const void*)trunk_fwd, hipFuncAttributeMaxDynamicSharedMemorySize, LDS_BYTES) != hipSuccess) { fprintf(stderr, "kernel_launch: hipFuncSetAttribute failed\n"); grid = -1; return; }
        if (hipOccupancyMaxActiveBlocksPerMultiprocessor(&per_cu, (const void*)trunk_fwd, 512, LDS_BYTES) != hipSuccess || per_cu < 1)
            fprintf(stderr, "kernel_launch: note: occupancy query reports %d workgroups per CU\n", per_cu);
        (void)hipGetLastError();
        grid = cus;
    }
    if (grid < 0) return;
    if (hipMemsetAsync((char*)d_ws + WS_CTL, 0, CTL_ZERO_BYTES, stream) != hipSuccess) { fprintf(stderr, "kernel_launch: memset failed\n"); return; }
    Args a{};
    for (int i = 0; i < N_INPUTS; ++i) a.in[i] = (const float*)d_in[i];
    a.out = (float*)d_out; a.ws = (unsigned char*)d_ws;
#if MK_ONE_LAUNCH
    a.ph_lo = 0; a.ph_hi = NPHASES;
    hipLaunchKernelGGL(trunk_fwd, dim3(grid), dim3(512), LDS_BYTES, stream, a);
#else
    for (int p = 0; p < NPHASES; ++p) { a.ph_lo = p; a.ph_hi = p + 1; hipLaunchKernelGGL(trunk_fwd, dim3(grid), dim3(512), LDS_BYTES, stream, a); }
#endif
    const hipError_t le = hipPeekAtLastError();
    if (le != hipSuccess) fprintf(stderr, "kernel_launch: launch failed: %s\n", hipGetErrorName(le));
}
```

```cpp
#include <hip/hip_runtime.h>
#include <cstdio>
#include <cstdint>

#ifndef MK_ONE_LAUNCH
#define MK_ONE_LAUNCH 1
#endif

#define LAS __attribute__((address_space(3)))
typedef unsigned short bf16_t;
typedef short bf16x8 __attribute__((ext_vector_type(8)));
typedef float f32x4 __attribute__((ext_vector_type(4)));
typedef float f32x16 __attribute__((ext_vector_type(16)));
typedef unsigned u32x4 __attribute__((ext_vector_type(4)));
typedef unsigned u32x2 __attribute__((ext_vector_type(2)));

constexpr int D_MODEL = 2048, BATCH = 4, SEQ = 2048, MTOK = BATCH * SEQ, D_FF = 5632, MEM_LEN = 256, MMEM = BATCH * MEM_LEN;
constexpr int N_GU = 2 * D_FF;
constexpr int NIN0 = 6656, NIN1 = 1792, NIN2 = 3072, NIN3 = 6912;
constexpr int K_OUT = 2560;
constexpr float RMS_EPS = 1e-6f;
constexpr float LOG2E = 1.4426950408889634f;

constexpr size_t MiB = 1u << 20;
constexpr size_t WS_CTL = 0, CTL_ZERO_BYTES = 1 * MiB;
constexpr size_t WS_PSUM = 1 * MiB, WS_UPS = 2 * MiB, WS_PSMEM = 3 * MiB, WS_CB = 4 * MiB;
constexpr size_t WS_XB = 8 * MiB, WS_MEMB = 40 * MiB, WS_MKV = 44 * MiB, WS_MK = 52 * MiB, WS_MVT = 56 * MiB;
constexpr size_t WS_CAT = 60 * MiB, WS_HID = 100 * MiB, WS_U = 188 * MiB, WS_QM = 296 * MiB, WS_KVM = 344 * MiB;
constexpr size_t WS_KBUF = 408 * MiB, WS_VTBUF = 456 * MiB;
constexpr size_t WS_WGU = 488 * MiB;
constexpr size_t WS_WD = 840 * MiB;
constexpr size_t WS_WIN0 = 1016 * MiB, WS_WIN1 = 1042 * MiB, WS_WIN2 = 1049 * MiB, WS_WIN3 = 1061 * MiB;
constexpr size_t WS_WOUT = 1088 * MiB;
constexpr size_t WS_WQB = 1128 * MiB, WS_WKVB = 1131 * MiB, WS_WMKV = 1135 * MiB, WS_XL = 1151 * MiB, WS_END = 1183 * MiB;
constexpr size_t WGU_BYTES = (size_t)N_GU * D_MODEL * 2, WD_BYTES = (size_t)D_MODEL * D_FF * 2, WOUT_BYTES = (size_t)D_MODEL * K_OUT * 2;
static_assert(WGU_BYTES == 44 * MiB && WD_BYTES == 22 * MiB && WOUT_BYTES == 10 * MiB, "weight sizes");

enum { I_X = 0, I_MEM, I_NORM_FFN1, I_F1G, I_F1U, I_F1D, I_NORM_MIX, I_NORM_FFN2, I_F2G, I_F2U, I_F2D, I_NORM_MEM, I_MEM_WKV, I_MEM_QN, I_MEM_KN,
       I_CONV_WIN, I_CONV_W, I_CONV_WOUT, I_MLA_WIN, I_MLA_QAN, I_MLA_WQB, I_MLA_KVAN, I_MLA_WKVB, I_MLA_QN, I_MLA_KN, I_MLA_WOUT,
       I_SWA_WIN, I_SWA_QN, I_SWA_KN, I_SWA_SINKS, I_SWA_WOUT, I_REL_BIAS, I_FOX_WIN, I_FOX_BF, I_FOX_QN, I_FOX_KN, I_FOX_WOUT, N_INPUTS };

__device__ __forceinline__ unsigned pk2(float lo, float hi) {
    typedef __bf16 b2 __attribute__((ext_vector_type(2))); typedef float f2 __attribute__((ext_vector_type(2)));
    return __builtin_bit_cast(unsigned, __builtin_convertvector((f2){lo, hi}, b2)); }
__device__ __forceinline__ float bf_lo(unsigned w) { return __uint_as_float(w << 16); }
__device__ __forceinline__ float bf_hi(unsigned w) { return __uint_as_float(w & 0xffff0000u); }
__device__ __forceinline__ void unpack8(const u32x4 v, float (&f)[8]) {
    f[0] = bf_lo(v.x); f[1] = bf_hi(v.x); f[2] = bf_lo(v.y); f[3] = bf_hi(v.y); f[4] = bf_lo(v.z); f[5] = bf_hi(v.z); f[6] = bf_lo(v.w); f[7] = bf_hi(v.w); }
__device__ __forceinline__ u32x4 pack8(const float (&f)[8]) { u32x4 o; o.x = pk2(f[0], f[1]); o.y = pk2(f[2], f[3]); o.z = pk2(f[4], f[5]); o.w = pk2(f[6], f[7]); return o; }
#define GAS __attribute__((address_space(1)))
__device__ __forceinline__ const GAS char* uni_ptr(const char* p) {
    const unsigned long long v = (unsigned long long)p; const unsigned lo = __builtin_amdgcn_readfirstlane((unsigned)v), hi = __builtin_amdgcn_readfirstlane((unsigned)(v >> 32));
    return (const GAS char*)(((unsigned long long)hi << 32) | lo); }
__device__ __forceinline__ float rope_invf_turns(int i) {
    return __builtin_amdgcn_exp2f(-(float)i * (13.287712379549449f / 32.0f)) * 0.15915494309189535f; }
__device__ __forceinline__ void rope_cs(int pos, int i, float& c, float& s) {
    float t = (float)pos * rope_invf_turns(i); t = t - floorf(t); c = __builtin_amdgcn_cosf(t); s = __builtin_amdgcn_sinf(t); }

namespace pg8 {
constexpr int BM = 256, BK = 64, HALF = 128, HTB = HALF * BK * 2, STAGE_BYTES = 8 * HTB, NXCD = 8, WGM = 8;
__host__ __device__ __forceinline__ int lds_byte(int r, int c) { const int st = (r >> 4) * 2 + (c >> 5), rr = r & 15, cc = c & 31, ob = rr * 64 + cc * 2; return st * 1024 + (ob ^ (((ob >> 9) & 1) << 5)); }
__host__ __device__ __forceinline__ void stage_rc(int b, int& R, int& C) { const int st = b / 1024, sb = b % 1024, swz = sb ^ (((sb >> 9) & 1) << 5); R = (st >> 1) * 16 + swz / 64; C = (st & 1) * 32 + (swz % 64) / 2; }
__host__ __device__ __forceinline__ int perm32(int rho) { const int n = rho >> 4, i = rho & 15; return 8 * (i >> 2) + 4 * n + (i & 3); }
struct Unit { int pm, pn; };
struct Gemm { const bf16_t* A; const bf16_t* Bt; int M, N, K, lda; };
struct StaticOrder {
    int nM, nN, nwg, G, c;
    __host__ __device__ void init(int M, int N, int G_, int c_) { nM = M / BM; nN = N / BM; nwg = nM * nN; G = G_; c = c_; }
    __host__ __device__ bool next(int i, Unit& u) const {
        const long L = (long)i * G + c; if (L >= nwg) return false;
        int wgid = (int)L; { const int q = nwg / NXCD, r = nwg % NXCD, xcd = wgid % NXCD, off = wgid / NXCD; wgid = (xcd < r ? xcd * (q + 1) : r * (q + 1) + (xcd - r) * q) + off; }
        const int nig = WGM * nN, gid = wgid / nig, fm = gid * WGM, gsz = (nM - fm) < WGM ? (nM - fm) : WGM;
        u.pm = fm + ((wgid % nig) % gsz); u.pn = (wgid % nig) / gsz; return true;
    }
    __device__ __forceinline__ void a_ready(const Unit&) const {}
    __device__ __forceinline__ void done(const Unit&) const {}
};

template <int CNT>
__device__ __forceinline__ void rows_rstd(const float* ps, int pitch, int off, int row0, int fq, float inv_dim, float (&rs)[2][4]) {
    float t[2][4];
#pragma unroll
    for (int ai = 0; ai < 2; ++ai)
#pragma unroll
        for (int m = 0; m < 4; ++m) { const float* p = ps + (size_t)(row0 + ai * HALF + m * 16) * pitch + off + fq * (CNT / 4); float s = 0.f;
#pragma unroll
            for (int i = 0; i < CNT / 4; ++i) s += p[i];
            t[ai][m] = s; }
#pragma unroll
    for (int ai = 0; ai < 2; ++ai)
#pragma unroll
        for (int m = 0; m < 4; ++m) { float s = t[ai][m]; s += __shfl_xor(s, 16); s += __shfl_xor(s, 32); rs[ai][m] = __builtin_amdgcn_rsqf(s * inv_dim + RMS_EPS); }
}
__device__ __forceinline__ float silu_mul(float g, float u) { return g * __builtin_amdgcn_rcpf(1.0f + __builtin_amdgcn_exp2f(-g * LOG2E)) * u; }

struct EpiSwiGLU {
    static constexpr bool PERM = true, AFTER_DRAIN = false;
    bf16_t* H; const float* ps;
    __device__ __forceinline__ void operator()(const f32x4 (&acc)[2][2][4][2], const Unit& u, int wr, int wc, int fr, int fq) const {
        const int row0 = u.pm * BM + wr * 64 + fr, col0 = u.pn * 128 + wc * 32 + 8 * fq;
        float rs[2][4]; rows_rstd<32>(ps, 32, 0, row0, fq, 1.0f / D_MODEL, rs);
#pragma unroll
        for (int ai = 0; ai < 2; ++ai)
#pragma unroll
            for (int m = 0; m < 4; ++m) {
                const int row = row0 + ai * HALF + m * 16;
                const float r = rs[ai][m];
                const f32x4 g0 = acc[ai][0][m][0] * r, g1 = acc[ai][0][m][1] * r, u0 = acc[ai][1][m][0] * r, u1 = acc[ai][1][m][1] * r;
                u32x4 w;
                w.x = pk2(silu_mul(g0[0], u0[0]), silu_mul(g0[1], u0[1])); w.y = pk2(silu_mul(g0[2], u0[2]), silu_mul(g0[3], u0[3]));
                w.z = pk2(silu_mul(g1[0], u1[0]), silu_mul(g1[1], u1[1])); w.w = pk2(silu_mul(g1[2], u1[2]), silu_mul(g1[3], u1[3]));
                *(u32x4*)(H + (size_t)row * D_FF + col0) = w;
            }
    }
};
template <int MODE> struct EpiResid {
    static constexpr bool PERM = false, AFTER_DRAIN = false;
    const float* base32; float* out32; bf16_t* xh; bf16_t* xl; float* ps; float alpha;
    __device__ __forceinline__ void operator()(const f32x4 (&acc)[2][2][4][2], const Unit& u, int wr, int wc, int fr, int fq) const {
        const int row0 = u.pm * BM + wr * 64 + fr, col0 = u.pn * BM + wc * 32 + 4 * fq;
#pragma unroll
        for (int ai = 0; ai < 2; ++ai) {
            f32x4 bv[4][2][2];
#pragma unroll
            for (int m = 0; m < 4; ++m)
#pragma unroll
                for (int bj = 0; bj < 2; ++bj)
#pragma unroll
                    for (int n = 0; n < 2; ++n) {
                        const size_t o = (size_t)(row0 + ai * HALF + m * 16) * D_MODEL + col0 + bj * HALF + n * 16;
                        if constexpr (MODE == 0) bv[m][bj][n] = *(const f32x4*)(base32 + o);
                        else { const u32x2 h = *(const u32x2*)(xh + o), l = *(const u32x2*)(xl + o);
                               bv[m][bj][n] = (f32x4){bf_lo(h.x) + bf_lo(l.x), bf_hi(h.x) + bf_hi(l.x), bf_lo(h.y) + bf_lo(l.y), bf_hi(h.y) + bf_hi(l.y)}; }
                    }
#pragma unroll
            for (int m = 0; m < 4; ++m) {
                const int row = row0 + ai * HALF + m * 16; const size_t off = (size_t)row * D_MODEL + col0;
                float ss = 0.f;
#pragma unroll
                for (int bj = 0; bj < 2; ++bj)
#pragma unroll
                    for (int n = 0; n < 2; ++n) {
                        const f32x4 v = bv[m][bj][n] + acc[ai][bj][m][n] * alpha;
                        if constexpr (MODE == 2) *(f32x4*)(out32 + off + bj * HALF + n * 16) = v;
                        else {
                            u32x2 h; h.x = pk2(v[0], v[1]); h.y = pk2(v[2], v[3]);
                            u32x2 l; l.x = pk2(v[0] - bf_lo(h.x), v[1] - bf_hi(h.x)); l.y = pk2(v[2] - bf_lo(h.y), v[3] - bf_hi(h.y));
                            *(u32x2*)(xh + off + bj * HALF + n * 16) = h; *(u32x2*)(xl + off + bj * HALF + n * 16) = l;
                            ss += (v[0] * v[0] + v[1] * v[1]) + (v[2] * v[2] + v[3] * v[3]);
                        }
                    }
                if constexpr (MODE != 2) { ss += __shfl_xor(ss, 16); ss += __shfl_xor(ss, 32); if (fq == 0) ps[(size_t)row * 32 + u.pn * 4 + wc] = ss; }
            }
        }
    }
};
template <int CNT, bool WPS> struct EpiScale {
    static constexpr bool PERM = true, AFTER_DRAIN = false;
    bf16_t* O; int ldo; const float* ps; int ps_pitch, ps_off; float inv_dim; float* ops;
    __device__ __forceinline__ void operator()(const f32x4 (&acc)[2][2][4][2], const Unit& u, int wr, int wc, int fr, int fq) const {
        const int row0 = u.pm * BM + wr * 64 + fr, col0 = u.pn * BM + wc * 32 + 8 * fq;
        float rs[2][4]; rows_rstd<CNT>(ps, ps_pitch, ps_off, row0, fq, inv_dim, rs);
#pragma unroll
        for (int ai = 0; ai < 2; ++ai)
#pragma unroll
            for (int m = 0; m < 4; ++m) {
                const int row = row0 + ai * HALF + m * 16;
                const float r = rs[ai][m];
                float ss = 0.f;
#pragma unroll
                for (int bj = 0; bj < 2; ++bj) {
                    const f32x4 v0 = acc[ai][bj][m][0] * r, v1 = acc[ai][bj][m][1] * r;
                    if (WPS) ss += (v0[0] * v0[0] + v0[1] * v0[1]) + (v0[2] * v0[2] + v0[3] * v0[3]) + (v1[0] * v1[0] + v1[1] * v1[1]) + (v1[2] * v1[2] + v1[3] * v1[3]);
                    u32x4 w; w.x = pk2(v0[0], v0[1]); w.y = pk2(v0[2], v0[3]); w.z = pk2(v1[0], v1[1]); w.w = pk2(v1[2], v1[3]);
                    *(u32x4*)(O + (size_t)row * ldo + col0 + bj * HALF) = w;
                }
                if (WPS) { ss += __shfl_xor(ss, 16); ss += __shfl_xor(ss, 32); if (fq == 0) ops[(size_t)row * 32 + u.pn * 4 + wc] = ss; }
            }
    }
};

template <class Epi, class Sched, bool ALIGN_EPI = true>
__device__ __forceinline__ void gemm_phase(LAS unsigned char* lds, const Gemm g, const Sched& S, const Epi& E) {
    int tid = threadIdx.x; asm volatile("" : "+v"(tid));
    const int wid = __builtin_amdgcn_readfirstlane(tid >> 6), lane = tid & 63, wr = wid >> 2, wc = wid & 3, fr = lane & 15, fq = lane >> 4;
    const int K = g.K, nt = K / BK, lda = g.lda;
    unsigned voffA[2], voffB[2];
#pragma unroll
    for (int i = 0; i < 2; ++i) { int R, C; stage_rc(tid * 16 + i * 8192, R, C); const int Rb = Epi::PERM ? ((R & ~31) + perm32(R & 31)) : R;
        voffA[i] = (unsigned)(R * lda + C) * 2u; voffB[i] = (unsigned)(Rb * K + C) * 2u; }
    const size_t kstep = (size_t)(BK * 2);
    const size_t hstepA = (size_t)HALF * lda * 2, hstepB = (size_t)HALF * K * 2;
    const size_t tstepA = 2 * hstepA, tstepB = 2 * hstepB;
    const unsigned ldsw = (unsigned)wid * 1024u;
    const int aoff = lds_byte(wr * 64 + fr, fq * 8), boff = lds_byte(wc * 32 + fr, fq * 8);
#define PG8_SA(b, h) (((b) * 2 + (h)) * HTB)
#define PG8_SB(b, h) ((4 + (b) * 2 + (h)) * HTB)
#define PG8_STAGE(bufoff, gbase, voff) do { _Pragma("unroll") for (int _i = 0; _i < 2; ++_i) \
        __builtin_amdgcn_global_load_lds((const unsigned*)((const char*)(gbase) + (voff)[_i]), (LAS unsigned*)(lds + (bufoff) + ldsw + _i * 8192), 16, 0, 0); } while (0)
#define PG8_LDA(dst, b, h) do { _Pragma("unroll") for (int m = 0; m < 4; ++m) _Pragma("unroll") for (int k = 0; k < 2; ++k) dst[m][k] = *(const LAS bf16x8*)(lds + PG8_SA(b, h) + aoff + m * 2048 + k * 1024); } while (0)
#define PG8_LDB(dst, b, h) do { _Pragma("unroll") for (int n = 0; n < 2; ++n) _Pragma("unroll") for (int k = 0; k < 2; ++k) dst[n][k] = *(const LAS bf16x8*)(lds + PG8_SB(b, h) + boff + n * 2048 + k * 1024); } while (0)
#define PG8_MMA(ai, bj, At, Bt) do { __builtin_amdgcn_s_setprio(1); _Pragma("unroll") for (int m = 0; m < 4; ++m) _Pragma("unroll") for (int n = 0; n < 2; ++n) _Pragma("unroll") for (int k = 0; k < 2; ++k) \
        acc[ai][bj][m][n] = __builtin_amdgcn_mfma_f32_16x16x32_bf16(Bt[n][k], At[m][k], acc[ai][bj][m][n], 0, 0, 0); __builtin_amdgcn_s_setprio(0); } while (0)
#define PG8_WAIT_V(n) asm volatile("s_waitcnt vmcnt(" #n ")" ::: "memory")
#define PG8_WAIT_L(n) asm volatile("s_waitcnt lgkmcnt(" #n ")" ::: "memory")
#define PG8_BAR __builtin_amdgcn_s_barrier()
#define PG8_SCHED __builtin_amdgcn_sched_barrier(0)
    Unit cur, nxt; int ui = 0;
    if (!S.next(0, cur)) return;
    f32x4 acc[2][2][4][2];
#pragma unroll
    for (int a = 0; a < 2; ++a)
#pragma unroll
        for (int b = 0; b < 2; ++b)
#pragma unroll
            for (int m = 0; m < 4; ++m)
#pragma unroll
                for (int n = 0; n < 2; ++n) acc[a][b][m][n] = (f32x4){0.f, 0.f, 0.f, 0.f};
    bf16x8 At[4][2], B0[2][2], B1[2][2];
    const char* cA = (const char*)g.A + (size_t)cur.pm * tstepA; const char* cB = (const char*)g.Bt + (size_t)cur.pn * tstepB;
    S.a_ready(cur);
    PG8_STAGE(PG8_SB(0, 0), cB, voffB); PG8_STAGE(PG8_SB(0, 1), cB + hstepB, voffB); PG8_STAGE(PG8_SA(0, 0), cA, voffA); PG8_STAGE(PG8_SA(0, 1), cA + hstepA, voffA);
    if (wr == 1) PG8_BAR;
    PG8_WAIT_V(2); PG8_BAR;
    PG8_STAGE(PG8_SB(1, 0), cB + kstep, voffB); PG8_STAGE(PG8_SA(1, 0), cA + kstep, voffA); PG8_STAGE(PG8_SB(1, 1), cB + hstepB + kstep, voffB);
    PG8_WAIT_V(6); PG8_BAR;
    for (;;) {
        const bool has_next = S.next(ui + 1, nxt);
        const char* nA = has_next ? (const char*)g.A + (size_t)nxt.pm * tstepA : cA; const char* nB = has_next ? (const char*)g.Bt + (size_t)nxt.pn * tstepB : cB;
        for (int t = 0; t < nt; t += 2) {
            const bool last = (t == nt - 2);
            const char* a1 = cA + (size_t)(t + 1) * kstep;
            const char* a2 = last ? nA : cA + (size_t)(t + 2) * kstep; const char* b2 = last ? nB : cB + (size_t)(t + 2) * kstep;
            const char* a3 = a2 + kstep; const char* b3 = b2 + kstep;
            if (last && has_next) S.a_ready(nxt);
            PG8_LDB(B0, 0, 0); PG8_LDB(B1, 0, 1); PG8_SCHED; PG8_LDA(At, 0, 0); PG8_STAGE(PG8_SA(1, 1), a1 + hstepA, voffA);
            PG8_WAIT_V(8); PG8_WAIT_L(0); PG8_BAR; PG8_MMA(0, 0, At, B0); PG8_MMA(0, 1, At, B1); PG8_BAR; PG8_SCHED;
            PG8_LDA(At, 0, 1); PG8_STAGE(PG8_SB(0, 0), b2, voffB); PG8_STAGE(PG8_SB(0, 1), b2 + hstepB, voffB); PG8_STAGE(PG8_SA(0, 0), a2, voffA);
            PG8_WAIT_V(8); PG8_WAIT_L(0); PG8_BAR; PG8_MMA(1, 0, At, B0); PG8_MMA(1, 1, At, B1); PG8_BAR; PG8_SCHED;
            PG8_LDB(B0, 1, 0); PG8_LDB(B1, 1, 1); PG8_SCHED; PG8_LDA(At, 1, 0); PG8_STAGE(PG8_SA(0, 1), a2 + hstepA, voffA);
            PG8_WAIT_V(8); PG8_WAIT_L(0); PG8_BAR; PG8_MMA(0, 0, At, B0); PG8_MMA(0, 1, At, B1); PG8_BAR; PG8_SCHED;
            PG8_LDA(At, 1, 1); PG8_STAGE(PG8_SB(1, 0), b3, voffB); PG8_STAGE(PG8_SB(1, 1), b3 + hstepB, voffB); PG8_STAGE(PG8_SA(1, 0), a3, voffA);
            PG8_WAIT_V(8); PG8_WAIT_L(0); PG8_BAR; PG8_MMA(1, 0, At, B0); PG8_MMA(1, 1, At, B1); PG8_BAR; PG8_SCHED;
        }
        if constexpr (ALIGN_EPI) { if (wr == 0) PG8_BAR; }
        E(acc, cur, wr, wc, fr, fq); S.done(cur);
        if (!has_next) break;
#pragma unroll
        for (int a = 0; a < 2; ++a)
#pragma unroll
            for (int b = 0; b < 2; ++b)
#pragma unroll
                for (int m = 0; m < 4; ++m)
#pragma unroll
                    for (int n = 0; n < 2; ++n) acc[a][b][m][n] = (f32x4){0.f, 0.f, 0.f, 0.f};
        cur = nxt; cA = nA; cB = nB; ++ui;
        if constexpr (ALIGN_EPI) { if (wr == 1) PG8_BAR; }
    }
    PG8_WAIT_V(0);
    if constexpr (!ALIGN_EPI) { if (wr == 0) PG8_BAR; }
    PG8_BAR;
#undef PG8_SA
#undef PG8_SB
#undef PG8_STAGE
#undef PG8_LDA
#undef PG8_LDB
#undef PG8_MMA
#undef PG8_WAIT_V
#undef PG8_WAIT_L
#undef PG8_BAR
#undef PG8_SCHED
}
}

struct FaArgs {
    const bf16_t* Q; int q_pitch, q_col0, q_hstride;
    const bf16_t* K; const bf16_t* Vt; int Skv, kv_group, nheads;
    bf16_t* O; int o_pitch, o_col0;
    const float* qgain; const float* bias; const float* sinks; float qscale;
};
__device__ const unsigned char T5_BUCKET[128] = {
    0, 1, 2, 3, 4, 5, 6, 7, 8, 9, 10, 11, 12, 13, 14, 15, 16, 16, 16, 17, 17, 18, 18, 18, 19, 19, 19, 20, 20, 20, 20, 21, 21, 21, 21, 22, 22, 22, 22, 22, 23, 23, 23, 23, 23, 23,
    24, 24, 24, 24, 24, 24, 25, 25, 25, 25, 25, 25, 25, 26, 26, 26, 26, 26, 26, 26, 26, 27, 27, 27, 27, 27, 27, 27, 27, 27, 27, 28, 28, 28, 28, 28, 28, 28, 28, 28, 28,
    29, 29, 29, 29, 29, 29, 29, 29, 29, 29, 29, 29, 30, 30, 30, 30, 30, 30, 30, 30, 30, 30, 30, 30, 30, 30, 31, 31, 31, 31, 31, 31, 31, 31, 31, 31, 31, 31, 31, 31, 31};

template <int DQK, int DV, int MODE>
__device__ __forceinline__ void fa_unit(LAS unsigned char* lds, const FaArgs& A, const int b, const int h, const int qb) {
    constexpr int NKS = DQK / 16, NDB = DV / 32, KP = DQK + 8, VP = 68;
    constexpr int KBYTES = 64 * KP * 2, VBYTES = DV * VP * 2;
    constexpr int OFF_K = 0, OFF_V = 2 * KBYTES, OFF_B = OFF_V + 2 * VBYTES, OFF_TAB = OFF_B + 512;
    static_assert(OFF_TAB + 512 <= 131072, "FA LDS");
    constexpr int KCH = DQK / 8, KPT = 64 * KCH / 512, VPT = DV * 8 / 512;
    static_assert(KPT * 512 == 64 * KCH && VPT * 512 == DV * 8, "FA staging");
    int tid = threadIdx.x; asm volatile("" : "+v"(tid));
    const int lane = tid & 63, w = __builtin_amdgcn_readfirstlane(tid >> 6), r = lane & 31, hh = lane >> 5;
    const int q0 = qb * 256, qw0 = q0 + w * 32, qpos = qw0 + r;
    const int bhk = (MODE == 1) ? b * (A.nheads / A.kv_group) + h / A.kv_group : b * A.nheads + h;

    bf16x8 Qf[NKS];
    {
        int opq = 0; asm volatile("" : "+v"(opq));
        const bf16_t* Qp = A.Q + (size_t)(b * SEQ + qpos) * A.q_pitch + A.q_col0 + h * A.q_hstride + 8 * hh;
        float qf[NKS][8];
#pragma unroll
        for (int ks = 0; ks < NKS; ++ks) { const u32x4 v = *(const u32x4*)(Qp + 16 * ks); unpack8(v, qf[ks]); }
        if constexpr (MODE == 0) {
            float sn = 0.f, sr = 0.f;
#pragma unroll
            for (int ks = 0; ks < 8; ++ks)
#pragma unroll
                for (int j = 0; j < 8; ++j) sn += qf[ks][j] * qf[ks][j];
#pragma unroll
            for (int ks = 8; ks < 12; ++ks)
#pragma unroll
                for (int j = 0; j < 8; ++j) sr += qf[ks][j] * qf[ks][j];
            sn += __shfl_xor(sn, 32); sr += __shfl_xor(sr, 32);
            const float rn = 1.0f / sqrtf(sn * (1.0f / 128.0f) + RMS_EPS), rr = 1.0f / sqrtf(sr * (1.0f / 64.0f) + RMS_EPS);
#pragma unroll
            for (int ks = 0; ks < 8; ++ks) {
                const f32x4 g0 = *(const f32x4*)(A.qgain + 16 * ks + 8 * hh), g1 = *(const f32x4*)(A.qgain + 16 * ks + 8 * hh + 4);
#pragma unroll
                for (int j = 0; j < 4; ++j) { qf[ks][j] *= rn * g0[j] * A.qscale; qf[ks][4 + j] *= rn * g1[j] * A.qscale; }
            }
#pragma unroll
            for (int ks = 8; ks < 10; ++ks) {
                const int i0 = 16 * (ks - 8) + 8 * hh;
                const f32x4 ga0 = *(const f32x4*)(A.qgain + 128 + i0), ga1 = *(const f32x4*)(A.qgain + 128 + i0 + 4);
                const f32x4 gb0 = *(const f32x4*)(A.qgain + 160 + i0), gb1 = *(const f32x4*)(A.qgain + 160 + i0 + 4);
#pragma unroll
                for (int j = 0; j < 8; ++j) {
                    const float ga = j < 4 ? ga0[j & 3] : ga1[j & 3], gb = j < 4 ? gb0[j & 3] : gb1[j & 3];
                    const float t1 = qf[ks][j] * rr * ga, t2 = qf[ks + 2][j] * rr * gb;
                    float c, s; rope_cs(qpos, i0 + j + opq, c, s);
                    qf[ks][j] = (t1 * c - t2 * s) * A.qscale; qf[ks + 2][j] = (t1 * s + t2 * c) * A.qscale;
                }
            }
        } else {
            float ss = 0.f;
#pragma unroll
            for (int ks = 0; ks < NKS; ++ks)
#pragma unroll
                for (int j = 0; j < 8; ++j) ss += qf[ks][j] * qf[ks][j];
            ss += __shfl_xor(ss, 32);
            const float rs = 1.0f / sqrtf(ss * (1.0f / DQK) + RMS_EPS) * A.qscale;
#pragma unroll
            for (int ks = 0; ks < NKS; ++ks) {
                const f32x4 g0 = *(const f32x4*)(A.qgain + 16 * ks + 8 * hh), g1 = *(const f32x4*)(A.qgain + 16 * ks + 8 * hh + 4);
#pragma unroll
                for (int j = 0; j < 4; ++j) { qf[ks][j] *= rs * g0[j]; qf[ks][4 + j] *= rs * g1[j]; }
            }
        }
#pragma unroll
        for (int ks = 0; ks < NKS; ++ks) Qf[ks] = __builtin_bit_cast(bf16x8, pack8(qf[ks]));
    }
    if constexpr (MODE == 1) { if (tid < 128) *(LAS float*)(lds + OFF_TAB + 4 * tid) = A.bias[(int)T5_BUCKET[tid] * 32 + h] * LOG2E; }

    int t_lo = 0, t_hi;
    if constexpr (MODE == 3) t_hi = A.Skv / 64; else t_hi = 4 * qb + 4;
    if constexpr (MODE == 1) { const int lowk = q0 - 127; t_lo = lowk > 0 ? lowk / 64 : 0; }
    const int nt = t_hi - t_lo;
    const bf16_t* Kg = A.K + (size_t)bhk * A.Skv * DQK;
    const bf16_t* Vg = A.Vt + (size_t)bhk * DV * A.Skv;
    const float* Bg = (MODE == 2) ? A.bias + (size_t)(b * A.nheads + h) * SEQ : nullptr;
    u32x4 kst[KPT], vst[VPT]; f32x4 bst = (f32x4){0.f, 0.f, 0.f, 0.f};
    unsigned koff[KPT], voff[VPT];
#pragma unroll
    for (int i = 0; i < KPT; ++i) { const int c = tid + 512 * i, row = c / KCH, cc = c % KCH; koff[i] = (unsigned)(row * DQK + cc * 8) * 2u; }
#pragma unroll
    for (int i = 0; i < VPT; ++i) { const int c = tid + 512 * i, d = c >> 3, cc = c & 7; voff[i] = (unsigned)(d * A.Skv + cc * 8) * 2u; }
#define FA_LOAD(t) do { const GAS char* _kt = uni_ptr((const char*)Kg + (size_t)(64 * (t)) * DQK * 2); const GAS char* _vt = uni_ptr((const char*)Vg + (size_t)(64 * (t)) * 2); \
        _Pragma("unroll") for (int _i = 0; _i < KPT; ++_i) kst[_i] = *(const GAS u32x4*)(_kt + koff[_i]); \
        _Pragma("unroll") for (int _i = 0; _i < VPT; ++_i) vst[_i] = *(const GAS u32x4*)(_vt + voff[_i]); \
        if (MODE == 2) { if (tid < 16) bst = *(const f32x4*)(Bg + 64 * (t) + 4 * tid); } } while (0)
#define FA_WRITE(buf) do { \
        _Pragma("unroll") for (int _i = 0; _i < KPT; ++_i) { const int _c = tid + 512 * _i, _row = _c / KCH, _cc = _c % KCH; *(LAS u32x4*)(lds + OFF_K + (buf) * KBYTES + (_row * KP + _cc * 8) * 2) = kst[_i]; } \
        _Pragma("unroll") for (int _i = 0; _i < VPT; ++_i) { const int _c = tid + 512 * _i, _d = _c >> 3, _cc = _c & 7; LAS unsigned char* _p = lds + OFF_V + (buf) * VBYTES + (_d * VP + _cc * 8) * 2; \
            *(LAS u32x2*)_p = (u32x2){vst[_i].x, vst[_i].y}; *(LAS u32x2*)(_p + 8) = (u32x2){vst[_i].z, vst[_i].w}; } \
        if (MODE == 2) { if (tid < 16) *(LAS f32x4*)(lds + OFF_B + (buf) * 256 + 16 * tid) = bst; } } while (0)

    f32x16 O[NDB];
#pragma unroll
    for (int db = 0; db < NDB; ++db)
#pragma unroll
        for (int i = 0; i < 16; ++i) O[db][i] = 0.f;
    float m_run = -1e30f, l_run = 0.f;
    FA_LOAD(t_lo);
    for (int it = 0; it < nt; ++it) {
        const int t = t_lo + it, buf = it & 1;
        FA_WRITE(buf);
        __syncthreads();
        if (it + 1 < nt) FA_LOAD(t + 1);
#pragma unroll
        for (int sub = 0; sub < 2; ++sub) {
            const int ks0 = 64 * t + 32 * sub;
            bool active = true;
            if constexpr (MODE == 0 || MODE == 2) active = (ks0 <= qw0 + 31);
            if constexpr (MODE == 1) active = (ks0 <= qw0 + 31) && (ks0 + 31 >= qw0 - 127);
            if (!active) continue;
            f32x16 s;
            if constexpr (MODE == 2) {
#pragma unroll
                for (int g = 0; g < 4; ++g) { const f32x4 bb = *(const LAS f32x4*)(lds + OFF_B + buf * 256 + (32 * sub + 8 * g + 4 * hh) * 4); s[4 * g] = bb[0]; s[4 * g + 1] = bb[1]; s[4 * g + 2] = bb[2]; s[4 * g + 3] = bb[3]; }
            } else if constexpr (MODE == 1) {
#pragma unroll
                for (int i = 0; i < 16; ++i) { int dist = qpos - (ks0 + (i & 3) + 8 * (i >> 2) + 4 * hh); dist = dist < 0 ? 0 : (dist > 127 ? 127 : dist); s[i] = *(const LAS float*)(lds + OFF_TAB + 4 * dist); }
            } else {
#pragma unroll
                for (int i = 0; i < 16; ++i) s[i] = 0.f;
            }
#pragma unroll
            for (int ks = 0; ks < NKS; ++ks) {
                const bf16x8 a = *(const LAS bf16x8*)(lds + OFF_K + buf * KBYTES + ((32 * sub + r) * KP + 16 * ks + 8 * hh) * 2);
                s = __builtin_amdgcn_mfma_f32_32x32x16_bf16(a, Qf[ks], s, 0, 0, 0);
            }
            if constexpr (MODE == 0 || MODE == 2) {
                if (ks0 + 31 > qw0) {
#pragma unroll
                    for (int i = 0; i < 16; ++i) { const int key = ks0 + (i & 3) + 8 * (i >> 2) + 4 * hh; if (key > qpos) s[i] = -__builtin_inff(); }
                }
            }
            if constexpr (MODE == 1) {
#pragma unroll
                for (int i = 0; i < 16; ++i) { const int key = ks0 + (i & 3) + 8 * (i >> 2) + 4 * hh; if ((unsigned)(qpos - key) >= 128u) s[i] = -__builtin_inff(); }
            }
            float mx = s[0];
#pragma unroll
            for (int i = 1; i < 16; ++i) mx = fmaxf(mx, s[i]);
            mx = fmaxf(mx, __shfl_xor(mx, 32));
            const float mnew = fmaxf(m_run, mx);
            const float alpha = __builtin_amdgcn_exp2f(m_run - mnew);
            m_run = mnew;
            float psum = 0.f;
#pragma unroll
            for (int i = 0; i < 16; ++i) { s[i] = __builtin_amdgcn_exp2f(s[i] - mnew); psum += s[i]; }
            l_run = l_run * alpha + psum;
#pragma unroll
            for (int db = 0; db < NDB; ++db)
#pragma unroll
                for (int i = 0; i < 16; ++i) O[db][i] *= alpha;
            bf16x8 P[2];
#pragma unroll
            for (int s2 = 0; s2 < 2; ++s2) { u32x4 pw; pw.x = pk2(s[8 * s2], s[8 * s2 + 1]); pw.y = pk2(s[8 * s2 + 2], s[8 * s2 + 3]); pw.z = pk2(s[8 * s2 + 4], s[8 * s2 + 5]); pw.w = pk2(s[8 * s2 + 6], s[8 * s2 + 7]); P[s2] = __builtin_bit_cast(bf16x8, pw); }
#pragma unroll
            for (int db = 0; db < NDB; ++db)
#pragma unroll
                for (int s2 = 0; s2 < 2; ++s2) {
                    const LAS unsigned char* vp = lds + OFF_V + buf * VBYTES + ((32 * db + r) * VP + 32 * sub + 16 * s2 + 4 * hh) * 2;
                    const u32x2 lo = *(const LAS u32x2*)vp, hi = *(const LAS u32x2*)(vp + 16);
                    const bf16x8 a = __builtin_bit_cast(bf16x8, (u32x4){lo.x, lo.y, hi.x, hi.y});
                    O[db] = __builtin_amdgcn_mfma_f32_32x32x16_bf16(a, P[s2], O[db], 0, 0, 0);
                }
        }
    }
#undef FA_LOAD
#undef FA_WRITE
    float l_tot = l_run + __shfl_xor(l_run, 32);
    if constexpr (MODE == 1) l_tot += __builtin_amdgcn_exp2f(A.sinks[h] * LOG2E - m_run);
    const float inv_l = 1.0f / l_tot;
    bf16_t* Op = A.O + (size_t)(b * SEQ + qpos) * A.o_pitch + A.o_col0 + h * DV;
#pragma unroll
    for (int db = 0; db < NDB; ++db)
#pragma unroll
        for (int g = 0; g < 4; ++g) {
            u32x2 wv; wv.x = pk2(O[db][4 * g] * inv_l, O[db][4 * g + 1] * inv_l); wv.y = pk2(O[db][4 * g + 2] * inv_l, O[db][4 * g + 3] * inv_l);
            *(u32x2*)(Op + 32 * db + 8 * g + 4 * hh) = wv;
        }
    __syncthreads();
}

template <int D>
__device__ __forceinline__ void headnorm_items(const bf16_t* src, int src_pitch, int src_col0, int src_hstride, int H, const float* gain,
                                               bf16_t* dst, int dst_D, int dst_d0, int S, int M, int gw, int NGW, int lane) {
    constexpr int LPI = D / 8, IPW = 64 / LPI;
    const int li = lane % LPI, sub = lane / LPI;
    const f32x4 g0 = *(const f32x4*)(gain + 8 * li), g1 = *(const f32x4*)(gain + 8 * li + 4);
    const int total = M * H;
    for (int it = gw * IPW + sub; it < total; it += NGW * IPW) {
        const int m = it / H, h = it % H;
        const u32x4 v = *(const u32x4*)(src + (size_t)m * src_pitch + src_col0 + h * src_hstride + 8 * li);
        float f[8]; unpack8(v, f);
        float ss = 0.f;
#pragma unroll
        for (int j = 0; j < 8; ++j) ss += f[j] * f[j];
#pragma unroll
        for (int o = 1; o < LPI; o <<= 1) ss += __shfl_xor(ss, o);
        const float rs = 1.0f / sqrtf(ss * (1.0f / D) + RMS_EPS);
#pragma unroll
        for (int j = 0; j < 4; ++j) { f[j] *= rs * g0[j]; f[4 + j] *= rs * g1[j]; }
        const int bb = m / S, s = m % S;
        *(u32x4*)(dst + ((size_t)(bb * H + h) * S + s) * dst_D + dst_d0 + 8 * li) = pack8(f);
    }
}
__device__ __forceinline__ void mla_krope_items(const bf16_t* src, int src_pitch, int col0, const float* gain, bf16_t* Kd, int gw, int NGW, int lane) {
    const int li = lane & 7, sub = lane >> 3;
    const f32x4 ga = *(const f32x4*)(gain + 4 * li), gb = *(const f32x4*)(gain + 32 + 4 * li);
    for (int m = gw * 8 + sub; m < MTOK; m += NGW * 8) {
        const u32x2 va = *(const u32x2*)(src + (size_t)m * src_pitch + col0 + 4 * li), vb = *(const u32x2*)(src + (size_t)m * src_pitch + col0 + 32 + 4 * li);
        float a[4] = {bf_lo(va.x), bf_hi(va.x), bf_lo(va.y), bf_hi(va.y)}, bq[4] = {bf_lo(vb.x), bf_hi(vb.x), bf_lo(vb.y), bf_hi(vb.y)};
        float ss = 0.f;
#pragma unroll
        for (int j = 0; j < 4; ++j) ss += a[j] * a[j] + bq[j] * bq[j];
        ss += __shfl_xor(ss, 1); ss += __shfl_xor(ss, 2); ss += __shfl_xor(ss, 4);
        const float rs = 1.0f / sqrtf(ss * (1.0f / 64.0f) + RMS_EPS);
        const int bb = m / SEQ, s = m % SEQ;
        float o1[4], o2[4];
#pragma unroll
        for (int j = 0; j < 4; ++j) { const float t1 = a[j] * rs * ga[j], t2 = bq[j] * rs * gb[j]; float c, sn; rope_cs(s, 4 * li + j, c, sn); o1[j] = t1 * c - t2 * sn; o2[j] = t1 * sn + t2 * c; }
        const u32x2 w1 = (u32x2){pk2(o1[0], o1[1]), pk2(o1[2], o1[3])}, w2 = (u32x2){pk2(o2[0], o2[1]), pk2(o2[2], o2[3])};
#pragma unroll
        for (int h = 0; h < 16; ++h) { bf16_t* kp = Kd + ((size_t)(bb * 16 + h) * SEQ + s) * 192 + 128; *(u32x2*)(kp + 4 * li) = w1; *(u32x2*)(kp + 32 + 4 * li) = w2; }
    }
}
__device__ __forceinline__ void vtrans_items(const bf16_t* src, int pitch, int col0, int hstride, int H, int DV, bf16_t* dst, int S, int B, LAS unsigned char* scr, int gw, int NGW, int lane) {
    const int ndb = DV / 32, ntb = S / 64, total = B * H * ntb * ndb;
    for (int it = gw; it < total; it += NGW) {
        const int dbk = it % ndb, tb = (it / ndb) % ntb, bh = it / (ndb * ntb), bb = bh / H, h = bh % H;
        u32x4 v[4];
#pragma unroll
        for (int i = 0; i < 4; ++i) { const int c = lane + 64 * i, tok = c >> 2, dc = c & 3; v[i] = *(const u32x4*)(src + (size_t)(bb * S + 64 * tb + tok) * pitch + col0 + h * hstride + 32 * dbk + 8 * dc); }
#pragma unroll
        for (int i = 0; i < 4; ++i) { const int c = lane + 64 * i, tok = c >> 2, dc = c & 3; const unsigned wv[4] = {v[i].x, v[i].y, v[i].z, v[i].w};
#pragma unroll
            for (int e = 0; e < 8; ++e) *(LAS unsigned short*)(scr + ((8 * dc + e) * 66 + tok) * 2) = (unsigned short)((e & 1) ? (wv[e >> 1] >> 16) : (wv[e >> 1] & 0xffffu)); }
        asm volatile("s_waitcnt lgkmcnt(0)" ::: "memory");
        const int d = lane & 31, half = lane >> 5;
        unsigned o[16];
#pragma unroll
        for (int i = 0; i < 16; ++i) o[i] = *(const LAS unsigned*)(scr + (d * 66 + 32 * half + 2 * i) * 2);
        bf16_t* dp = dst + ((size_t)(bh * DV + 32 * dbk + d)) * S + 64 * tb + 32 * half;
#pragma unroll
        for (int i = 0; i < 4; ++i) *(u32x4*)(dp + 8 * i) = (u32x4){o[4 * i], o[4 * i + 1], o[4 * i + 2], o[4 * i + 3]};
        asm volatile("s_waitcnt lgkmcnt(0)" ::: "memory");
    }
}
__device__ __forceinline__ void conv_items(const bf16_t* u, const float* cw, bf16_t* cat, int gt, int NT) {
    const int total = MTOK * (D_MODEL / 8);
    for (int it = gt; it < total; it += NT) {
        const int m = it / (D_MODEL / 8), c8 = (it % (D_MODEL / 8)) * 8, s = m % SEQ;
        float z[3][8];
#pragma unroll
        for (int tap = 0; tap < 3; ++tap) {
            const int back = 2 - tap;
            if (s - back >= 0) { const bf16_t* p = u + (size_t)(m - back) * NIN0 + c8; float gc[8], xt[8]; unpack8(*(const u32x4*)(p + D_MODEL), gc); unpack8(*(const u32x4*)(p + 2 * D_MODEL), xt);
#pragma unroll
                for (int j = 0; j < 8; ++j) z[tap][j] = gc[j] * xt[j]; }
            else {
#pragma unroll
                for (int j = 0; j < 8; ++j) z[tap][j] = 0.f; }
        }
        float gb[8], o[8]; unpack8(*(const u32x4*)(u + (size_t)m * NIN0 + c8), gb);
#pragma unroll
        for (int j = 0; j < 8; ++j) o[j] = gb[j] * (z[0][j] * cw[c8 + j] + z[1][j] * cw[D_MODEL + c8 + j] + z[2][j] * cw[2 * D_MODEL + c8 + j]);
        *(u32x4*)(cat + (size_t)m * K_OUT + c8) = pack8(o);
    }
}
__device__ __forceinline__ void fox_scan_items(const bf16_t* u, int pitch, int fcol0, const float* bfv, float* CB, int gw, int NGW, int lane) {
    for (int it = gw; it < BATCH * 32; it += NGW) {
        const int bb = it / 32, h = it % 32; const float bias = bfv[h];
        float v[32]; float run = 0.f;
#pragma unroll
        for (int i = 0; i < 32; ++i) { const int s = lane * 32 + i; const float x = __uint_as_float(((unsigned)u[(size_t)(bb * SEQ + s) * pitch + fcol0 + h]) << 16) + bias;
            const float ls = fminf(x, 0.f) - log1pf(expf(-fabsf(x))); run += ls; v[i] = run; }
        float tot = run;
#pragma unroll
        for (int o = 1; o < 64; o <<= 1) { const float t = __shfl_up(tot, o); if (lane >= o) tot += t; }
        const float base = tot - run;
        float* cp = CB + (size_t)it * SEQ + lane * 32;
#pragma unroll
        for (int i = 0; i < 8; ++i) *(f32x4*)(cp + 4 * i) = (f32x4){-(base + v[4 * i]) * LOG2E, -(base + v[4 * i + 1]) * LOG2E, -(base + v[4 * i + 2]) * LOG2E, -(base + v[4 * i + 3]) * LOG2E};
    }
}
__device__ __forceinline__ void rowinit_items(const float* src, bf16_t* dst, float* ps, int rows, int gw, int NGW, int lane) {
    for (int m = gw; m < rows; m += NGW) {
        const f32x4* xr = (const f32x4*)(src + (size_t)m * D_MODEL); float ss = 0.f;
#pragma unroll
        for (int j = 0; j < 8; ++j) { const f32x4 v = xr[64 * j + lane]; ss += (v[0] * v[0] + v[1] * v[1]) + (v[2] * v[2] + v[3] * v[3]);
            *(u32x2*)(dst + (size_t)m * D_MODEL + 4 * (64 * j + lane)) = (u32x2){pk2(v[0], v[1]), pk2(v[2], v[3])}; }
#pragma unroll
        for (int o = 1; o < 64; o <<= 1) ss += __shfl_xor(ss, o);
        if (lane < 32) ps[(size_t)m * 32 + lane] = (lane == 0) ? ss : 0.f;
    }
}

struct Seg { int in_idx; int src_off; int K; int Nsrc; int col0; int ncols; int dst_mib; int drow0; int gain_idx; int gain_off; int inter; int start; };
__device__ const Seg SEGS[] = {
    {I_F1G, 0, 2048, 5632, 0, 5632, 488, 0, I_NORM_FFN1, 0, 1, 0},
    {I_F1U, 0, 2048, 5632, 0, 5632, 488, 128, I_NORM_FFN1, 0, 1, 5632},
    {I_MEM_WKV, 0, 2048, 1024, 0, 1024, 1135, 0, I_NORM_MEM, 0, 0, 11264},
    {I_MEM_WKV, 2097152, 2048, 1024, 0, 1024, 1135, 1024, I_NORM_MEM, 2048, 0, 12288},
    {I_MEM_WKV, 4194304, 2048, 1024, 0, 1024, 1135, 2048, I_NORM_MEM, 4096, 0, 13312},
    {I_MEM_WKV, 6291456, 2048, 1024, 0, 1024, 1135, 3072, I_NORM_MEM, 6144, 0, 14336},
    {I_F1D, 0, 5632, 2048, 0, 2048, 840, 0, -1, 0, 0, 15360},
    {I_CONV_WIN, 0, 2048, 6656, 0, 6656, 1016, 0, I_NORM_MIX, 0, 0, 20992},
    {I_CONV_WOUT, 0, 2560, 2048, 0, 2048, 1088, 0, -1, 0, 0, 27648},
    {I_F2G, 0, 2048, 5632, 0, 5632, 532, 0, I_NORM_FFN2, 0, 1, 30208},
    {I_F2U, 0, 2048, 5632, 0, 5632, 532, 128, I_NORM_FFN2, 0, 1, 35840},
    {I_F2D, 0, 5632, 2048, 0, 2048, 862, 0, -1, 0, 0, 41472},
    {I_F1G, 11534336, 2048, 5632, 0, 5632, 576, 0, I_NORM_FFN1, 2048, 1, 47104},
    {I_F1U, 11534336, 2048, 5632, 0, 5632, 576, 128, I_NORM_FFN1, 2048, 1, 52736},
    {I_F1D, 11534336, 5632, 2048, 0, 2048, 884, 0, -1, 0, 0, 58368},
    {I_MLA_WIN, 0, 2048, 1600, 0, 1024, 1042, 0, I_NORM_MIX, 2048, 0, 64000},
    {I_MLA_WIN, 0, 2048, 1600, 1088, 512, 1042, 1024, I_NORM_MIX, 2048, 0, 65024},
    {I_MLA_WIN, 0, 2048, 1600, 1024, 64, 1042, 1536, I_NORM_MIX, 2048, 0, 65536},
    {I_MLA_WQB, 0, 512, 3072, 0, 3072, 1128, 0, I_MLA_QAN, 0, 0, 65600},
    {I_MLA_WKVB, 0, 512, 4096, 0, 4096, 1131, 0, I_MLA_KVAN, 0, 0, 66368},
    {I_MLA_WOUT, 0, 2560, 2048, 0, 2048, 1098, 0, -1, 0, 0, 67392},
    {I_F2G, 11534336, 2048, 5632, 0, 5632, 620, 0, I_NORM_FFN2, 2048, 1, 69952},
    {I_F2U, 11534336, 2048, 5632, 0, 5632, 620, 128, I_NORM_FFN2, 2048, 1, 75584},
    {I_F2D, 11534336, 5632, 2048, 0, 2048, 906, 0, -1, 0, 0, 81216},
    {I_F1G, 23068672, 2048, 5632, 0, 5632, 664, 0, I_NORM_FFN1, 4096, 1, 86848},
    {I_F1U, 23068672, 2048, 5632, 0, 5632, 664, 128, I_NORM_FFN1, 4096, 1, 92480},
    {I_F1D, 23068672, 5632, 2048, 0, 2048, 928, 0, -1, 0, 0, 98112},
    {I_SWA_WIN, 0, 2048, 3072, 0, 3072, 1049, 0, I_NORM_MIX, 4096, 0, 103744},
    {I_SWA_WOUT, 0, 2560, 2048, 0, 2048, 1108, 0, -1, 0, 0, 106816},
    {I_F2G, 23068672, 2048, 5632, 0, 5632, 708, 0, I_NORM_FFN2, 4096, 1, 109376},
    {I_F2U, 23068672, 2048, 5632, 0, 5632, 708, 128, I_NORM_FFN2, 4096, 1, 115008},
    {I_F2D, 23068672, 5632, 2048, 0, 2048, 950, 0, -1, 0, 0, 120640},
    {I_F1G, 34603008, 2048, 5632, 0, 5632, 752, 0, I_NORM_FFN1, 6144, 1, 126272},
    {I_F1U, 34603008, 2048, 5632, 0, 5632, 752, 128, I_NORM_FFN1, 6144, 1, 131904},
    {I_F1D, 34603008, 5632, 2048, 0, 2048, 972, 0, -1, 0, 0, 137536},
    {I_FOX_WIN, 0, 2048, 6688, 0, 6144, 1061, 0, I_NORM_MIX, 6144, 0, 143168},
    {I_FOX_WIN, 0, 2048, 6688, 6176, 512, 1061, 6144, I_NORM_MIX, 6144, 0, 149312},
    {I_FOX_WIN, 0, 2048, 6688, 6144, 32, 1061, 6656, I_NORM_MIX, 6144, 0, 149824},
    {I_FOX_WOUT, 0, 2560, 2048, 0, 2048, 1118, 0, -1, 0, 0, 149856},
    {I_F2G, 34603008, 2048, 5632, 0, 5632, 796, 0, I_NORM_FFN2, 6144, 1, 152416},
    {I_F2U, 34603008, 2048, 5632, 0, 5632, 796, 128, I_NORM_FFN2, 6144, 1, 158048},
    {I_F2D, 34603008, 5632, 2048, 0, 2048, 994, 0, -1, 0, 0, 163680},
};
constexpr int NSEG = 42, NITEMS = 169312, P0_ITEMS = 36192;
struct Slot { int phase, blk0, nblk, it0, it1; };
constexpr Slot SLOTS[] = {{1, 192, 64, 36192, 42336}, {3, 64, 192, 42336, 60768}, {6, 128, 128, 60768, 73056}, {8, 128, 128, 73056, 85344}, {10, 224, 32, 85344, 88416}, {15, 128, 128, 88416, 100704}, {17, 128, 128, 100704, 112992}, {19, 128, 128, 112992, 125280}, {23, 128, 128, 125280, 137568}, {25, 128, 128, 137568, 149856}, {27, 96, 160, 149856, 165216}, {31, 128, 128, 165216, 169312}};
constexpr int NSLOT = 12;

struct CvtItem { const float* src; bf16_t* dst; const float* gain; int Nsrc, K; };
__device__ __forceinline__ void cvt_load(const CvtItem& c, int lane, f32x4 (&v)[8]) {
    const float* p = c.src + (size_t)(8 * (lane >> 3)) * c.Nsrc + 4 * (lane & 7);
#pragma unroll
    for (int j = 0; j < 8; ++j) v[j] = __builtin_nontemporal_load((const f32x4*)(p + (size_t)j * c.Nsrc));
}
__device__ __forceinline__ void cvt_store(const CvtItem& c, int lane, const f32x4 (&v)[8]) {
    f32x4 g0 = (f32x4){1.f, 1.f, 1.f, 1.f}, g1 = g0;
    if (c.gain) { g0 = *(const f32x4*)(c.gain + 8 * (lane >> 3)); g1 = *(const f32x4*)(c.gain + 8 * (lane >> 3) + 4); }
    bf16_t* q = c.dst + (size_t)(4 * (lane & 7)) * c.K + 8 * (lane >> 3);
#pragma unroll
    for (int e = 0; e < 4; ++e) {
        u32x4 o; o.x = pk2(v[0][e] * g0[0], v[1][e] * g0[1]); o.y = pk2(v[2][e] * g0[2], v[3][e] * g0[3]); o.z = pk2(v[4][e] * g1[0], v[5][e] * g1[1]); o.w = pk2(v[6][e] * g1[2], v[7][e] * g1[3]);
        __builtin_nontemporal_store(o, (u32x4*)(q + (size_t)e * c.K));
    }
}

#define XB_TMO      128
#define XB_XCNT(j)  (256  + 64 * (j))
#define XB_XSUB(j)  (1280 + 64 * (j))
#define XB_XGEN(j)  (2304 + 64 * (j))
#define XB_TOP      3328
#define XB_TOPGEN   3392
#define XCD_BAR_WORDS 3456
#define XB_SPIN_CAP (1u << 18)
__device__ __forceinline__ unsigned xb_ld(unsigned* p)              { return __hip_atomic_load(p, __ATOMIC_RELAXED, __HIP_MEMORY_SCOPE_AGENT); }
__device__ __forceinline__ unsigned xb_add(unsigned* p, unsigned v) { return __hip_atomic_fetch_add(p, v, __ATOMIC_RELAXED, __HIP_MEMORY_SCOPE_AGENT); }
__device__ __forceinline__ unsigned xb_xcc_id() { return (unsigned)__builtin_amdgcn_s_getreg((3 << 11) | 20) & 0xFu; }
#define XB_SPIN(cond, bar) do { unsigned _sp = 0; while (cond) { __builtin_amdgcn_s_sleep(1); \
    if ((++_sp & 255u) == 0u) { if (xb_ld(&(bar)[XB_TMO])) break; if (_sp > XB_SPIN_CAP) { atomicAdd(&(bar)[XB_TMO], 1u); break; } } } } while (0)
struct XcdBarrier { unsigned* bar; unsigned x; volatile LAS unsigned* st; };
__device__ __forceinline__ XcdBarrier xcd_barrier_post(unsigned* bar, volatile LAS unsigned* st) {
    XcdBarrier b; b.bar = bar; b.x = xb_xcc_id(); b.st = st;
    if (threadIdx.x == 0) (void)xb_add(&bar[XB_XCNT(b.x)], 1u);
    return b;
}
__device__ __forceinline__ void xcd_barrier_complete(unsigned* bar, unsigned x, unsigned& nloc, unsigned& nx) {
    const unsigned G = gridDim.x * gridDim.y * gridDim.z;
    unsigned sum, cnt, mine, sp = 0u;
    for (;;) {
        sum = 0u; cnt = 0u; mine = 0u;
#pragma unroll
        for (unsigned j = 0; j < 16; ++j) { const unsigned c = xb_ld(&bar[XB_XCNT(j)]); sum += c; cnt += (c > 0u) ? 1u : 0u; mine = (j == x) ? c : mine; }
        if (sum == G) break;
        __builtin_amdgcn_s_sleep(1);
        if ((++sp & 255u) == 0u) { if (xb_ld(&bar[XB_TMO])) break; if (sp > XB_SPIN_CAP) { atomicAdd(&bar[XB_TMO], 1u); break; } }
    }
    nloc = mine > 0u ? mine : 1u; nx = cnt > 0u ? cnt : 1u;
}
__device__ __forceinline__ void xcd_barrier(const XcdBarrier& b) {
    asm volatile("s_waitcnt vmcnt(0)" ::: "memory");
    __syncthreads();
    if (threadIdx.x == 0) {
        unsigned* bar = b.bar;
        __builtin_amdgcn_s_waitcnt(0);
        unsigned nloc = b.st[0], nx = b.st[1];
        if (nloc == 0u) { xcd_barrier_complete(bar, b.x, nloc, nx); b.st[0] = nloc; b.st[1] = nx; }
        const unsigned old = xb_add(&bar[XB_XSUB(b.x)], 1u);
        const unsigned gen = old / nloc;
        if (old + 1u == (gen + 1u) * nloc) {
            __builtin_amdgcn_fence(__ATOMIC_RELEASE, "agent");
            asm volatile("s_waitcnt vmcnt(0)" ::: "memory");
            const unsigned og = xb_add(&bar[XB_TOP], 1u);
            const unsigned tg = og / nx;
            if (og + 1u == (tg + 1u) * nx) xb_add(&bar[XB_TOPGEN], 1u);
            else XB_SPIN(xb_ld(&bar[XB_TOPGEN]) == tg, bar);
            __builtin_amdgcn_fence(__ATOMIC_ACQUIRE, "agent");
            xb_add(&bar[XB_XGEN(b.x)], 1u);
            asm volatile("s_waitcnt vmcnt(0)" ::: "memory");
        } else {
            XB_SPIN(xb_ld(&bar[XB_XGEN(b.x)]) == gen, bar);
            __builtin_amdgcn_fence(__ATOMIC_ACQUIRE, "agent");
            asm volatile("s_waitcnt vmcnt(0)" ::: "memory");
        }
    }
    __syncthreads();
}

constexpr int RING_BYTES = 131072, LDSCTL_OFF = RING_BYTES, LDS_BYTES = 147456;
constexpr int CW_BAR = 4096;
constexpr int NPHASES = 33;

struct Args { const float* in[N_INPUTS]; float* out; unsigned char* ws; int ph_lo, ph_hi; };
static_assert(sizeof(Args) == N_INPUTS * 8 + 8 + 8 + 8, "Args has no padding");

__device__ __forceinline__ CvtItem cvt_item(const Args& args, unsigned char* ws, int it, int& sg) {
    while (sg + 1 < NSEG && it >= SEGS[sg + 1].start) ++sg;
    const Seg s = SEGS[sg];
    const int nbc = s.ncols / 32, rr = it - s.start, kb = rr / nbc, nb = rr % nbc, n = 32 * nb;
    const int drow = s.drow0 + (s.inter ? (((n >> 7) << 8) + (n & 127)) : n);
    CvtItem c;
    c.src = args.in[s.in_idx] + s.src_off + (size_t)(64 * kb) * s.Nsrc + s.col0 + n;
    c.dst = (bf16_t*)(ws + (size_t)s.dst_mib * MiB) + (size_t)drow * s.K + 64 * kb;
    c.gain = s.gain_idx >= 0 ? args.in[s.gain_idx] + s.gain_off + 64 * kb : nullptr;
    c.Nsrc = s.Nsrc; c.K = s.K;
    return c;
}
__device__ __forceinline__ void convert_range(const Args& args, unsigned char* ws, int it0, int it1, int widx, int nw, int lane) {
    int sg = 0;
    int it = it0 + widx;
    for (; it + nw < it1; it += 2 * nw) {
        const CvtItem a = cvt_item(args, ws, it, sg); const CvtItem b = cvt_item(args, ws, it + nw, sg);
        f32x4 va[8], vb[8];
        cvt_load(a, lane, va); cvt_load(b, lane, vb);
        cvt_store(a, lane, va); cvt_store(b, lane, vb);
    }
    if (it < it1) { const CvtItem a = cvt_item(args, ws, it, sg); f32x4 va[8]; cvt_load(a, lane, va); cvt_store(a, lane, va); }
}

__global__ void __launch_bounds__(512, 2) trunk_fwd(Args args) {
    extern __shared__ __attribute__((aligned(16))) unsigned char lds_raw[];
    LAS unsigned char* lds = (LAS unsigned char*)lds_raw;
    const int tid = threadIdx.x, wave = __builtin_amdgcn_readfirstlane(tid >> 6);
    const int G = gridDim.x, bx = blockIdx.x;
    const int vcu = (G % 8 == 0) ? (bx % 8) * (G / 8) + bx / 8 : bx;
    const int gw = vcu * 8 + wave, NGW = G * 8, NT = NGW * 64;
    const bool plan_ok = (G == 256);
#define LANE_ ({ int t_ = threadIdx.x; asm volatile("" : "+v"(t_)); t_ & 63; })
#define GT_ (gw * 64 + LANE_)
    unsigned char* ws = args.ws;
    const int lo = args.ph_lo, hi = args.ph_hi;
    for (int u = tid; u < (LDS_BYTES - LDSCTL_OFF) / 4; u += 512) ((LAS unsigned*)(lds + LDSCTL_OFF))[u] = 0u;
    __syncthreads();
    XcdBarrier bar; bar.bar = (unsigned*)(ws + WS_CTL) + CW_BAR; bar.x = 0; bar.st = nullptr;
    if (hi - lo > 1) bar = xcd_barrier_post((unsigned*)(ws + WS_CTL) + CW_BAR, (volatile LAS unsigned*)(lds + LDSCTL_OFF + 64));

    float* PSUM = (float*)(ws + WS_PSUM); float* UPS = (float*)(ws + WS_UPS); float* PSMEM = (float*)(ws + WS_PSMEM); float* CB = (float*)(ws + WS_CB);
    bf16_t* XB = (bf16_t*)(ws + WS_XB); bf16_t* XL = (bf16_t*)(ws + WS_XL); bf16_t* MEMB = (bf16_t*)(ws + WS_MEMB); bf16_t* MKV = (bf16_t*)(ws + WS_MKV); bf16_t* MK = (bf16_t*)(ws + WS_MK); bf16_t* MVT = (bf16_t*)(ws + WS_MVT);
    bf16_t* CAT = (bf16_t*)(ws + WS_CAT); bf16_t* HID = (bf16_t*)(ws + WS_HID); bf16_t* U = (bf16_t*)(ws + WS_U); bf16_t* QM = (bf16_t*)(ws + WS_QM); bf16_t* KVM = (bf16_t*)(ws + WS_KVM);
    bf16_t* KBUF = (bf16_t*)(ws + WS_KBUF); bf16_t* VTBUF = (bf16_t*)(ws + WS_VTBUF);
    float* OUT = args.out;

#define PH(id) if (lo <= (id) && (id) < hi)
#define BAR(id) do { if (lo <= (id) && (id) + 1 < hi) xcd_barrier(bar); } while (0)
#define GEMM_PHASE_C(EPI_T, E_INIT, Aptr, Bptr, M_, N_, K_, LDA_, C_) do { pg8::Gemm g_{(Aptr), (Bptr), (M_), (N_), (K_), (LDA_)}; pg8::StaticOrder S_; S_.init((M_), (N_), G, (C_)); \
        EPI_T E_ E_INIT; pg8::gemm_phase<EPI_T, pg8::StaticOrder, true>(lds, g_, S_, E_); } while (0)
#define GEMM_PHASE(EPI_T, E_INIT, Aptr, Bptr, M_, N_, K_, LDA_) do { pg8::Gemm g_{(Aptr), (Bptr), (M_), (N_), (K_), (LDA_)}; pg8::StaticOrder S_; S_.init((M_), (N_), G, bx); \
        EPI_T E_ E_INIT; pg8::gemm_phase<EPI_T, pg8::StaticOrder, true>(lds, g_, S_, E_); } while (0)
#define COMMA ,
#define TAIL_SLOT(k, id) do { static_assert(SLOTS[k].phase == (id), "slot/phase"); if (plan_ok && bx >= SLOTS[k].blk0) \
        convert_range(args, ws, SLOTS[k].it0, SLOTS[k].it1, (bx - SLOTS[k].blk0) * 8 + wave, SLOTS[k].nblk * 8, LANE_); } while (0)

    PH(0) {
        convert_range(args, ws, 0, plan_ok ? P0_ITEMS : NITEMS, gw, NGW, LANE_);
        rowinit_items(args.in[I_X], XB, PSUM, MTOK, gw, NGW, LANE_);
        rowinit_items(args.in[I_MEM], MEMB, PSMEM, MMEM, gw, NGW, LANE_);
        { u32x4* z1 = (u32x4*)(ws + WS_WIN1 + (size_t)1600 * D_MODEL * 2); const int n1 = 192 * D_MODEL * 2 / 16; for (int i = GT_; i < n1; i += NT) z1[i] = (u32x4){0u, 0u, 0u, 0u};
          u32x4* z3 = (u32x4*)(ws + WS_WIN3 + (size_t)6688 * D_MODEL * 2); const int n3 = 224 * D_MODEL * 2 / 16; for (int i = GT_; i < n3; i += NT) z3[i] = (u32x4){0u, 0u, 0u, 0u}; }
    }
    BAR(0);

#define GU_PHASE(id, L, WHICH) PH(id) GEMM_PHASE(pg8::EpiSwiGLU, {HID COMMA PSUM}, XB, (const bf16_t*)(ws + WS_WGU + (size_t)(2 * (L) + (WHICH)) * WGU_BYTES), MTOK, N_GU, D_MODEL, D_MODEL)
#define DN_PHASE(id, L, WHICH, RMODE) PH(id) GEMM_PHASE(pg8::EpiResid<RMODE>, {args.in[I_X] COMMA OUT COMMA XB COMMA XL COMMA PSUM COMMA 0.5f}, HID, (const bf16_t*)(ws + WS_WD + (size_t)(2 * (L) + (WHICH)) * WD_BYTES), MTOK, D_MODEL, D_FF, D_FF); BAR(id)
#define OUT_PHASE(id, L) PH(id) GEMM_PHASE(pg8::EpiResid<1>, {args.in[I_X] COMMA OUT COMMA XB COMMA XL COMMA PSUM COMMA 1.0f}, CAT, (const bf16_t*)(ws + WS_WOUT + (size_t)(L) * WOUT_BYTES), MTOK, D_MODEL, K_OUT, K_OUT); BAR(id)
#define MEM_FA(L, UPITCH, MQCOL) do { FaArgs fa_; fa_.Q = U; fa_.q_pitch = (UPITCH); fa_.q_col0 = (MQCOL); fa_.q_hstride = 128; fa_.K = MK + (size_t)(L) * 16 * 256 * 128; fa_.Vt = MVT + (size_t)(L) * 16 * 128 * 256; \
        fa_.Skv = MEM_LEN; fa_.kv_group = 1; fa_.nheads = 4; fa_.O = CAT; fa_.o_pitch = K_OUT; fa_.o_col0 = 2048; fa_.qgain = args.in[I_MEM_QN] + (L) * 128; fa_.bias = nullptr; fa_.sinks = nullptr; \
        fa_.qscale = 0.08838834764831845f * LOG2E; \
        for (int i_ = bx; i_ < 16 * 8; i_ += G) fa_unit<128, 128, 3>(lds, fa_, (i_ >> 3) >> 2, (i_ >> 3) & 3, i_ & 7); } while (0)

    PH(1) {
        GEMM_PHASE(pg8::EpiSwiGLU, {HID COMMA PSUM}, XB, (const bf16_t*)(ws + WS_WGU), MTOK, N_GU, D_MODEL, D_MODEL);
        GEMM_PHASE_C(pg8::EpiScale<32 COMMA false>, {MKV COMMA 4096 COMMA PSMEM COMMA 32 COMMA 0 COMMA 1.0f / D_MODEL COMMA nullptr}, MEMB, (const bf16_t*)(ws + WS_WMKV), MMEM, 4096, D_MODEL, D_MODEL, plan_ok ? ((bx + 128) & 255) : bx);
        TAIL_SLOT(0, 1);
    }
    BAR(1);
    DN_PHASE(2, 0, 0, 0);
    PH(3) {
        GEMM_PHASE(pg8::EpiScale<32 COMMA false>, {U COMMA NIN0 COMMA PSUM COMMA 32 COMMA 0 COMMA 1.0f / D_MODEL COMMA nullptr}, XB, (const bf16_t*)(ws + WS_WIN0), MTOK, NIN0, D_MODEL, D_MODEL);
        if (!plan_ok || bx >= 64) {
            const int widx = plan_ok ? (bx - 64) * 8 + wave : gw, nw = plan_ok ? 192 * 8 : NGW;
            for (int L = 0; L < 4; ++L) {
                headnorm_items<128>(MKV, 4096, L * 1024, 128, 4, args.in[I_MEM_KN] + L * 128, MK + (size_t)L * 16 * 256 * 128, 128, 0, MEM_LEN, MMEM, widx, nw, LANE_);
                vtrans_items(MKV, 4096, L * 1024 + 512, 128, 4, 128, MVT + (size_t)L * 16 * 128 * 256, MEM_LEN, BATCH, lds + wave * 8448, widx, nw, LANE_);
            }
        }
        TAIL_SLOT(1, 3);
    }
    BAR(3);
    PH(4) { conv_items(U, args.in[I_CONV_W], CAT, GT_, NT); MEM_FA(0, NIN0, 6144); }
    BAR(4);
    OUT_PHASE(5, 0);
    PH(6) { GEMM_PHASE(pg8::EpiSwiGLU, {HID COMMA PSUM}, XB, (const bf16_t*)(ws + WS_WGU + (size_t)1 * WGU_BYTES), MTOK, N_GU, D_MODEL, D_MODEL); TAIL_SLOT(2, 6); }
    BAR(6);
    DN_PHASE(7, 0, 1, 1);

    PH(8) { GEMM_PHASE(pg8::EpiSwiGLU, {HID COMMA PSUM}, XB, (const bf16_t*)(ws + WS_WGU + (size_t)2 * WGU_BYTES), MTOK, N_GU, D_MODEL, D_MODEL); TAIL_SLOT(3, 8); }
    BAR(8);
    DN_PHASE(9, 1, 0, 1);
    PH(10) { GEMM_PHASE(pg8::EpiScale<32 COMMA true>, {U COMMA NIN1 COMMA PSUM COMMA 32 COMMA 0 COMMA 1.0f / D_MODEL COMMA UPS}, XB, (const bf16_t*)(ws + WS_WIN1), MTOK, NIN1, D_MODEL, D_MODEL); TAIL_SLOT(4, 10); }
    BAR(10);
    PH(11) {
        GEMM_PHASE(pg8::EpiScale<8 COMMA false>, {QM COMMA 3072 COMMA UPS COMMA 32 COMMA 0 COMMA 1.0f / 512.0f COMMA nullptr}, U, (const bf16_t*)(ws + WS_WQB), MTOK, 3072, 512, NIN1);
        GEMM_PHASE(pg8::EpiScale<8 COMMA false>, {KVM COMMA 4096 COMMA UPS COMMA 32 COMMA 8 COMMA 1.0f / 512.0f COMMA nullptr}, U + 512, (const bf16_t*)(ws + WS_WKVB), MTOK, 4096, 512, NIN1);
    }
    BAR(11);
    PH(12) {
        headnorm_items<128>(KVM, 4096, 0, 256, 16, args.in[I_MLA_KN], KBUF, 192, 0, SEQ, MTOK, gw, NGW, LANE_);
        mla_krope_items(U, NIN1, 1536, args.in[I_MLA_KN] + 128, KBUF, gw, NGW, LANE_);
        vtrans_items(KVM, 4096, 128, 256, 16, 128, VTBUF, SEQ, BATCH, lds + wave * 8448, gw, NGW, LANE_);
    }
    BAR(12);
    PH(13) {
        FaArgs fa; fa.Q = QM; fa.q_pitch = 3072; fa.q_col0 = 0; fa.q_hstride = 192; fa.K = KBUF; fa.Vt = VTBUF; fa.Skv = SEQ; fa.kv_group = 1; fa.nheads = 16;
        fa.O = CAT; fa.o_pitch = K_OUT; fa.o_col0 = 0; fa.qgain = args.in[I_MLA_QN]; fa.bias = nullptr; fa.sinks = nullptr; fa.qscale = 0.07216878364870323f * LOG2E;
        for (int j = bx; j < 64 * 4; j += G) { const int bh = j >> 2, q4 = j & 3; for (int k = 0; k < 2; ++k) fa_unit<192, 128, 0>(lds, fa, bh >> 4, bh & 15, k ? q4 : 7 - q4); }
        MEM_FA(1, NIN1, 1024);
    }
    BAR(13);
    OUT_PHASE(14, 1);
    PH(15) { GEMM_PHASE(pg8::EpiSwiGLU, {HID COMMA PSUM}, XB, (const bf16_t*)(ws + WS_WGU + (size_t)3 * WGU_BYTES), MTOK, N_GU, D_MODEL, D_MODEL); TAIL_SLOT(5, 15); }
    BAR(15);
    DN_PHASE(16, 1, 1, 1);

    PH(17) { GEMM_PHASE(pg8::EpiSwiGLU, {HID COMMA PSUM}, XB, (const bf16_t*)(ws + WS_WGU + (size_t)4 * WGU_BYTES), MTOK, N_GU, D_MODEL, D_MODEL); TAIL_SLOT(6, 17); }
    BAR(17);
    DN_PHASE(18, 2, 0, 1);
    PH(19) { GEMM_PHASE(pg8::EpiScale<32 COMMA false>, {U COMMA NIN2 COMMA PSUM COMMA 32 COMMA 0 COMMA 1.0f / D_MODEL COMMA nullptr}, XB, (const bf16_t*)(ws + WS_WIN2), MTOK, NIN2, D_MODEL, D_MODEL); TAIL_SLOT(7, 19); }
    BAR(19);
    PH(20) {
        headnorm_items<64>(U, NIN2, 2048, 64, 4, args.in[I_SWA_KN], KBUF, 64, 0, SEQ, MTOK, gw, NGW, LANE_);
        vtrans_items(U, NIN2, 2304, 64, 4, 64, VTBUF, SEQ, BATCH, lds + wave * 8448, gw, NGW, LANE_);
    }
    BAR(20);
    PH(21) {
        FaArgs fa; fa.Q = U; fa.q_pitch = NIN2; fa.q_col0 = 0; fa.q_hstride = 64; fa.K = KBUF; fa.Vt = VTBUF; fa.Skv = SEQ; fa.kv_group = 8; fa.nheads = 32;
        fa.O = CAT; fa.o_pitch = K_OUT; fa.o_col0 = 0; fa.qgain = args.in[I_SWA_QN]; fa.bias = args.in[I_REL_BIAS]; fa.sinks = args.in[I_SWA_SINKS]; fa.qscale = 0.125f * LOG2E;
        for (int i = bx; i < 128 * 8; i += G) { const int bh = i >> 3; fa_unit<64, 64, 1>(lds, fa, bh >> 5, bh & 31, i & 7); }
        MEM_FA(2, NIN2, 2560);
    }
    BAR(21);
    OUT_PHASE(22, 2);
    PH(23) { GEMM_PHASE(pg8::EpiSwiGLU, {HID COMMA PSUM}, XB, (const bf16_t*)(ws + WS_WGU + (size_t)5 * WGU_BYTES), MTOK, N_GU, D_MODEL, D_MODEL); TAIL_SLOT(8, 23); }
    BAR(23);
    DN_PHASE(24, 2, 1, 1);

    PH(25) { GEMM_PHASE(pg8::EpiSwiGLU, {HID COMMA PSUM}, XB, (const bf16_t*)(ws + WS_WGU + (size_t)6 * WGU_BYTES), MTOK, N_GU, D_MODEL, D_MODEL); TAIL_SLOT(9, 25); }
    BAR(25);
    DN_PHASE(26, 3, 0, 1);
    PH(27) { GEMM_PHASE(pg8::EpiScale<32 COMMA false>, {U COMMA NIN3 COMMA PSUM COMMA 32 COMMA 0 COMMA 1.0f / D_MODEL COMMA nullptr}, XB, (const bf16_t*)(ws + WS_WIN3), MTOK, NIN3, D_MODEL, D_MODEL); TAIL_SLOT(10, 27); }
    BAR(27);
    PH(28) {
        headnorm_items<64>(U, NIN3, 2048, 64, 32, args.in[I_FOX_KN], KBUF, 64, 0, SEQ, MTOK, gw, NGW, LANE_);
        vtrans_items(U, NIN3, 4096, 64, 32, 64, VTBUF, SEQ, BATCH, lds + wave * 8448, gw, NGW, LANE_);
        fox_scan_items(U, NIN3, 6656, args.in[I_FOX_BF], CB, gw, NGW, LANE_);
    }
    BAR(28);
    PH(29) {
        FaArgs fa; fa.Q = U; fa.q_pitch = NIN3; fa.q_col0 = 0; fa.q_hstride = 64; fa.K = KBUF; fa.Vt = VTBUF; fa.Skv = SEQ; fa.kv_group = 1; fa.nheads = 32;
        fa.O = CAT; fa.o_pitch = K_OUT; fa.o_col0 = 0; fa.qgain = args.in[I_FOX_QN]; fa.bias = CB; fa.sinks = nullptr; fa.qscale = 0.125f * LOG2E;
        for (int j = bx; j < 128 * 4; j += G) { const int bh = j >> 2, q4 = j & 3; for (int k = 0; k < 2; ++k) fa_unit<64, 64, 2>(lds, fa, bh >> 5, bh & 31, k ? q4 : 7 - q4); }
        MEM_FA(3, NIN3, 6144);
    }
    BAR(29);
    OUT_PHASE(30, 3);
    PH(31) { GEMM_PHASE(pg8::EpiSwiGLU, {HID COMMA PSUM}, XB, (const bf16_t*)(ws + WS_WGU + (size_t)7 * WGU_BYTES), MTOK, N_GU, D_MODEL, D_MODEL); TAIL_SLOT(11, 31); }
    BAR(31);
    DN_PHASE(32, 3, 1, 2);
}

extern "C" void kernel_launch(void* const* d_in, const int* in_sizes, int n_in, void* d_out, int out_size, void* d_ws, size_t ws_size, hipStream_t stream) {
    static int grid = 0;
    if (grid == 0) {
        if (n_in != N_INPUTS || out_size != MTOK * D_MODEL || ws_size < WS_END) { fprintf(stderr, "kernel_launch: unexpected problem: n_in %d out %d ws %zu (need %zu)\n", n_in, out_size, ws_size, (size_t)WS_END); grid = -1; return; }
        int dev = 0, cus = 0, per_cu = 0;
        if (hipGetDevice(&dev) != hipSuccess || hipDeviceGetAttribute(&cus, hipDeviceAttributeMultiprocessorCount, dev) != hipSuccess) { grid = -1; return; }
        if (hipFuncSetAttribute((const void*)trunk_fwd, hipFuncAttributeMaxDynamicSharedMemorySize, LDS_BYTES) != hipSuccess) { fprintf(stderr, "kernel_launch: hipFuncSetAttribute failed\n"); grid = -1; return; }
        if (hipOccupancyMaxActiveBlocksPerMultiprocessor(&per_cu, (const void*)trunk_fwd, 512, LDS_BYTES) != hipSuccess || per_cu < 1)
            fprintf(stderr, "kernel_launch: note: occupancy query reports %d workgroups per CU\n", per_cu);
        (void)hipGetLastError();
        grid = cus;
    }
    if (grid < 0) return;
    if (hipMemsetAsync((char*)d_ws + WS_CTL, 0, CTL_ZERO_BYTES, stream) != hipSuccess) { fprintf(stderr, "kernel_launch: memset failed\n"); return; }
    Args a{};
    for (int i = 0; i < N_INPUTS; ++i) a.in[i] = (const float*)d_in[i];
    a.out = (float*)d_out; a.ws = (unsigned char*)d_ws;
#if MK_ONE_LAUNCH
    a.ph_lo = 0; a.ph_hi = NPHASES;
    hipLaunchKernelGGL(trunk_fwd, dim3(grid), dim3(512), LDS_BYTES, stream, a);
#else
    for (int p = 0; p < NPHASES; ++p) { a.ph_lo = p; a.ph_hi = p + 1; hipLaunchKernelGGL(trunk_fwd, dim3(grid), dim3(512), LDS_BYTES, stream, a); }
#endif
    const hipError_t le = hipPeekAtLastError();
    if (le != hipSuccess) fprintf(stderr, "kernel_launch: launch failed: %s\n", hipGetErrorName(le));
}
```

```cpp
#include <hip/hip_runtime.h>
#include <cstdio>
#include <cstdint>

#ifndef MK_ONE_LAUNCH
#define MK_ONE_LAUNCH 1
#endif

#ifndef PROBE_SEC
#define PROBE_SEC 0
#endif
#ifndef PROBE_ARG
#define PROBE_ARG 0
#endif
#define PROBE_K 8
#define PT_NOW() ((unsigned long long)__builtin_amdgcn_s_memrealtime())

#define LAS __attribute__((address_space(3)))
typedef unsigned short bf16_t;
typedef short bf16x8 __attribute__((ext_vector_type(8)));
typedef float f32x4 __attribute__((ext_vector_type(4)));
typedef float f32x16 __attribute__((ext_vector_type(16)));
typedef unsigned u32x4 __attribute__((ext_vector_type(4)));
typedef unsigned u32x2 __attribute__((ext_vector_type(2)));

constexpr int D_MODEL = 2048, BATCH = 4, SEQ = 2048, MTOK = BATCH * SEQ, D_FF = 5632, MEM_LEN = 256, MMEM = BATCH * MEM_LEN;
constexpr int N_GU = 2 * D_FF;
constexpr int NIN0 = 6656, NIN1 = 1792, NIN2 = 3072, NIN3 = 6912;
constexpr int K_OUT = 2560;
constexpr float RMS_EPS = 1e-6f;
constexpr float LOG2E = 1.4426950408889634f;

constexpr size_t MiB = 1u << 20;
constexpr size_t WS_CTL = 0, CTL_ZERO_BYTES = 1 * MiB;
constexpr size_t WS_PSUM = 1 * MiB, WS_UPS = 2 * MiB, WS_PSMEM = 3 * MiB, WS_CB = 4 * MiB;
constexpr size_t WS_XB = 8 * MiB, WS_MEMB = 40 * MiB, WS_MKV = 44 * MiB, WS_MK = 52 * MiB, WS_MVT = 56 * MiB;
constexpr size_t WS_CAT = 60 * MiB, WS_HID = 100 * MiB, WS_U = 188 * MiB, WS_QM = 296 * MiB, WS_KVM = 344 * MiB;
constexpr size_t WS_KBUF = 408 * MiB, WS_VTBUF = 456 * MiB;
constexpr size_t WS_WGU = 488 * MiB;
constexpr size_t WS_WD = 840 * MiB;
constexpr size_t WS_WIN0 = 1016 * MiB, WS_WIN1 = 1042 * MiB, WS_WIN2 = 1049 * MiB, WS_WIN3 = 1061 * MiB;
constexpr size_t WS_WOUT = 1088 * MiB;
constexpr size_t WS_WQB = 1128 * MiB, WS_WKVB = 1131 * MiB, WS_WMKV = 1135 * MiB, WS_XL = 1151 * MiB, WS_END = 1183 * MiB;
constexpr size_t WGU_BYTES = (size_t)N_GU * D_MODEL * 2, WD_BYTES = (size_t)D_MODEL * D_FF * 2, WOUT_BYTES = (size_t)D_MODEL * K_OUT * 2;
static_assert(WGU_BYTES == 44 * MiB && WD_BYTES == 22 * MiB && WOUT_BYTES == 10 * MiB, "weight sizes");

enum { I_X = 0, I_MEM, I_NORM_FFN1, I_F1G, I_F1U, I_F1D, I_NORM_MIX, I_NORM_FFN2, I_F2G, I_F2U, I_F2D, I_NORM_MEM, I_MEM_WKV, I_MEM_QN, I_MEM_KN,
       I_CONV_WIN, I_CONV_W, I_CONV_WOUT, I_MLA_WIN, I_MLA_QAN, I_MLA_WQB, I_MLA_KVAN, I_MLA_WKVB, I_MLA_QN, I_MLA_KN, I_MLA_WOUT,
       I_SWA_WIN, I_SWA_QN, I_SWA_KN, I_SWA_SINKS, I_SWA_WOUT, I_REL_BIAS, I_FOX_WIN, I_FOX_BF, I_FOX_QN, I_FOX_KN, I_FOX_WOUT, N_INPUTS };

__device__ __forceinline__ unsigned pk2(float lo, float hi) {
    typedef __bf16 b2 __attribute__((ext_vector_type(2))); typedef float f2 __attribute__((ext_vector_type(2)));
    return __builtin_bit_cast(unsigned, __builtin_convertvector((f2){lo, hi}, b2)); }
__device__ __forceinline__ float bf_lo(unsigned w) { return __uint_as_float(w << 16); }
__device__ __forceinline__ float bf_hi(unsigned w) { return __uint_as_float(w & 0xffff0000u); }
__device__ __forceinline__ void unpack8(const u32x4 v, float (&f)[8]) {
    f[0] = bf_lo(v.x); f[1] = bf_hi(v.x); f[2] = bf_lo(v.y); f[3] = bf_hi(v.y); f[4] = bf_lo(v.z); f[5] = bf_hi(v.z); f[6] = bf_lo(v.w); f[7] = bf_hi(v.w); }
__device__ __forceinline__ u32x4 pack8(const float (&f)[8]) { u32x4 o; o.x = pk2(f[0], f[1]); o.y = pk2(f[2], f[3]); o.z = pk2(f[4], f[5]); o.w = pk2(f[6], f[7]); return o; }
#define GAS __attribute__((address_space(1)))
__device__ __forceinline__ const GAS char* uni_ptr(const char* p) {
    const unsigned long long v = (unsigned long long)p; const unsigned lo = __builtin_amdgcn_readfirstlane((unsigned)v), hi = __builtin_amdgcn_readfirstlane((unsigned)(v >> 32));
    return (const GAS char*)(((unsigned long long)hi << 32) | lo); }
__device__ __forceinline__ float xor32_sum(float x) {
    const auto rr = __builtin_amdgcn_permlane32_swap(__float_as_uint(x), __float_as_uint(x), false, false);
    return __uint_as_float(rr[0]) + __uint_as_float(rr[1]); }
template <int CTRL> __device__ __forceinline__ float dpp_f(float x) { return __int_as_float(__builtin_amdgcn_update_dpp(0, __float_as_int(x), CTRL, 0xF, 0xF, true)); }
template <int N> __device__ __forceinline__ float group_sum(float s) {
    s += dpp_f<0xB1>(s); s += dpp_f<0x4E>(s); s += dpp_f<0x141>(s);
    if constexpr (N == 16) s += dpp_f<0x140>(s);
    return s;
}
__device__ __forceinline__ float rope_invf_turns(int i) {
    return __builtin_amdgcn_exp2f(-(float)i * (13.287712379549449f / 32.0f)) * 0.15915494309189535f; }
__device__ __forceinline__ void rope_cs(int pos, int i, float& c, float& s) {
    float t = (float)pos * rope_invf_turns(i); t = t - floorf(t); c = __builtin_amdgcn_cosf(t); s = __builtin_amdgcn_sinf(t); }

namespace pg8 {
constexpr int BM = 256, BK = 64, HALF = 128, HTB = HALF * BK * 2, STAGE_BYTES = 8 * HTB, NXCD = 8, WGM = 8;
__host__ __device__ __forceinline__ int lds_byte(int r, int c) { const int st = (r >> 4) * 2 + (c >> 5), rr = r & 15, cc = c & 31, ob = rr * 64 + cc * 2; return st * 1024 + (ob ^ (((ob >> 9) & 1) << 5)); }
__host__ __device__ __forceinline__ void stage_rc(int b, int& R, int& C) { const int st = b / 1024, sb = b % 1024, swz = sb ^ (((sb >> 9) & 1) << 5); R = (st >> 1) * 16 + swz / 64; C = (st & 1) * 32 + (swz % 64) / 2; }
__host__ __device__ __forceinline__ int perm32(int rho) { const int n = rho >> 4, i = rho & 15; return 8 * (i >> 2) + 4 * n + (i & 3); }
struct Unit { int pm, pn; };
struct Gemm { const bf16_t* A; const bf16_t* Bt; int M, N, K, lda; };
struct StaticOrder {
    int nM, nN, nwg, G, c;
    __host__ __device__ void init(int M, int N, int G_, int c_) { nM = M / BM; nN = N / BM; nwg = nM * nN; G = G_; c = c_; }
    __host__ __device__ bool next(int i, Unit& u) const {
        const long L = (long)i * G + c; if (L >= nwg) return false;
        int wgid = (int)L; { const int q = nwg / NXCD, r = nwg % NXCD, xcd = wgid % NXCD, off = wgid / NXCD; wgid = (xcd < r ? xcd * (q + 1) : r * (q + 1) + (xcd - r) * q) + off; }
        const int nig = WGM * nN, gid = wgid / nig, fm = gid * WGM, gsz = (nM - fm) < WGM ? (nM - fm) : WGM;
        u.pm = fm + ((wgid % nig) % gsz); u.pn = (wgid % nig) / gsz; return true;
    }
    __device__ __forceinline__ void a_ready(const Unit&) const {}
    __device__ __forceinline__ void done(const Unit&) const {}
};

struct EpiCtx { LAS float* tab; int parity; bool has_next; int nxt_pm; int tid; };
template <int CNT> struct RstdPf {
    f32x4 v[CNT / 4];
    __device__ __forceinline__ void issue(const float* ps, int pitch, int off, int row) {
        const float* p = ps + (size_t)row * pitch + off;
#pragma unroll
        for (int i = 0; i < CNT / 4; ++i) v[i] = *(const f32x4*)(p + 4 * i);
    }
    __device__ __forceinline__ float finish(float inv_dim) const {
        float s = 0.f;
#pragma unroll
        for (int i = 0; i < CNT / 4; ++i) s += (v[i][0] + v[i][1]) + (v[i][2] + v[i][3]);
        return __builtin_amdgcn_rsqf(s * inv_dim + RMS_EPS);
    }
};
__device__ __forceinline__ void tab_rstd(const EpiCtx& c, int wr, int fr, float (&rs)[2][4]) {
#pragma unroll
    for (int ai = 0; ai < 2; ++ai)
#pragma unroll
        for (int m = 0; m < 4; ++m) rs[ai][m] = c.tab[c.parity * 256 + ai * HALF + wr * 64 + m * 16 + fr];
}
__device__ __forceinline__ float silu_mul(float g, float u) { return g * __builtin_amdgcn_rcpf(1.0f + __builtin_amdgcn_exp2f(-g * LOG2E)) * u; }

struct EpiSwiGLU {
    static constexpr bool PERM = true, AFTER_DRAIN = false;
    bf16_t* H; const float* ps;
    __device__ __forceinline__ void prime(const Unit& u, LAS float* tab, int tid) const {
        if (tid < 256) { RstdPf<32> pf; pf.issue(ps, 32, 0, u.pm * BM + tid); tab[tid] = pf.finish(1.0f / D_MODEL); } }
    __device__ __forceinline__ void operator()(const f32x4 (&acc)[2][2][4][2], const Unit& u, int wr, int wc, int fr, int fq, const EpiCtx& c) const {
        const int row0 = u.pm * BM + wr * 64 + fr, col0 = u.pn * 128 + wc * 32 + 8 * fq;
        RstdPf<32> pf; const bool do_pf = c.has_next && c.tid < 256;
        if (do_pf) pf.issue(ps, 32, 0, c.nxt_pm * BM + c.tid);
        float rs[2][4]; tab_rstd(c, wr, fr, rs);
#pragma unroll
        for (int ai = 0; ai < 2; ++ai)
#pragma unroll
            for (int m = 0; m < 4; ++m) {
                const int row = row0 + ai * HALF + m * 16;
                const float r = rs[ai][m];
                const f32x4 g0 = acc[ai][0][m][0] * r, g1 = acc[ai][0][m][1] * r, u0 = acc[ai][1][m][0] * r, u1 = acc[ai][1][m][1] * r;
                u32x4 w;
                w.x = pk2(silu_mul(g0[0], u0[0]), silu_mul(g0[1], u0[1])); w.y = pk2(silu_mul(g0[2], u0[2]), silu_mul(g0[3], u0[3]));
                w.z = pk2(silu_mul(g1[0], u1[0]), silu_mul(g1[1], u1[1])); w.w = pk2(silu_mul(g1[2], u1[2]), silu_mul(g1[3], u1[3]));
                *(u32x4*)(H + (size_t)row * D_FF + col0) = w;
            }
        if (do_pf) c.tab[(c.parity ^ 1) * 256 + c.tid] = pf.finish(1.0f / D_MODEL);
    }
};
template <int MODE> struct EpiResid {
    static constexpr bool PERM = true, AFTER_DRAIN = false;
    const float* base32; float* out32; bf16_t* xh; bf16_t* xl; float* ps; float alpha;
    __device__ __forceinline__ void prime(const Unit&, LAS float*, int) const {}
    __device__ __forceinline__ void load_q(int q, int row0, int col0, f32x4 (&bv)[2][2][2]) const {
#pragma unroll
        for (int mm = 0; mm < 2; ++mm)
#pragma unroll
            for (int bj = 0; bj < 2; ++bj) {
                const size_t o = (size_t)(row0 + (q >> 1) * HALF + (2 * (q & 1) + mm) * 16) * D_MODEL + col0 + bj * HALF;
                if constexpr (MODE == 0) { bv[mm][bj][0] = *(const f32x4*)(base32 + o); bv[mm][bj][1] = *(const f32x4*)(base32 + o + 4); }
                else { const u32x4 h = *(const u32x4*)(xh + o), l = *(const u32x4*)(xl + o);
                       bv[mm][bj][0] = (f32x4){bf_lo(h.x) + bf_lo(l.x), bf_hi(h.x) + bf_hi(l.x), bf_lo(h.y) + bf_lo(l.y), bf_hi(h.y) + bf_hi(l.y)};
                       bv[mm][bj][1] = (f32x4){bf_lo(h.z) + bf_lo(l.z), bf_hi(h.z) + bf_hi(l.z), bf_lo(h.w) + bf_lo(l.w), bf_hi(h.w) + bf_hi(l.w)}; }
            }
    }
    __device__ __forceinline__ void store_q(int q, const f32x4 (&acc)[2][2][4][2], const Unit& u, int row0, int col0, int wc, int fq, const f32x4 (&bv)[2][2][2]) const {
        const int ai = q >> 1;
#pragma unroll
        for (int mm = 0; mm < 2; ++mm) {
            const int m = 2 * (q & 1) + mm, row = row0 + ai * HALF + m * 16; const size_t off = (size_t)row * D_MODEL + col0;
            float ss = 0.f;
#pragma unroll
            for (int bj = 0; bj < 2; ++bj) {
                const f32x4 v0 = bv[mm][bj][0] + acc[ai][bj][m][0] * alpha, v1 = bv[mm][bj][1] + acc[ai][bj][m][1] * alpha;
                if constexpr (MODE == 2) { *(f32x4*)(out32 + off + bj * HALF) = v0; *(f32x4*)(out32 + off + bj * HALF + 4) = v1; }
                else {
                    u32x4 h; h.x = pk2(v0[0], v0[1]); h.y = pk2(v0[2], v0[3]); h.z = pk2(v1[0], v1[1]); h.w = pk2(v1[2], v1[3]);
                    u32x4 l; l.x = pk2(v0[0] - bf_lo(h.x), v0[1] - bf_hi(h.x)); l.y = pk2(v0[2] - bf_lo(h.y), v0[3] - bf_hi(h.y));
                    l.z = pk2(v1[0] - bf_lo(h.z), v1[1] - bf_hi(h.z)); l.w = pk2(v1[2] - bf_lo(h.w), v1[3] - bf_hi(h.w));
                    *(u32x4*)(xh + off + bj * HALF) = h; *(u32x4*)(xl + off + bj * HALF) = l;
                    ss += (v0[0] * v0[0] + v0[1] * v0[1]) + (v0[2] * v0[2] + v0[3] * v0[3]) + (v1[0] * v1[0] + v1[1] * v1[1]) + (v1[2] * v1[2] + v1[3] * v1[3]);
                }
            }
            if constexpr (MODE != 2) { ss += __shfl_xor(ss, 16); ss += __shfl_xor(ss, 32); if (fq == 0) ps[(size_t)row * 32 + u.pn * 4 + wc] = ss; }
        }
    }
    __device__ __forceinline__ void operator()(const f32x4 (&acc)[2][2][4][2], const Unit& u, int wr, int wc, int fr, int fq, const EpiCtx&) const {
        const int row0 = u.pm * BM + wr * 64 + fr, col0 = u.pn * BM + wc * 32 + 8 * fq;
        f32x4 b0[2][2][2], b1[2][2][2];
        load_q(0, row0, col0, b0);
        load_q(1, row0, col0, b1); store_q(0, acc, u, row0, col0, wc, fq, b0);
        load_q(2, row0, col0, b0); store_q(1, acc, u, row0, col0, wc, fq, b1);
        load_q(3, row0, col0, b1); store_q(2, acc, u, row0, col0, wc, fq, b0);
        store_q(3, acc, u, row0, col0, wc, fq, b1);
    }
};
template <int CNT, bool WPS> struct EpiScale {
    static constexpr bool PERM = true, AFTER_DRAIN = false;
    bf16_t* O; int ldo; const float* ps; int ps_pitch, ps_off; float inv_dim; float* ops;
    __device__ __forceinline__ void prime(const Unit& u, LAS float* tab, int tid) const {
        if (tid < 256) { RstdPf<CNT> pf; pf.issue(ps, ps_pitch, ps_off, u.pm * BM + tid); tab[tid] = pf.finish(inv_dim); } }
    __device__ __forceinline__ void operator()(const f32x4 (&acc)[2][2][4][2], const Unit& u, int wr, int wc, int fr, int fq, const EpiCtx& c) const {
        const int row0 = u.pm * BM + wr * 64 + fr, col0 = u.pn * BM + wc * 32 + 8 * fq;
        RstdPf<CNT> pf; const bool do_pf = c.has_next && c.tid < 256;
        if (do_pf) pf.issue(ps, ps_pitch, ps_off, c.nxt_pm * BM + c.tid);
        float rs[2][4]; tab_rstd(c, wr, fr, rs);
#pragma unroll
        for (int ai = 0; ai < 2; ++ai)
#pragma unroll
            for (int m = 0; m < 4; ++m) {
                const int row = row0 + ai * HALF + m * 16;
                const float r = rs[ai][m];
                float ss = 0.f;
#pragma unroll
                for (int bj = 0; bj < 2; ++bj) {
                    const f32x4 v0 = acc[ai][bj][m][0] * r, v1 = acc[ai][bj][m][1] * r;
                    if (WPS) ss += (v0[0] * v0[0] + v0[1] * v0[1]) + (v0[2] * v0[2] + v0[3] * v0[3]) + (v1[0] * v1[0] + v1[1] * v1[1]) + (v1[2] * v1[2] + v1[3] * v1[3]);
                    u32x4 w; w.x = pk2(v0[0], v0[1]); w.y = pk2(v0[2], v0[3]); w.z = pk2(v1[0], v1[1]); w.w = pk2(v1[2], v1[3]);
                    *(u32x4*)(O + (size_t)row * ldo + col0 + bj * HALF) = w;
                }
                if (WPS) { ss += __shfl_xor(ss, 16); ss += __shfl_xor(ss, 32); if (fq == 0) ops[(size_t)row * 32 + u.pn * 4 + wc] = ss; }
            }
        if (do_pf) c.tab[(c.parity ^ 1) * 256 + c.tid] = pf.finish(inv_dim);
    }
};

template <class Epi, class Sched, bool ALIGN_EPI = true, int PCLASS = 0>
__device__ __forceinline__ void gemm_phase(LAS unsigned char* lds, const Gemm g, const Sched& S, const Epi& E, unsigned long long& pacc) {
    constexpr bool PRB = ((PROBE_SEC >= 2 && PROBE_SEC <= 5) || PROBE_SEC == 8) && PROBE_ARG == PCLASS;
    unsigned long long pt0 = 0; (void)pt0;
#define PG8_PT0(sec) do { if constexpr (PRB && PROBE_SEC == (sec)) pt0 = PT_NOW(); } while (0)
#define PG8_PT1(sec) do { if constexpr (PRB && PROBE_SEC == (sec)) pacc += PT_NOW() - pt0; } while (0)
    PG8_PT0(2);
    int tid = threadIdx.x; asm volatile("" : "+v"(tid));
    const int wid = __builtin_amdgcn_readfirstlane(tid >> 6), lane = tid & 63, wr = wid >> 2, wc = wid & 3, fr = lane & 15, fq = lane >> 4;
    const int K = g.K, nt = K / BK, lda = g.lda;
    unsigned voffA[2], voffB[2];
#pragma unroll
    for (int i = 0; i < 2; ++i) { int R, C; stage_rc(tid * 16 + i * 8192, R, C); const int Rb = Epi::PERM ? ((R & ~31) + perm32(R & 31)) : R;
        voffA[i] = (unsigned)(R * lda + C) * 2u; voffB[i] = (unsigned)(Rb * K + C) * 2u; }
    const size_t kstep = (size_t)(BK * 2);
    const size_t hstepA = (size_t)HALF * lda * 2, hstepB = (size_t)HALF * K * 2;
    const size_t tstepA = 2 * hstepA, tstepB = 2 * hstepB;
    const unsigned ldsw = (unsigned)wid * 1024u;
    const int aoff = lds_byte(wr * 64 + fr, fq * 8), boff = lds_byte(wc * 32 + fr, fq * 8);
#define PG8_SA(b, h) (((b) * 2 + (h)) * HTB)
#define PG8_SB(b, h) ((4 + (b) * 2 + (h)) * HTB)
#define PG8_STAGE(bufoff, gbase, voff) do { _Pragma("unroll") for (int _i = 0; _i < 2; ++_i) \
        __builtin_amdgcn_global_load_lds((const unsigned*)((const char*)(gbase) + (voff)[_i]), (LAS unsigned*)(lds + (bufoff) + ldsw + _i * 8192), 16, 0, 0); } while (0)
#define PG8_LDA(dst, b, h) do { _Pragma("unroll") for (int m = 0; m < 4; ++m) _Pragma("unroll") for (int k = 0; k < 2; ++k) dst[m][k] = *(const LAS bf16x8*)(lds + PG8_SA(b, h) + aoff + m * 2048 + k * 1024); } while (0)
#define PG8_LDB(dst, b, h) do { _Pragma("unroll") for (int n = 0; n < 2; ++n) _Pragma("unroll") for (int k = 0; k < 2; ++k) dst[n][k] = *(const LAS bf16x8*)(lds + PG8_SB(b, h) + boff + n * 2048 + k * 1024); } while (0)
#define PG8_MMA(ai, bj, At, Bt) do { __builtin_amdgcn_s_setprio(1); _Pragma("unroll") for (int m = 0; m < 4; ++m) _Pragma("unroll") for (int n = 0; n < 2; ++n) _Pragma("unroll") for (int k = 0; k < 2; ++k) \
        acc[ai][bj][m][n] = __builtin_amdgcn_mfma_f32_16x16x32_bf16(Bt[n][k], At[m][k], acc[ai][bj][m][n], 0, 0, 0); __builtin_amdgcn_s_setprio(0); } while (0)
#define PG8_WAIT_V(n) asm volatile("s_waitcnt vmcnt(" #n ")" ::: "memory")
#define PG8_WAIT_L(n) asm volatile("s_waitcnt lgkmcnt(" #n ")" ::: "memory")
#define PG8_BAR __builtin_amdgcn_s_barrier()
#define PG8_SCHED __builtin_amdgcn_sched_barrier(0)
    Unit cur, nxt; int ui = 0;
    if (!S.next(0, cur)) return;
    f32x4 acc[2][2][4][2];
#pragma unroll
    for (int a = 0; a < 2; ++a)
#pragma unroll
        for (int b = 0; b < 2; ++b)
#pragma unroll
            for (int m = 0; m < 4; ++m)
#pragma unroll
                for (int n = 0; n < 2; ++n) acc[a][b][m][n] = (f32x4){0.f, 0.f, 0.f, 0.f};
    bf16x8 At[4][2], B0[2][2], B1[2][2];
    const char* cA = (const char*)g.A + (size_t)cur.pm * tstepA; const char* cB = (const char*)g.Bt + (size_t)cur.pn * tstepB;
    LAS float* rtab = (LAS float*)(lds + 131072 + 1024);
    E.prime(cur, rtab, tid); asm volatile("s_waitcnt vmcnt(0) lgkmcnt(0)" ::: "memory");
    S.a_ready(cur);
    PG8_STAGE(PG8_SB(0, 0), cB, voffB); PG8_STAGE(PG8_SB(0, 1), cB + hstepB, voffB); PG8_STAGE(PG8_SA(0, 0), cA, voffA); PG8_STAGE(PG8_SA(0, 1), cA + hstepA, voffA);
    if (wr == 1) PG8_BAR;
    PG8_WAIT_V(2); PG8_BAR;
    PG8_STAGE(PG8_SB(1, 0), cB + kstep, voffB); PG8_STAGE(PG8_SA(1, 0), cA + kstep, voffA); PG8_STAGE(PG8_SB(1, 1), cB + hstepB + kstep, voffB);
    PG8_WAIT_V(6); PG8_BAR;
    PG8_PT1(2);
    for (;;) {
        const bool has_next = S.next(ui + 1, nxt);
        PG8_PT0(3); if constexpr (PRB && PROBE_SEC == 8) pt0 = (unsigned long long)__builtin_readcyclecounter();
        const char* nA = has_next ? (const char*)g.A + (size_t)nxt.pm * tstepA : cA; const char* nB = has_next ? (const char*)g.Bt + (size_t)nxt.pn * tstepB : cB;
        for (int t = 0; t < nt; t += 2) {
            const bool last = (t == nt - 2);
            const char* a1 = cA + (size_t)(t + 1) * kstep;
            const char* a2 = last ? nA : cA + (size_t)(t + 2) * kstep; const char* b2 = last ? nB : cB + (size_t)(t + 2) * kstep;
            const char* a3 = a2 + kstep; const char* b3 = b2 + kstep;
            if (last && has_next) S.a_ready(nxt);
            PG8_LDB(B0, 0, 0); PG8_LDB(B1, 0, 1); PG8_SCHED; PG8_LDA(At, 0, 0); PG8_STAGE(PG8_SA(1, 1), a1 + hstepA, voffA);
            PG8_WAIT_V(8); PG8_WAIT_L(0); PG8_BAR; PG8_MMA(0, 0, At, B0); PG8_MMA(0, 1, At, B1); PG8_BAR; PG8_SCHED;
            PG8_LDA(At, 0, 1); PG8_STAGE(PG8_SB(0, 0), b2, voffB); PG8_STAGE(PG8_SB(0, 1), b2 + hstepB, voffB); PG8_STAGE(PG8_SA(0, 0), a2, voffA);
            PG8_WAIT_V(8); PG8_WAIT_L(0); PG8_BAR; PG8_MMA(1, 0, At, B0); PG8_MMA(1, 1, At, B1); PG8_BAR; PG8_SCHED;
            PG8_LDB(B0, 1, 0); PG8_LDB(B1, 1, 1); PG8_SCHED; PG8_LDA(At, 1, 0); PG8_STAGE(PG8_SA(0, 1), a2 + hstepA, voffA);
            PG8_WAIT_V(8); PG8_WAIT_L(0); PG8_BAR; PG8_MMA(0, 0, At, B0); PG8_MMA(0, 1, At, B1); PG8_BAR; PG8_SCHED;
            PG8_LDA(At, 1, 1); PG8_STAGE(PG8_SB(1, 0), b3, voffB); PG8_STAGE(PG8_SB(1, 1), b3 + hstepB, voffB); PG8_STAGE(PG8_SA(1, 0), a3, voffA);
            PG8_WAIT_V(8); PG8_WAIT_L(0); PG8_BAR; PG8_MMA(1, 0, At, B0); PG8_MMA(1, 1, At, B1); PG8_BAR; PG8_SCHED;
        }
        PG8_PT1(3); if constexpr (PRB && PROBE_SEC == 8) pacc += ((unsigned long long)__builtin_readcyclecounter() - pt0) >> 4; PG8_PT0(4);
        if constexpr (ALIGN_EPI) { if (wr == 0) PG8_BAR; }
        { const EpiCtx ec{rtab, ui & 1, has_next, nxt.pm, tid}; E(acc, cur, wr, wc, fr, fq, ec); } S.done(cur);
        PG8_PT1(4);
        if (!has_next) break;
#pragma unroll
        for (int a = 0; a < 2; ++a)
#pragma unroll
            for (int b = 0; b < 2; ++b)
#pragma unroll
                for (int m = 0; m < 4; ++m)
#pragma unroll
                    for (int n = 0; n < 2; ++n) acc[a][b][m][n] = (f32x4){0.f, 0.f, 0.f, 0.f};
        cur = nxt; cA = nA; cB = nB; ++ui;
        if constexpr (ALIGN_EPI) { if (wr == 1) PG8_BAR; }
    }
    PG8_PT0(5);
    PG8_WAIT_V(0);
    if constexpr (!ALIGN_EPI) { if (wr == 0) PG8_BAR; }
    PG8_BAR;
    PG8_PT1(5);
#undef PG8_PT0
#undef PG8_PT1
#undef PG8_SA
#undef PG8_SB
#undef PG8_STAGE
#undef PG8_LDA
#undef PG8_LDB
#undef PG8_MMA
#undef PG8_WAIT_V
#undef PG8_WAIT_L
#undef PG8_BAR
#undef PG8_SCHED
}
}

struct FaArgs {
    const bf16_t* Q; int q_pitch, q_col0, q_hstride;
    const bf16_t* K; int k_pitch, k_col0, k_hstride;
    const float* kgain; int kg_lds;
    const bf16_t* KR;
    int Skv, kv_group, nheads;
    const bf16_t* V; int v_pitch, v_col0, v_hstride;
    bf16_t* O; int o_pitch, o_col0;
    const float* qgain; const float* bias; const float* sinks; float qscale;
    float mbound;
};
__device__ __forceinline__ float fa_mbound(const float* gq, const float* gk, int n1, int n2, float qscale) {
    float aq = 0.f, ak = 0.f, bq = 0.f, bk = 0.f;
    for (int i = 0; i < n1; ++i) { aq = fmaxf(aq, fabsf(gq[i])); ak = fmaxf(ak, fabsf(gk[i])); }
    for (int i = n1; i < n1 + n2; ++i) { bq = fmaxf(bq, fabsf(gq[i])); bk = fmaxf(bk, fabsf(gk[i])); }
    return qscale * ((float)n1 * aq * ak + (float)n2 * bq * bk) * 1.02f + 0.25f;
}
__device__ const unsigned char T5_BUCKET[128] = {
    0, 1, 2, 3, 4, 5, 6, 7, 8, 9, 10, 11, 12, 13, 14, 15, 16, 16, 16, 17, 17, 18, 18, 18, 19, 19, 19, 20, 20, 20, 20, 21, 21, 21, 21, 22, 22, 22, 22, 22, 23, 23, 23, 23, 23, 23,
    24, 24, 24, 24, 24, 24, 25, 25, 25, 25, 25, 25, 25, 26, 26, 26, 26, 26, 26, 26, 26, 27, 27, 27, 27, 27, 27, 27, 27, 27, 27, 28, 28, 28, 28, 28, 28, 28, 28, 28, 28,
    29, 29, 29, 29, 29, 29, 29, 29, 29, 29, 29, 29, 30, 30, 30, 30, 30, 30, 30, 30, 30, 30, 30, 30, 30, 30, 31, 31, 31, 31, 31, 31, 31, 31, 31, 31, 31, 31, 31, 31, 31};

template <int DQK, int DV, int MODE>
__device__ __forceinline__ void fa_unit(LAS unsigned char* lds, const FaArgs& A, const int b, const int h, const int qb, unsigned long long& pacc) {
    constexpr bool FPRB = (PROBE_SEC >= 9 && PROBE_SEC <= 13 && PROBE_ARG == MODE);
    unsigned long long ft0 = 0; (void)ft0;
#define FA_PT0(sec) do { if constexpr (FPRB && PROBE_SEC == (sec)) ft0 = PT_NOW(); } while (0)
#define FA_PT1(sec) do { if constexpr (FPRB && PROBE_SEC == (sec)) pacc += PT_NOW() - ft0; } while (0)
    FA_PT0(12);
    constexpr int NKS = DQK / 16, NDB = DV / 32, KP = DQK + 8;
    constexpr int VPB = (DV == 64) ? 192 : 320;
    constexpr int KBYTES = 64 * KP * 2, VBYTES = 64 * VPB;
    constexpr int OFF_K = 0, OFF_V = 2 * KBYTES, OFF_B = OFF_V + 2 * VBYTES, OFF_TAB = OFF_B + 512;
    static_assert(OFF_TAB + 512 <= 131072, "FA LDS");
    constexpr int DKN = (MODE == 0) ? 128 : DQK;
    constexpr int KCH = DKN / 8, KPTN = 64 * KCH / 512, KPTR = (MODE == 0) ? 1 : 0, KPT = KPTN + KPTR, VCH = DV / 8, VPT = DV * 8 / 512;
    static_assert(KPTN * 512 == 64 * KCH && VPT * 512 == DV * 8 && (KCH == 8 || KCH == 16), "FA staging");
    int tid = threadIdx.x; asm volatile("" : "+v"(tid));
    const int lane = tid & 63, w = __builtin_amdgcn_readfirstlane(tid >> 6), r = lane & 31, hh = lane >> 5;
    const int q0 = qb * 256, qw0 = q0 + w * 32, qpos = qw0 + r;
    const int hk = (MODE == 1) ? h / A.kv_group : h;

    bf16x8 Qf[NKS];
    {
        int opq = 0; asm volatile("" : "+v"(opq));
        const GAS char* Qb = uni_ptr((const char*)(A.Q + (size_t)(b * SEQ + q0) * A.q_pitch + A.q_col0 + h * A.q_hstride));
        const unsigned qoff = (unsigned)((w * 32 + r) * A.q_pitch + 8 * hh) * 2u;
        float qf[NKS][8];
#pragma unroll
        for (int ks = 0; ks < NKS; ++ks) { const u32x4 v = *(const GAS u32x4*)(Qb + qoff + 32 * ks); unpack8(v, qf[ks]); }
        if constexpr (MODE == 0) {
            float sn = 0.f, sr = 0.f;
#pragma unroll
            for (int ks = 0; ks < 8; ++ks)
#pragma unroll
                for (int j = 0; j < 8; ++j) sn += qf[ks][j] * qf[ks][j];
#pragma unroll
            for (int ks = 8; ks < 12; ++ks)
#pragma unroll
                for (int j = 0; j < 8; ++j) sr += qf[ks][j] * qf[ks][j];
            sn = xor32_sum(sn); sr = xor32_sum(sr);
            const float rn = 1.0f / sqrtf(sn * (1.0f / 128.0f) + RMS_EPS), rr = 1.0f / sqrtf(sr * (1.0f / 64.0f) + RMS_EPS);
#pragma unroll
            for (int ks = 0; ks < 8; ++ks) {
                const f32x4 g0 = *(const f32x4*)(A.qgain + 16 * ks + 8 * hh), g1 = *(const f32x4*)(A.qgain + 16 * ks + 8 * hh + 4);
#pragma unroll
                for (int j = 0; j < 4; ++j) { qf[ks][j] *= rn * g0[j] * A.qscale; qf[ks][4 + j] *= rn * g1[j] * A.qscale; }
            }
#pragma unroll
            for (int ks = 8; ks < 10; ++ks) {
                const int i0 = 16 * (ks - 8) + 8 * hh;
                const f32x4 ga0 = *(const f32x4*)(A.qgain + 128 + i0), ga1 = *(const f32x4*)(A.qgain + 128 + i0 + 4);
                const f32x4 gb0 = *(const f32x4*)(A.qgain + 160 + i0), gb1 = *(const f32x4*)(A.qgain + 160 + i0 + 4);
#pragma unroll
                for (int j = 0; j < 8; ++j) {
                    const float ga = j < 4 ? ga0[j & 3] : ga1[j & 3], gb = j < 4 ? gb0[j & 3] : gb1[j & 3];
                    const float t1 = qf[ks][j] * rr * ga, t2 = qf[ks + 2][j] * rr * gb;
                    float c, s; rope_cs(qpos, i0 + j + opq, c, s);
                    qf[ks][j] = (t1 * c - t2 * s) * A.qscale; qf[ks + 2][j] = (t1 * s + t2 * c) * A.qscale;
                }
            }
        } else {
            float ss = 0.f;
#pragma unroll
            for (int ks = 0; ks < NKS; ++ks)
#pragma unroll
                for (int j = 0; j < 8; ++j) ss += qf[ks][j] * qf[ks][j];
            ss = xor32_sum(ss);
            const float rs = 1.0f / sqrtf(ss * (1.0f / DQK) + RMS_EPS) * A.qscale;
#pragma unroll
            for (int ks = 0; ks < NKS; ++ks) {
                const f32x4 g0 = *(const f32x4*)(A.qgain + 16 * ks + 8 * hh), g1 = *(const f32x4*)(A.qgain + 16 * ks + 8 * hh + 4);
#pragma unroll
                for (int j = 0; j < 4; ++j) { qf[ks][j] *= rs * g0[j]; qf[ks][4 + j] *= rs * g1[j]; }
            }
        }
#pragma unroll
        for (int ks = 0; ks < NKS; ++ks) Qf[ks] = __builtin_bit_cast(bf16x8, pack8(qf[ks]));
    }
    float mshift = A.mbound;
    if constexpr (MODE == 1) {
        float mb = A.bias[(lane & 31) * 32 + h];
#pragma unroll
        for (int o = 1; o < 32; o <<= 1) mb = fmaxf(mb, __shfl_xor(mb, o));
        mshift += mb * LOG2E;
        if (tid < 128) *(LAS float*)(lds + OFF_TAB + 4 * tid) = A.bias[(int)T5_BUCKET[tid] * 32 + h] * LOG2E - mshift;
    }
    if constexpr (MODE == 2) mshift += A.bias[(size_t)(b * A.nheads + h) * SEQ + qpos];

    int t_lo = 0, t_hi;
    if constexpr (MODE == 3) t_hi = A.Skv / 64; else t_hi = 4 * qb + 4;
    if constexpr (MODE == 1) { const int lowk = q0 - 127; t_lo = lowk > 0 ? lowk / 64 : 0; }
    const int nt = t_hi - t_lo;
    const bf16_t* Kg = A.K + (size_t)(b * A.Skv) * A.k_pitch + A.k_col0 + hk * A.k_hstride;
    const bf16_t* KRg = (MODE == 0) ? A.KR + (size_t)(b * SEQ) * 64 : nullptr;
    const bf16_t* Vg = A.V + (size_t)(b * A.Skv) * A.v_pitch + A.v_col0 + hk * A.v_hstride;
    const float* Bg = (MODE == 2) ? A.bias + (size_t)(b * A.nheads + h) * SEQ : nullptr;
    u32x4 kst[KPT], vst[VPT]; f32x4 bst = (f32x4){0.f, 0.f, 0.f, 0.f};
    unsigned koff[KPT], voff[VPT];
#pragma unroll
    for (int i = 0; i < KPTN; ++i) { const int c = tid + 512 * i, row = c / KCH, cc = c % KCH; koff[i] = (unsigned)(row * A.k_pitch + cc * 8) * 2u; }
    if constexpr (MODE == 0) koff[KPTN] = (unsigned)((tid >> 3) * 64 + (tid & 7) * 8) * 2u;
    f32x4 kg0 = (f32x4){1.f, 1.f, 1.f, 1.f}, kg1 = kg0;
    if constexpr (KCH == 8) { kg0 = *(const f32x4*)(A.kgain + 8 * (tid & 7)); kg1 = *(const f32x4*)(A.kgain + 8 * (tid & 7) + 4); }
#pragma unroll
    for (int i = 0; i < VPT; ++i) { const int c = tid + 512 * i, key = c / VCH, cc = c % VCH; voff[i] = (unsigned)(key * A.v_pitch + cc * 8) * 2u; }
#define FA_LOAD(t) do { const GAS char* _kt = uni_ptr((const char*)Kg + (size_t)(64 * (t)) * A.k_pitch * 2); const GAS char* _vt = uni_ptr((const char*)Vg + (size_t)(64 * (t)) * A.v_pitch * 2); \
        _Pragma("unroll") for (int _i = 0; _i < KPTN; ++_i) kst[_i] = *(const GAS u32x4*)(_kt + koff[_i]); \
        if constexpr (MODE == 0) { const GAS char* _kr = uni_ptr((const char*)KRg + (size_t)(64 * (t)) * 64 * 2); kst[KPTN] = *(const GAS u32x4*)(_kr + koff[KPTN]); } \
        _Pragma("unroll") for (int _i = 0; _i < VPT; ++_i) vst[_i] = *(const GAS u32x4*)(_vt + voff[_i]); \
        if (MODE == 2) { if (tid < 16) bst = *(const f32x4*)(Bg + 64 * (t) + 4 * tid); } } while (0)
#define FA_WRITE(buf) do { \
        _Pragma("unroll") for (int _i = 0; _i < KPTN; ++_i) { const int _c = tid + 512 * _i, _row = _c / KCH, _cc = _c % KCH; \
            float _f[8]; unpack8(kst[_i], _f); float _ss = 0.f; \
            _Pragma("unroll") for (int _j = 0; _j < 8; ++_j) _ss += _f[_j] * _f[_j]; \
            _ss = group_sum<KCH>(_ss);            \
            const float _rs = __builtin_amdgcn_rsqf(_ss * (1.0f / DKN) + RMS_EPS); \
            f32x4 _g0 = kg0, _g1 = kg1; if constexpr (KCH == 16) { _g0 = *(const LAS f32x4*)(lds + A.kg_lds + 32 * _cc); _g1 = *(const LAS f32x4*)(lds + A.kg_lds + 32 * _cc + 16); } \
            _Pragma("unroll") for (int _j = 0; _j < 4; ++_j) { _f[_j] *= _rs * _g0[_j]; _f[4 + _j] *= _rs * _g1[_j]; } \
            *(LAS u32x4*)(lds + OFF_K + (buf) * KBYTES + (_row * KP + _cc * 8) * 2) = pack8(_f); } \
        if constexpr (MODE == 0) *(LAS u32x4*)(lds + OFF_K + (buf) * KBYTES + ((tid >> 3) * KP + 128 + (tid & 7) * 8) * 2) = kst[KPTN]; \
        _Pragma("unroll") for (int _i = 0; _i < VPT; ++_i) { const int _c = tid + 512 * _i, _key = _c / VCH, _cc = _c % VCH; *(LAS u32x4*)(lds + OFF_V + (buf) * VBYTES + _key * VPB + _cc * 16) = vst[_i]; } \
        if (MODE == 2) { if (tid < 16) *(LAS f32x4*)(lds + OFF_B + (buf) * 256 + 16 * tid) = bst; } } while (0)

    f32x16 O[NDB];
#pragma unroll
    for (int db = 0; db < NDB; ++db)
#pragma unroll
        for (int i = 0; i < 16; ++i) O[db][i] = 0.f;
    float l_run = 0.f;
    FA_LOAD(t_lo);
    FA_PT1(12);
    for (int it = 0; it < nt; ++it) {
        const int t = t_lo + it, buf = it & 1;
        FA_PT0(10);
        FA_WRITE(buf);
        asm volatile("s_waitcnt lgkmcnt(0)" ::: "memory");
        FA_PT1(10); FA_PT0(9);
        __syncthreads();
        FA_PT1(9); FA_PT0(11);
        if (it + 1 < nt) FA_LOAD(t + 1);
#pragma unroll
        for (int sub = 0; sub < 2; ++sub) {
            const int ks0 = 64 * t + 32 * sub;
            bool active = true;
            if constexpr (MODE == 0 || MODE == 2) active = (ks0 <= qw0 + 31);
            if constexpr (MODE == 1) active = (ks0 <= qw0 + 31) && (ks0 + 31 >= qw0 - 127);
            if (!active) continue;
            f32x16 s;
            if constexpr (MODE == 2) {
#pragma unroll
                for (int g = 0; g < 4; ++g) { const f32x4 bb = *(const LAS f32x4*)(lds + OFF_B + buf * 256 + (32 * sub + 8 * g + 4 * hh) * 4); s[4 * g] = bb[0]; s[4 * g + 1] = bb[1]; s[4 * g + 2] = bb[2]; s[4 * g + 3] = bb[3]; }
            } else if constexpr (MODE == 1) {
#pragma unroll
                for (int i = 0; i < 16; ++i) { int dist = qpos - (ks0 + (i & 3) + 8 * (i >> 2) + 4 * hh); dist = dist < 0 ? 0 : (dist > 127 ? 127 : dist); s[i] = *(const LAS float*)(lds + OFF_TAB + 4 * dist); }
            } else {
#pragma unroll
                for (int i = 0; i < 16; ++i) s[i] = -mshift;
            }
#pragma unroll
            for (int ks = 0; ks < NKS; ++ks) {
                const bf16x8 a = *(const LAS bf16x8*)(lds + OFF_K + buf * KBYTES + ((32 * sub + r) * KP + 16 * ks + 8 * hh) * 2);
                s = __builtin_amdgcn_mfma_f32_32x32x16_bf16(a, Qf[ks], s, 0, 0, 0);
            }
            if constexpr (MODE == 0 || MODE == 2) {
                if (ks0 + 31 > qw0) {
#pragma unroll
                    for (int i = 0; i < 16; ++i) { const int key = ks0 + (i & 3) + 8 * (i >> 2) + 4 * hh; if (key > qpos) s[i] = -__builtin_inff(); }
                }
            }
            if constexpr (MODE == 1) {
#pragma unroll
                for (int i = 0; i < 16; ++i) { const int key = ks0 + (i & 3) + 8 * (i >> 2) + 4 * hh; if ((unsigned)(qpos - key) >= 128u) s[i] = -__builtin_inff(); }
            }
            float psum = 0.f;
#pragma unroll
            for (int i = 0; i < 16; ++i) { s[i] = __builtin_amdgcn_exp2f(MODE == 2 ? s[i] - mshift : s[i]); psum += s[i]; }
            l_run += psum;
            bf16x8 P[2];
#pragma unroll
            for (int s2 = 0; s2 < 2; ++s2) { u32x4 pw; pw.x = pk2(s[8 * s2], s[8 * s2 + 1]); pw.y = pk2(s[8 * s2 + 2], s[8 * s2 + 3]); pw.z = pk2(s[8 * s2 + 4], s[8 * s2 + 5]); pw.w = pk2(s[8 * s2 + 6], s[8 * s2 + 7]); P[s2] = __builtin_bit_cast(bf16x8, pw); }
            {
                const unsigned vbase = (unsigned)(unsigned long long)(lds + OFF_V + buf * VBYTES) + (unsigned)((32 * sub + 4 * hh + ((lane & 15) >> 2)) * VPB + (16 * ((lane >> 4) & 1) + 4 * (lane & 3)) * 2);
#pragma unroll
                for (int dp = 0; dp < NDB; dp += 2) {
                    u32x2 f[2][2][2];
                    asm volatile("ds_read_b64_tr_b16 %0, %8 offset:%9\n\tds_read_b64_tr_b16 %1, %8 offset:%10\n\tds_read_b64_tr_b16 %2, %8 offset:%11\n\tds_read_b64_tr_b16 %3, %8 offset:%12\n\t"
                                 "ds_read_b64_tr_b16 %4, %8 offset:%13\n\tds_read_b64_tr_b16 %5, %8 offset:%14\n\tds_read_b64_tr_b16 %6, %8 offset:%15\n\tds_read_b64_tr_b16 %7, %8 offset:%16\n\ts_waitcnt lgkmcnt(0)"
                                 : "=&v"(f[0][0][0]), "=&v"(f[0][0][1]), "=&v"(f[0][1][0]), "=&v"(f[0][1][1]), "=&v"(f[1][0][0]), "=&v"(f[1][0][1]), "=&v"(f[1][1][0]), "=&v"(f[1][1][1])
                                 : "v"(vbase),
                                   "i"(64 * dp + 0 * VPB), "i"(64 * dp + 8 * VPB), "i"(64 * dp + 16 * VPB), "i"(64 * dp + 24 * VPB),
                                   "i"(64 * (dp + 1) + 0 * VPB), "i"(64 * (dp + 1) + 8 * VPB), "i"(64 * (dp + 1) + 16 * VPB), "i"(64 * (dp + 1) + 24 * VPB)
                                 : "memory");
#pragma unroll
                    for (int d2 = 0; d2 < 2; ++d2)
#pragma unroll
                        for (int s2 = 0; s2 < 2; ++s2) {
                            const bf16x8 a = __builtin_bit_cast(bf16x8, (u32x4){f[d2][s2][0].x, f[d2][s2][0].y, f[d2][s2][1].x, f[d2][s2][1].y});
                            O[dp + d2] = __builtin_amdgcn_mfma_f32_32x32x16_bf16(a, P[s2], O[dp + d2], 0, 0, 0);
                        }
                }
            }
        }
        FA_PT1(11);
    }
    FA_PT0(13);
#undef FA_LOAD
#undef FA_WRITE
    float l_tot = xor32_sum(l_run);
    if constexpr (MODE == 1) l_tot += __builtin_amdgcn_exp2f(A.sinks[h] * LOG2E - mshift);
    const float inv_l = 1.0f / l_tot;
    bf16_t* Op = A.O + (size_t)(b * SEQ + qpos) * A.o_pitch + A.o_col0 + h * DV;
#pragma unroll
    for (int db = 0; db < NDB; ++db)
#pragma unroll
        for (int g = 0; g < 4; ++g) {
            u32x2 wv; wv.x = pk2(O[db][4 * g] * inv_l, O[db][4 * g + 1] * inv_l); wv.y = pk2(O[db][4 * g + 2] * inv_l, O[db][4 * g + 3] * inv_l);
            *(u32x2*)(Op + 32 * db + 8 * g + 4 * hh) = wv;
        }
    __syncthreads();
    FA_PT1(13);
#undef FA_PT0
#undef FA_PT1
}

template <int D>
__device__ __forceinline__ void headnorm_items(const bf16_t* src, int src_pitch, int src_col0, int src_hstride, int H, const float* gain,
                                               bf16_t* dst, int dst_D, int dst_d0, int S, int M, int gw, int NGW, int lane) {
    constexpr int LPI = D / 8, IPW = 64 / LPI;
    const int li = lane % LPI, sub = lane / LPI;
    const f32x4 g0 = *(const f32x4*)(gain + 8 * li), g1 = *(const f32x4*)(gain + 8 * li + 4);
    const int total = M * H;
    for (int it = gw * IPW + sub; it < total; it += NGW * IPW) {
        const int m = it / H, h = it % H;
        const u32x4 v = *(const u32x4*)(src + (size_t)m * src_pitch + src_col0 + h * src_hstride + 8 * li);
        float f[8]; unpack8(v, f);
        float ss = 0.f;
#pragma unroll
        for (int j = 0; j < 8; ++j) ss += f[j] * f[j];
#pragma unroll
        for (int o = 1; o < LPI; o <<= 1) ss += __shfl_xor(ss, o);
        const float rs = 1.0f / sqrtf(ss * (1.0f / D) + RMS_EPS);
#pragma unroll
        for (int j = 0; j < 4; ++j) { f[j] *= rs * g0[j]; f[4 + j] *= rs * g1[j]; }
        const int bb = m / S, s = m % S;
        *(u32x4*)(dst + ((size_t)(bb * H + h) * S + s) * dst_D + dst_d0 + 8 * li) = pack8(f);
    }
}
__device__ __forceinline__ void mla_krope_items(const bf16_t* src, int src_pitch, int col0, const float* gain, bf16_t* KR, int gw, int NGW, int lane) {
    const int li = lane & 7, sub = lane >> 3;
    const f32x4 ga = *(const f32x4*)(gain + 4 * li), gb = *(const f32x4*)(gain + 32 + 4 * li);
    for (int m = gw * 8 + sub; m < MTOK; m += NGW * 8) {
        const u32x2 va = *(const u32x2*)(src + (size_t)m * src_pitch + col0 + 4 * li), vb = *(const u32x2*)(src + (size_t)m * src_pitch + col0 + 32 + 4 * li);
        float a[4] = {bf_lo(va.x), bf_hi(va.x), bf_lo(va.y), bf_hi(va.y)}, bq[4] = {bf_lo(vb.x), bf_hi(vb.x), bf_lo(vb.y), bf_hi(vb.y)};
        float ss = 0.f;
#pragma unroll
        for (int j = 0; j < 4; ++j) ss += a[j] * a[j] + bq[j] * bq[j];
        ss += __shfl_xor(ss, 1); ss += __shfl_xor(ss, 2); ss += __shfl_xor(ss, 4);
        const float rs = 1.0f / sqrtf(ss * (1.0f / 64.0f) + RMS_EPS);
        const int s = m % SEQ;
        float o1[4], o2[4];
#pragma unroll
        for (int j = 0; j < 4; ++j) { const float t1 = a[j] * rs * ga[j], t2 = bq[j] * rs * gb[j]; float c, sn; rope_cs(s, 4 * li + j, c, sn); o1[j] = t1 * c - t2 * sn; o2[j] = t1 * sn + t2 * c; }
        *(u32x2*)(KR + (size_t)m * 64 + 4 * li) = (u32x2){pk2(o1[0], o1[1]), pk2(o1[2], o1[3])};
        *(u32x2*)(KR + (size_t)m * 64 + 32 + 4 * li) = (u32x2){pk2(o2[0], o2[1]), pk2(o2[2], o2[3])};
    }
}
__device__ __forceinline__ void vtrans_items(const bf16_t* src, int pitch, int col0, int hstride, int H, int DV, bf16_t* dst, int S, int B, LAS unsigned char* scr, int gw, int NGW, int lane) {
    const int ndb = DV / 32, ntb = S / 64, total = B * H * ntb * ndb;
    for (int it = gw; it < total; it += NGW) {
        const int dbk = it % ndb, tb = (it / ndb) % ntb, bh = it / (ndb * ntb), bb = bh / H, h = bh % H;
        u32x4 v[4];
#pragma unroll
        for (int i = 0; i < 4; ++i) { const int c = lane + 64 * i, tok = c >> 2, dc = c & 3; v[i] = *(const u32x4*)(src + (size_t)(bb * S + 64 * tb + tok) * pitch + col0 + h * hstride + 32 * dbk + 8 * dc); }
#pragma unroll
        for (int i = 0; i < 4; ++i) { const int c = lane + 64 * i, tok = c >> 2, dc = c & 3; const unsigned wv[4] = {v[i].x, v[i].y, v[i].z, v[i].w};
#pragma unroll
            for (int e = 0; e < 8; ++e) *(LAS unsigned short*)(scr + ((8 * dc + e) * 66 + tok) * 2) = (unsigned short)((e & 1) ? (wv[e >> 1] >> 16) : (wv[e >> 1] & 0xffffu)); }
        asm volatile("s_waitcnt lgkmcnt(0)" ::: "memory");
        const int d = lane & 31, half = lane >> 5;
        unsigned o[16];
#pragma unroll
        for (int i = 0; i < 16; ++i) o[i] = *(const LAS unsigned*)(scr + (d * 66 + 32 * half + 2 * i) * 2);
        bf16_t* dp = dst + ((size_t)(bh * DV + 32 * dbk + d)) * S + 64 * tb + 32 * half;
#pragma unroll
        for (int i = 0; i < 4; ++i) *(u32x4*)(dp + 8 * i) = (u32x4){o[4 * i], o[4 * i + 1], o[4 * i + 2], o[4 * i + 3]};
        asm volatile("s_waitcnt lgkmcnt(0)" ::: "memory");
    }
}
__device__ __forceinline__ void conv_items(const bf16_t* u, const float* cw, bf16_t* cat, int gt, int NT) {
    const int total = MTOK * (D_MODEL / 8);
    for (int it = gt; it < total; it += NT) {
        const int m = it / (D_MODEL / 8), c8 = (it % (D_MODEL / 8)) * 8, s = m % SEQ;
        float z[3][8];
#pragma unroll
        for (int tap = 0; tap < 3; ++tap) {
            const int back = 2 - tap;
            if (s - back >= 0) { const bf16_t* p = u + (size_t)(m - back) * NIN0 + c8; float gc[8], xt[8]; unpack8(*(const u32x4*)(p + D_MODEL), gc); unpack8(*(const u32x4*)(p + 2 * D_MODEL), xt);
#pragma unroll
                for (int j = 0; j < 8; ++j) z[tap][j] = gc[j] * xt[j]; }
            else {
#pragma unroll
                for (int j = 0; j < 8; ++j) z[tap][j] = 0.f; }
        }
        float gb[8], o[8]; unpack8(*(const u32x4*)(u + (size_t)m * NIN0 + c8), gb);
#pragma unroll
        for (int j = 0; j < 8; ++j) o[j] = gb[j] * (z[0][j] * cw[c8 + j] + z[1][j] * cw[D_MODEL + c8 + j] + z[2][j] * cw[2 * D_MODEL + c8 + j]);
        *(u32x4*)(cat + (size_t)m * K_OUT + c8) = pack8(o);
    }
}
__device__ __forceinline__ void fox_scan_items(const bf16_t* u, int pitch, int fcol0, const float* bfv, float* CB, int gw, int NGW, int lane) {
    if ((gw & 15) != 0 && NGW >= 2048) return;
    const int w16 = NGW >= 2048 ? (gw >> 4) : gw, nw16 = NGW >= 2048 ? (NGW >> 4) : NGW;
    for (int it = w16; it < BATCH * 32; it += nw16) {
        const int bb = it / 32, h = it % 32; const float bias = bfv[h];
        float v[32]; float run = 0.f;
#pragma unroll
        for (int i = 0; i < 32; ++i) { const int s = lane * 32 + i; const float x = __uint_as_float(((unsigned)u[(size_t)(bb * SEQ + s) * pitch + fcol0 + h]) << 16) + bias;
            const float ls = fminf(x, 0.f) - __builtin_amdgcn_logf(1.0f + __builtin_amdgcn_exp2f(-fabsf(x) * LOG2E)) * 0.6931471805599453f; run += ls; v[i] = run; }
        float tot = run;
#pragma unroll
        for (int o = 1; o < 64; o <<= 1) { const float t = __shfl_up(tot, o); if (lane >= o) tot += t; }
        const float base = tot - run;
        float* cp = CB + (size_t)it * SEQ + lane * 32;
#pragma unroll
        for (int i = 0; i < 8; ++i) *(f32x4*)(cp + 4 * i) = (f32x4){-(base + v[4 * i]) * LOG2E, -(base + v[4 * i + 1]) * LOG2E, -(base + v[4 * i + 2]) * LOG2E, -(base + v[4 * i + 3]) * LOG2E};
    }
}
__device__ __forceinline__ void rowinit_items(const float* src, bf16_t* dst, float* ps, int rows, int gw, int NGW, int lane) {
    for (int m = gw; m < rows; m += NGW) {
        const f32x4* xr = (const f32x4*)(src + (size_t)m * D_MODEL); float ss = 0.f;
#pragma unroll
        for (int j = 0; j < 8; ++j) { const f32x4 v = xr[64 * j + lane]; ss += (v[0] * v[0] + v[1] * v[1]) + (v[2] * v[2] + v[3] * v[3]);
            *(u32x2*)(dst + (size_t)m * D_MODEL + 4 * (64 * j + lane)) = (u32x2){pk2(v[0], v[1]), pk2(v[2], v[3])}; }
#pragma unroll
        for (int o = 1; o < 64; o <<= 1) ss += __shfl_xor(ss, o);
        if (lane < 32) ps[(size_t)m * 32 + lane] = (lane == 0) ? ss : 0.f;
    }
}

struct Seg { int in_idx; int src_off; int K; int Nsrc; int col0; int ncols; int dst_mib; int drow0; int gain_idx; int gain_off; int inter; int start; };
__device__ const Seg SEGS[] = {
    {I_F1G, 0, 2048, 5632, 0, 5632, 488, 0, I_NORM_FFN1, 0, 1, 0},
    {I_F1U, 0, 2048, 5632, 0, 5632, 488, 128, I_NORM_FFN1, 0, 1, 5632},
    {I_MEM_WKV, 0, 2048, 1024, 0, 1024, 1135, 0, I_NORM_MEM, 0, 0, 11264},
    {I_MEM_WKV, 2097152, 2048, 1024, 0, 1024, 1135, 1024, I_NORM_MEM, 2048, 0, 12288},
    {I_MEM_WKV, 4194304, 2048, 1024, 0, 1024, 1135, 2048, I_NORM_MEM, 4096, 0, 13312},
    {I_MEM_WKV, 6291456, 2048, 1024, 0, 1024, 1135, 3072, I_NORM_MEM, 6144, 0, 14336},
    {I_F1D, 0, 5632, 2048, 0, 2048, 840, 0, -1, 0, 0, 15360},
    {I_CONV_WIN, 0, 2048, 6656, 0, 6656, 1016, 0, I_NORM_MIX, 0, 0, 20992},
    {I_CONV_WOUT, 0, 2560, 2048, 0, 2048, 1088, 0, -1, 0, 0, 27648},
    {I_F2G, 0, 2048, 5632, 0, 5632, 532, 0, I_NORM_FFN2, 0, 1, 30208},
    {I_F2U, 0, 2048, 5632, 0, 5632, 532, 128, I_NORM_FFN2, 0, 1, 35840},
    {I_F2D, 0, 5632, 2048, 0, 2048, 862, 0, -1, 0, 0, 41472},
    {I_F1G, 11534336, 2048, 5632, 0, 5632, 576, 0, I_NORM_FFN1, 2048, 1, 47104},
    {I_F1U, 11534336, 2048, 5632, 0, 5632, 576, 128, I_NORM_FFN1, 2048, 1, 52736},
    {I_F1D, 11534336, 5632, 2048, 0, 2048, 884, 0, -1, 0, 0, 58368},
    {I_MLA_WIN, 0, 2048, 1600, 0, 1024, 1042, 0, I_NORM_MIX, 2048, 0, 64000},
    {I_MLA_WIN, 0, 2048, 1600, 1088, 512, 1042, 1024, I_NORM_MIX, 2048, 0, 65024},
    {I_MLA_WIN, 0, 2048, 1600, 1024, 64, 1042, 1536, I_NORM_MIX, 2048, 0, 65536},
    {I_MLA_WQB, 0, 512, 3072, 0, 3072, 1128, 0, I_MLA_QAN, 0, 0, 65600},
    {I_MLA_WKVB, 0, 512, 4096, 0, 4096, 1131, 0, I_MLA_KVAN, 0, 0, 66368},
    {I_MLA_WOUT, 0, 2560, 2048, 0, 2048, 1098, 0, -1, 0, 0, 67392},
    {I_F2G, 11534336, 2048, 5632, 0, 5632, 620, 0, I_NORM_FFN2, 2048, 1, 69952},
    {I_F2U, 11534336, 2048, 5632, 0, 5632, 620, 128, I_NORM_FFN2, 2048, 1, 75584},
    {I_F2D, 11534336, 5632, 2048, 0, 2048, 906, 0, -1, 0, 0, 81216},
    {I_F1G, 23068672, 2048, 5632, 0, 5632, 664, 0, I_NORM_FFN1, 4096, 1, 86848},
    {I_F1U, 23068672, 2048, 5632, 0, 5632, 664, 128, I_NORM_FFN1, 4096, 1, 92480},
    {I_F1D, 23068672, 5632, 2048, 0, 2048, 928, 0, -1, 0, 0, 98112},
    {I_SWA_WIN, 0, 2048, 3072, 0, 3072, 1049, 0, I_NORM_MIX, 4096, 0, 103744},
    {I_SWA_WOUT, 0, 2560, 2048, 0, 2048, 1108, 0, -1, 0, 0, 106816},
    {I_F2G, 23068672, 2048, 5632, 0, 5632, 708, 0, I_NORM_FFN2, 4096, 1, 109376},
    {I_F2U, 23068672, 2048, 5632, 0, 5632, 708, 128, I_NORM_FFN2, 4096, 1, 115008},
    {I_F2D, 23068672, 5632, 2048, 0, 2048, 950, 0, -1, 0, 0, 120640},
    {I_F1G, 34603008, 2048, 5632, 0, 5632, 752, 0, I_NORM_FFN1, 6144, 1, 126272},
    {I_F1U, 34603008, 2048, 5632, 0, 5632, 752, 128, I_NORM_FFN1, 6144, 1, 131904},
    {I_F1D, 34603008, 5632, 2048, 0, 2048, 972, 0, -1, 0, 0, 137536},
    {I_FOX_WIN, 0, 2048, 6688, 0, 6144, 1061, 0, I_NORM_MIX, 6144, 0, 143168},
    {I_FOX_WIN, 0, 2048, 6688, 6176, 512, 1061, 6144, I_NORM_MIX, 6144, 0, 149312},
    {I_FOX_WIN, 0, 2048, 6688, 6144, 32, 1061, 6656, I_NORM_MIX, 6144, 0, 149824},
    {I_FOX_WOUT, 0, 2560, 2048, 0, 2048, 1118, 0, -1, 0, 0, 149856},
    {I_F2G, 34603008, 2048, 5632, 0, 5632, 796, 0, I_NORM_FFN2, 6144, 1, 152416},
    {I_F2U, 34603008, 2048, 5632, 0, 5632, 796, 128, I_NORM_FFN2, 6144, 1, 158048},
    {I_F2D, 34603008, 5632, 2048, 0, 2048, 994, 0, -1, 0, 0, 163680},
};
constexpr int NSEG = 42, NITEMS = 169312, P0_ITEMS = 21504;
struct Slot { int phase, blk0, nblk, it0, it1; };
constexpr Slot SLOTS[] = {{1, 192, 64, 21504, 27648}, {3, 64, 192, 27648, 46080}, {4, 128, 128, 46080, 52224}, {6, 128, 128, 52224, 64512}, {8, 128, 128, 64512, 76800}, {10, 224, 32, 76800, 79872}, {13, 128, 128, 79872, 86016}, {15, 128, 128, 86016, 98304}, {17, 128, 128, 98304, 110592}, {19, 128, 128, 110592, 122880}, {21, 128, 128, 122880, 129024}, {23, 128, 128, 129024, 141312}, {25, 128, 128, 141312, 153600}, {27, 96, 160, 153600, 168960}, {29, 128, 128, 168960, 169312}, {31, 128, 128, 169312, 169312}};
constexpr int NSLOT = 16;
constexpr int slot_of(int phase) { for (int i = 0; i < NSLOT; ++i) if (SLOTS[i].phase == phase) return i; return -1; }

struct CvtItem { const float* src; bf16_t* dst; const float* gain; int Nsrc, K; };
__device__ __forceinline__ void cvt_load(const CvtItem& c, int lane, f32x4 (&v)[8]) {
    const float* p = c.src + (size_t)(8 * (lane >> 3)) * c.Nsrc + 4 * (lane & 7);
#pragma unroll
    for (int j = 0; j < 8; ++j) v[j] = __builtin_nontemporal_load((const f32x4*)(p + (size_t)j * c.Nsrc));
}
__device__ __forceinline__ void cvt_store(const CvtItem& c, int lane, const f32x4 (&v)[8]) {
    f32x4 g0 = (f32x4){1.f, 1.f, 1.f, 1.f}, g1 = g0;
    if (c.gain) { g0 = *(const f32x4*)(c.gain + 8 * (lane >> 3)); g1 = *(const f32x4*)(c.gain + 8 * (lane >> 3) + 4); }
    bf16_t* q = c.dst + (size_t)(4 * (lane & 7)) * c.K + 8 * (lane >> 3);
#pragma unroll
    for (int e = 0; e < 4; ++e) {
        u32x4 o; o.x = pk2(v[0][e] * g0[0], v[1][e] * g0[1]); o.y = pk2(v[2][e] * g0[2], v[3][e] * g0[3]); o.z = pk2(v[4][e] * g1[0], v[5][e] * g1[1]); o.w = pk2(v[6][e] * g1[2], v[7][e] * g1[3]);
        __builtin_nontemporal_store(o, (u32x4*)(q + (size_t)e * c.K));
    }
}

#define XB_TMO      128
#define XB_XCNT(j)  (256  + 64 * (j))
#define XB_XSUB(j)  (1280 + 64 * (j))
#define XB_XGEN(j)  (2304 + 64 * (j))
#define XB_TOP      3328
#define XB_TOPGEN   3392
#define XCD_BAR_WORDS 3456
#define XB_SPIN_CAP (1u << 18)
__device__ __forceinline__ unsigned xb_ld(unsigned* p)              { return __hip_atomic_load(p, __ATOMIC_RELAXED, __HIP_MEMORY_SCOPE_AGENT); }
__device__ __forceinline__ unsigned xb_add(unsigned* p, unsigned v) { return __hip_atomic_fetch_add(p, v, __ATOMIC_RELAXED, __HIP_MEMORY_SCOPE_AGENT); }
__device__ __forceinline__ unsigned xb_xcc_id() { return (unsigned)__builtin_amdgcn_s_getreg((3 << 11) | 20) & 0xFu; }
#define XB_SPIN(cond, bar) do { unsigned _sp = 0; while (cond) { __builtin_amdgcn_s_sleep(1); \
    if ((++_sp & 255u) == 0u) { if (xb_ld(&(bar)[XB_TMO])) break; if (_sp > XB_SPIN_CAP) { atomicAdd(&(bar)[XB_TMO], 1u); break; } } } } while (0)
struct XcdBarrier { unsigned* bar; unsigned x; volatile LAS unsigned* st; };
__device__ __forceinline__ XcdBarrier xcd_barrier_post(unsigned* bar, volatile LAS unsigned* st) {
    XcdBarrier b; b.bar = bar; b.x = xb_xcc_id(); b.st = st;
    if (threadIdx.x == 0) (void)xb_add(&bar[XB_XCNT(b.x)], 1u);
    return b;
}
__device__ __forceinline__ void xcd_barrier_complete(unsigned* bar, unsigned x, unsigned& nloc, unsigned& nx) {
    const unsigned G = gridDim.x * gridDim.y * gridDim.z;
    unsigned sum, cnt, mine, sp = 0u;
    for (;;) {
        sum = 0u; cnt = 0u; mine = 0u;
#pragma unroll
        for (unsigned j = 0; j < 16; ++j) { const unsigned c = xb_ld(&bar[XB_XCNT(j)]); sum += c; cnt += (c > 0u) ? 1u : 0u; mine = (j == x) ? c : mine; }
        if (sum == G) break;
        __builtin_amdgcn_s_sleep(1);
        if ((++sp & 255u) == 0u) { if (xb_ld(&bar[XB_TMO])) break; if (sp > XB_SPIN_CAP) { atomicAdd(&bar[XB_TMO], 1u); break; } }
    }
    nloc = mine > 0u ? mine : 1u; nx = cnt > 0u ? cnt : 1u;
}
__device__ __forceinline__ void xcd_barrier(const XcdBarrier& b) {
    asm volatile("s_waitcnt vmcnt(0)" ::: "memory");
    __syncthreads();
    if (threadIdx.x == 0) {
        unsigned* bar = b.bar;
        __builtin_amdgcn_s_waitcnt(0);
        unsigned nloc = b.st[0], nx = b.st[1];
        if (nloc == 0u) { xcd_barrier_complete(bar, b.x, nloc, nx); b.st[0] = nloc; b.st[1] = nx; }
        const unsigned old = xb_add(&bar[XB_XSUB(b.x)], 1u);
        const unsigned gen = old / nloc;
        if (old + 1u == (gen + 1u) * nloc) {
            __builtin_amdgcn_fence(__ATOMIC_RELEASE, "agent");
            asm volatile("s_waitcnt vmcnt(0)" ::: "memory");
            const unsigned og = xb_add(&bar[XB_TOP], 1u);
            const unsigned tg = og / nx;
            if (og + 1u == (tg + 1u) * nx) xb_add(&bar[XB_TOPGEN], 1u);
            else XB_SPIN(xb_ld(&bar[XB_TOPGEN]) == tg, bar);
            __builtin_amdgcn_fence(__ATOMIC_ACQUIRE, "agent");
            xb_add(&bar[XB_XGEN(b.x)], 1u);
            asm volatile("s_waitcnt vmcnt(0)" ::: "memory");
        } else {
            XB_SPIN(xb_ld(&bar[XB_XGEN(b.x)]) == gen, bar);
            __builtin_amdgcn_fence(__ATOMIC_ACQUIRE, "agent");
            asm volatile("s_waitcnt vmcnt(0)" ::: "memory");
        }
    }
    __syncthreads();
}

constexpr int RING_BYTES = 131072, LDSCTL_OFF = RING_BYTES, LDS_BYTES = 147456;
constexpr int KG_LDS = 122880;
constexpr int CW_BAR = 4096;
constexpr int NPHASES = 33;

struct Args { const float* in[N_INPUTS]; float* out; unsigned char* ws; int ph_lo, ph_hi; };
static_assert(sizeof(Args) == N_INPUTS * 8 + 8 + 8 + 8, "Args has no padding");

__device__ __forceinline__ CvtItem cvt_item(const Args& args, unsigned char* ws, int it, int& sg) {
    while (sg + 1 < NSEG && it >= SEGS[sg + 1].start) ++sg;
    const Seg s = SEGS[sg];
    const int nbc = s.ncols / 32, rr = it - s.start, kb = rr / nbc, nb = rr % nbc, n = 32 * nb;
    const int drow = s.drow0 + (s.inter ? (((n >> 7) << 8) + (n & 127)) : n);
    CvtItem c;
    c.src = args.in[s.in_idx] + s.src_off + (size_t)(64 * kb) * s.Nsrc + s.col0 + n;
    c.dst = (bf16_t*)(ws + (size_t)s.dst_mib * MiB) + (size_t)drow * s.K + 64 * kb;
    c.gain = s.gain_idx >= 0 ? args.in[s.gain_idx] + s.gain_off + 64 * kb : nullptr;
    c.Nsrc = s.Nsrc; c.K = s.K;
    return c;
}
__device__ __forceinline__ void convert_range(const Args& args, unsigned char* ws, int it0, int it1, int widx, int nw, int lane) {
    int sg = 0;
    int it = it0 + widx;
    for (; it + nw < it1; it += 2 * nw) {
        const CvtItem a = cvt_item(args, ws, it, sg); const CvtItem b = cvt_item(args, ws, it + nw, sg);
        f32x4 va[8], vb[8];
        cvt_load(a, lane, va); cvt_load(b, lane, vb);
        cvt_store(a, lane, va); cvt_store(b, lane, vb);
    }
    if (it < it1) { const CvtItem a = cvt_item(args, ws, it, sg); f32x4 va[8]; cvt_load(a, lane, va); cvt_store(a, lane, va); }
}

__global__ void __launch_bounds__(512, 2) trunk_fwd(Args args) {
    extern __shared__ __attribute__((aligned(16))) unsigned char lds_raw[];
    LAS unsigned char* lds = (LAS unsigned char*)lds_raw;
    const int tid = threadIdx.x, wave = __builtin_amdgcn_readfirstlane(tid >> 6);
    const int G = gridDim.x, bx = blockIdx.x;
    const int vcu = (G % 8 == 0) ? (bx % 8) * (G / 8) + bx / 8 : bx;
    const int gw = vcu * 8 + wave, NGW = G * 8, NT = NGW * 64;
    const bool plan_ok = (G == 256);
#define LANE_ ({ int t_ = threadIdx.x; asm volatile("" : "+v"(t_)); t_ & 63; })
#define GT_ (gw * 64 + LANE_)
    unsigned char* ws = args.ws;
    const int lo = args.ph_lo, hi = args.ph_hi;
    for (int u = tid; u < (LDS_BYTES - LDSCTL_OFF) / 4; u += 512) ((LAS unsigned*)(lds + LDSCTL_OFF))[u] = 0u;
    __syncthreads();
    XcdBarrier bar; bar.bar = (unsigned*)(ws + WS_CTL) + CW_BAR; bar.x = 0; bar.st = nullptr;
    if (hi - lo > 1) bar = xcd_barrier_post((unsigned*)(ws + WS_CTL) + CW_BAR, (volatile LAS unsigned*)(lds + LDSCTL_OFF + 64));

    float* PSUM = (float*)(ws + WS_PSUM); float* UPS = (float*)(ws + WS_UPS); float* PSMEM = (float*)(ws + WS_PSMEM); float* CB = (float*)(ws + WS_CB);
    bf16_t* XB = (bf16_t*)(ws + WS_XB); bf16_t* XL = (bf16_t*)(ws + WS_XL); bf16_t* MEMB = (bf16_t*)(ws + WS_MEMB); bf16_t* MKV = (bf16_t*)(ws + WS_MKV);
    bf16_t* CAT = (bf16_t*)(ws + WS_CAT); bf16_t* HID = (bf16_t*)(ws + WS_HID); bf16_t* U = (bf16_t*)(ws + WS_U); bf16_t* QM = (bf16_t*)(ws + WS_QM); bf16_t* KVM = (bf16_t*)(ws + WS_KVM);

    float* OUT = args.out;

    unsigned long long pacc = 0, pph = 0; (void)pph;
#define PH(id) if (PROBE_SEC == 6 && PROBE_ARG == (id)) pph = PT_NOW(); if (lo <= (id) && (id) < hi)
#define BAR(id) do { if (PROBE_SEC == 6 && PROBE_ARG == (id)) { asm volatile("s_waitcnt vmcnt(0)" ::: "memory"); __syncthreads(); pacc += PT_NOW() - pph; } \
        if (lo <= (id) && (id) + 1 < hi) { const bool pb_ = (PROBE_SEC == 1) || (PROBE_SEC == 7 && PROBE_ARG == (id)); const unsigned long long tb_ = pb_ ? PT_NOW() : 0ull; xcd_barrier(bar); if (pb_) pacc += PT_NOW() - tb_; } } while (0)
#define GEMM_PHASE_C(PC, EPI_T, E_INIT, Aptr, Bptr, M_, N_, K_, LDA_, C_) do { pg8::Gemm g_{(Aptr), (Bptr), (M_), (N_), (K_), (LDA_)}; pg8::StaticOrder S_; S_.init((M_), (N_), G, (C_)); \
        EPI_T E_ E_INIT; pg8::gemm_phase<EPI_T, pg8::StaticOrder, true, PC>(lds, g_, S_, E_, pacc); } while (0)
#define GEMM_PHASE(PC, EPI_T, E_INIT, Aptr, Bptr, M_, N_, K_, LDA_) do { pg8::Gemm g_{(Aptr), (Bptr), (M_), (N_), (K_), (LDA_)}; pg8::StaticOrder S_; S_.init((M_), (N_), G, bx); \
        EPI_T E_ E_INIT; pg8::gemm_phase<EPI_T, pg8::StaticOrder, true, PC>(lds, g_, S_, E_, pacc); } while (0)
#define COMMA ,
#define TAIL_SLOT(id) do { constexpr int k_ = slot_of(id); if constexpr (k_ >= 0) { if (plan_ok && bx >= SLOTS[k_].blk0) \
        convert_range(args, ws, SLOTS[k_].it0, SLOTS[k_].it1, (bx - SLOTS[k_].blk0) * 8 + wave, SLOTS[k_].nblk * 8, LANE_); } } while (0)

    PH(0) {
        convert_range(args, ws, 0, plan_ok ? P0_ITEMS : NITEMS, gw, NGW, LANE_);
        rowinit_items(args.in[I_X], XB, PSUM, MTOK, gw, NGW, LANE_);
        rowinit_items(args.in[I_MEM], MEMB, PSMEM, MMEM, gw, NGW, LANE_);
        { u32x4* z1 = (u32x4*)(ws + WS_WIN1 + (size_t)1600 * D_MODEL * 2); const int n1 = 192 * D_MODEL * 2 / 16; for (int i = GT_; i < n1; i += NT) z1[i] = (u32x4){0u, 0u, 0u, 0u};
          u32x4* z3 = (u32x4*)(ws + WS_WIN3 + (size_t)6688 * D_MODEL * 2); const int n3 = 224 * D_MODEL * 2 / 16; for (int i = GT_; i < n3; i += NT) z3[i] = (u32x4){0u, 0u, 0u, 0u}; }
    }
    BAR(0);

#define GU_PHASE(id, L, WHICH) PH(id) GEMM_PHASE(0, pg8::EpiSwiGLU, {HID COMMA PSUM}, XB, (const bf16_t*)(ws + WS_WGU + (size_t)(2 * (L) + (WHICH)) * WGU_BYTES), MTOK, N_GU, D_MODEL, D_MODEL)
#define DN_PHASE(id, L, WHICH, RMODE) PH(id) GEMM_PHASE(1, pg8::EpiResid<RMODE>, {args.in[I_X] COMMA OUT COMMA XB COMMA XL COMMA PSUM COMMA 0.5f}, HID, (const bf16_t*)(ws + WS_WD + (size_t)(2 * (L) + (WHICH)) * WD_BYTES), MTOK, D_MODEL, D_FF, D_FF); BAR(id)
#define OUT_PHASE(id, L) PH(id) GEMM_PHASE(3, pg8::EpiResid<1>, {args.in[I_X] COMMA OUT COMMA XB COMMA XL COMMA PSUM COMMA 1.0f}, CAT, (const bf16_t*)(ws + WS_WOUT + (size_t)(L) * WOUT_BYTES), MTOK, D_MODEL, K_OUT, K_OUT); BAR(id)
#define MEM_FA(L, UPITCH, MQCOL) do { FaArgs fa_; fa_.Q = U; fa_.q_pitch = (UPITCH); fa_.q_col0 = (MQCOL); fa_.q_hstride = 128; fa_.K = MKV; fa_.k_pitch = 4096; fa_.k_col0 = (L) * 1024; fa_.k_hstride = 128; fa_.kgain = args.in[I_MEM_KN] + (L) * 128; fa_.kg_lds = KG_LDS + 512; fa_.KR = nullptr; fa_.V = MKV; fa_.v_pitch = 4096; fa_.v_col0 = (L) * 1024 + 512; fa_.v_hstride = 128; \
        fa_.Skv = MEM_LEN; fa_.kv_group = 1; fa_.nheads = 4; fa_.O = CAT; fa_.o_pitch = K_OUT; fa_.o_col0 = 2048; fa_.qgain = args.in[I_MEM_QN] + (L) * 128; fa_.bias = nullptr; fa_.sinks = nullptr; \
        fa_.qscale = 0.08838834764831845f * LOG2E; fa_.mbound = fa_mbound(fa_.qgain, args.in[I_MEM_KN] + (L) * 128, 128, 0, fa_.qscale); \
        if (tid < 32) *(LAS f32x4*)(lds + KG_LDS + 512 + 16 * tid) = *(const f32x4*)(fa_.kgain + 4 * tid); __syncthreads(); \
        for (int i_ = bx; i_ < 16 * 8; i_ += G) fa_unit<128, 128, 3>(lds, fa_, (i_ >> 3) >> 2, (i_ >> 3) & 3, i_ & 7, pacc); } while (0)

    PH(1) {
        GEMM_PHASE(0, pg8::EpiSwiGLU, {HID COMMA PSUM}, XB, (const bf16_t*)(ws + WS_WGU), MTOK, N_GU, D_MODEL, D_MODEL);
        GEMM_PHASE_C(5, pg8::EpiScale<32 COMMA false>, {MKV COMMA 4096 COMMA PSMEM COMMA 32 COMMA 0 COMMA 1.0f / D_MODEL COMMA nullptr}, MEMB, (const bf16_t*)(ws + WS_WMKV), MMEM, 4096, D_MODEL, D_MODEL, plan_ok ? ((bx + 128) & 255) : bx);
        TAIL_SLOT(1);
    }
    BAR(1);
    DN_PHASE(2, 0, 0, 0);
    PH(3) {
        GEMM_PHASE(2, pg8::EpiScale<32 COMMA false>, {U COMMA NIN0 COMMA PSUM COMMA 32 COMMA 0 COMMA 1.0f / D_MODEL COMMA nullptr}, XB, (const bf16_t*)(ws + WS_WIN0), MTOK, NIN0, D_MODEL, D_MODEL);
        TAIL_SLOT(3);
    }
    BAR(3);
    PH(4) { conv_items(U, args.in[I_CONV_W], CAT, GT_, NT); MEM_FA(0, NIN0, 6144); TAIL_SLOT(4); }
    BAR(4);
    OUT_PHASE(5, 0);
    PH(6) { GEMM_PHASE(0, pg8::EpiSwiGLU, {HID COMMA PSUM}, XB, (const bf16_t*)(ws + WS_WGU + (size_t)1 * WGU_BYTES), MTOK, N_GU, D_MODEL, D_MODEL); TAIL_SLOT(6); }
    BAR(6);
    DN_PHASE(7, 0, 1, 1);

    PH(8) { GEMM_PHASE(0, pg8::EpiSwiGLU, {HID COMMA PSUM}, XB, (const bf16_t*)(ws + WS_WGU + (size_t)2 * WGU_BYTES), MTOK, N_GU, D_MODEL, D_MODEL); TAIL_SLOT(8); }
    BAR(8);
    DN_PHASE(9, 1, 0, 1);
    PH(10) { GEMM_PHASE(2, pg8::EpiScale<32 COMMA true>, {U COMMA NIN1 COMMA PSUM COMMA 32 COMMA 0 COMMA 1.0f / D_MODEL COMMA UPS}, XB, (const bf16_t*)(ws + WS_WIN1), MTOK, NIN1, D_MODEL, D_MODEL); TAIL_SLOT(10); }
    BAR(10);
    PH(11) {
        mla_krope_items(U, NIN1, 1536, args.in[I_MLA_KN] + 128, (bf16_t*)(ws + WS_MK), gw, NGW, LANE_);
        GEMM_PHASE(4, pg8::EpiScale<8 COMMA false>, {QM COMMA 3072 COMMA UPS COMMA 32 COMMA 0 COMMA 1.0f / 512.0f COMMA nullptr}, U, (const bf16_t*)(ws + WS_WQB), MTOK, 3072, 512, NIN1);
        GEMM_PHASE(4, pg8::EpiScale<8 COMMA false>, {KVM COMMA 4096 COMMA UPS COMMA 32 COMMA 8 COMMA 1.0f / 512.0f COMMA nullptr}, U + 512, (const bf16_t*)(ws + WS_WKVB), MTOK, 4096, 512, NIN1);
    }
    BAR(11);
    PH(13) {
        FaArgs fa; fa.Q = QM; fa.q_pitch = 3072; fa.q_col0 = 0; fa.q_hstride = 192; fa.K = KVM; fa.k_pitch = 4096; fa.k_col0 = 0; fa.k_hstride = 256; fa.kgain = args.in[I_MLA_KN]; fa.kg_lds = KG_LDS; fa.KR = (const bf16_t*)(ws + WS_MK);
        fa.V = KVM; fa.v_pitch = 4096; fa.v_col0 = 128; fa.v_hstride = 256; fa.Skv = SEQ; fa.kv_group = 1; fa.nheads = 16;
        if (tid < 32) *(LAS f32x4*)(lds + KG_LDS + 16 * tid) = *(const f32x4*)(fa.kgain + 4 * tid);
        __syncthreads();
        fa.O = CAT; fa.o_pitch = K_OUT; fa.o_col0 = 0; fa.qgain = args.in[I_MLA_QN]; fa.bias = nullptr; fa.sinks = nullptr; fa.qscale = 0.07216878364870323f * LOG2E; fa.mbound = fa_mbound(fa.qgain, args.in[I_MLA_KN], 128, 64, fa.qscale);
        for (int j = bx; j < 64 * 4; j += G) { const int bh = j >> 2, q4 = j & 3; for (int k = 0; k < 2; ++k) fa_unit<192, 128, 0>(lds, fa, bh >> 4, bh & 15, k ? q4 : 7 - q4, pacc); }
        MEM_FA(1, NIN1, 1024);
        TAIL_SLOT(13);
    }
    BAR(13);
    OUT_PHASE(14, 1);
    PH(15) { GEMM_PHASE(0, pg8::EpiSwiGLU, {HID COMMA PSUM}, XB, (const bf16_t*)(ws + WS_WGU + (size_t)3 * WGU_BYTES), MTOK, N_GU, D_MODEL, D_MODEL); TAIL_SLOT(15); }
    BAR(15);
    DN_PHASE(16, 1, 1, 1);

    PH(17) { GEMM_PHASE(0, pg8::EpiSwiGLU, {HID COMMA PSUM}, XB, (const bf16_t*)(ws + WS_WGU + (size_t)4 * WGU_BYTES), MTOK, N_GU, D_MODEL, D_MODEL); TAIL_SLOT(17); }
    BAR(17);
    DN_PHASE(18, 2, 0, 1);
    PH(19) { GEMM_PHASE(2, pg8::EpiScale<32 COMMA false>, {U COMMA NIN2 COMMA PSUM COMMA 32 COMMA 0 COMMA 1.0f / D_MODEL COMMA nullptr}, XB, (const bf16_t*)(ws + WS_WIN2), MTOK, NIN2, D_MODEL, D_MODEL); TAIL_SLOT(19); }
    BAR(19);
    PH(21) {
        FaArgs fa; fa.Q = U; fa.q_pitch = NIN2; fa.q_col0 = 0; fa.q_hstride = 64; fa.K = U; fa.k_pitch = NIN2; fa.k_col0 = 2048; fa.k_hstride = 64; fa.kgain = args.in[I_SWA_KN]; fa.kg_lds = 0; fa.KR = nullptr;
        fa.V = U; fa.v_pitch = NIN2; fa.v_col0 = 2304; fa.v_hstride = 64; fa.Skv = SEQ; fa.kv_group = 8; fa.nheads = 32;
        fa.O = CAT; fa.o_pitch = K_OUT; fa.o_col0 = 0; fa.qgain = args.in[I_SWA_QN]; fa.bias = args.in[I_REL_BIAS]; fa.sinks = args.in[I_SWA_SINKS]; fa.qscale = 0.125f * LOG2E; fa.mbound = fa_mbound(fa.qgain, args.in[I_SWA_KN], 64, 0, fa.qscale);
        for (int i = bx, k = 0; i < 128 * 8; i += G, ++k) { const int bh = i >> 3; fa_unit<64, 64, 1>(lds, fa, bh >> 5, bh & 31, (i + k) & 7, pacc); }
        MEM_FA(2, NIN2, 2560);
        TAIL_SLOT(21);
    }
    BAR(21);
    OUT_PHASE(22, 2);
    PH(23) { GEMM_PHASE(0, pg8::EpiSwiGLU, {HID COMMA PSUM}, XB, (const bf16_t*)(ws + WS_WGU + (size_t)5 * WGU_BYTES), MTOK, N_GU, D_MODEL, D_MODEL); TAIL_SLOT(23); }
    BAR(23);
    DN_PHASE(24, 2, 1, 1);

    PH(25) { GEMM_PHASE(0, pg8::EpiSwiGLU, {HID COMMA PSUM}, XB, (const bf16_t*)(ws + WS_WGU + (size_t)6 * WGU_BYTES), MTOK, N_GU, D_MODEL, D_MODEL); TAIL_SLOT(25); }
    BAR(25);
    DN_PHASE(26, 3, 0, 1);
    PH(27) { GEMM_PHASE(2, pg8::EpiScale<32 COMMA false>, {U COMMA NIN3 COMMA PSUM COMMA 32 COMMA 0 COMMA 1.0f / D_MODEL COMMA nullptr}, XB, (const bf16_t*)(ws + WS_WIN3), MTOK, NIN3, D_MODEL, D_MODEL); TAIL_SLOT(27); }
    BAR(27);
    PH(28) { fox_scan_items(U, NIN3, 6656, args.in[I_FOX_BF], CB, gw, NGW, LANE_); }
    BAR(28);
    PH(29) {
        FaArgs fa; fa.Q = U; fa.q_pitch = NIN3; fa.q_col0 = 0; fa.q_hstride = 64; fa.K = U; fa.k_pitch = NIN3; fa.k_col0 = 2048; fa.k_hstride = 64; fa.kgain = args.in[I_FOX_KN]; fa.kg_lds = 0; fa.KR = nullptr;
        fa.V = U; fa.v_pitch = NIN3; fa.v_col0 = 4096; fa.v_hstride = 64; fa.Skv = SEQ; fa.kv_group = 1; fa.nheads = 32;
        fa.O = CAT; fa.o_pitch = K_OUT; fa.o_col0 = 0; fa.qgain = args.in[I_FOX_QN]; fa.bias = CB; fa.sinks = nullptr; fa.qscale = 0.125f * LOG2E; fa.mbound = fa_mbound(fa.qgain, args.in[I_FOX_KN], 64, 0, fa.qscale);
        for (int j = bx; j < 128 * 4; j += G) { const int bh = j >> 2, q4 = j & 3; for (int k = 0; k < 2; ++k) fa_unit<64, 64, 2>(lds, fa, bh >> 5, bh & 31, k ? q4 : 7 - q4, pacc); }
        MEM_FA(3, NIN3, 6144);
        TAIL_SLOT(29);
    }
    BAR(29);
    OUT_PHASE(30, 3);
    PH(31) { GEMM_PHASE(0, pg8::EpiSwiGLU, {HID COMMA PSUM}, XB, (const bf16_t*)(ws + WS_WGU + (size_t)7 * WGU_BYTES), MTOK, N_GU, D_MODEL, D_MODEL); TAIL_SLOT(31); }
    BAR(31);
    DN_PHASE(32, 3, 1, 2);
    if (PROBE_SEC != 0 && bx == 0 && wave == 0) { const unsigned long long t_end = PT_NOW() + PROBE_K * pacc; while (PT_NOW() < t_end) __builtin_amdgcn_s_sleep(32); }
}

extern "C" void kernel_launch(void* const* d_in, const int* in_sizes, int n_in, void* d_out, int out_size, void* d_ws, size_t ws_size, hipStream_t stream) {
    static int grid = 0;
    if (grid == 0) {
        if (n_in != N_INPUTS || out_size != MTOK * D_MODEL || ws_size < WS_END) { fprintf(stderr, "kernel_launch: unexpected problem: n_in %d out %d ws %zu (need %zu)\n", n_in, out_size, ws_size, (size_t)WS_END); grid = -1; return; }
        int dev = 0, cus = 0, per_cu = 0;
        if (hipGetDevice(&dev) != hipSuccess || hipDeviceGetAttribute(&cus, hipDeviceAttributeMultiprocessorCount, dev) != hipSuccess) { grid = -1; return; }
        if (hipFuncSetAttribute((const void*)trunk_fwd, hipFuncAttributeMaxDynamicSharedMemorySize, LDS_BYTES) != hipSuccess) { fprintf(stderr, "kernel_launch: hipFuncSetAttribute failed\n"); grid = -1; return; }
        if (hipOccupancyMaxActiveBlocksPerMultiprocessor(&per_cu, (const void*)trunk_fwd, 512, LDS_BYTES) != hipSuccess || per_cu < 1)
            fprintf(stderr, "kernel_launch: note: occupancy query reports %d workgroups per CU\n", per_cu);
        (void)hipGetLastError();
        grid = cus;
    }
    if (grid < 0) return;
    if (hipMemsetAsync((char*)d_ws + WS_CTL, 0, CTL_ZERO_BYTES, stream) != hipSuccess) { fprintf(stderr, "kernel_launch: memset failed\n"); return; }
    Args a{};
    for (int i = 0; i < N_INPUTS; ++i) a.in[i] = (const float*)d_in[i];
    a.out = (float*)d_out; a.ws = (unsigned char*)d_ws;
#if MK_ONE_LAUNCH
    a.ph_lo = 0; a.ph_hi = NPHASES;
    hipLaunchKernelGGL(trunk_fwd, dim3(grid), dim3(512), LDS_BYTES, stream, a);
#else
    for (int p = 0; p < NPHASES; ++p) { a.ph_lo = p; a.ph_hi = p + 1; hipLaunchKernelGGL(trunk_fwd, dim3(grid), dim3(512), LDS_BYTES, stream, a); }
#endif
    const hipError_t le = hipPeekAtLastError();
    if (le != hipSuccess) fprintf(stderr, "kernel_launch: launch failed: %s\n", hipGetErrorName(le));
}
```

```cpp
#include <hip/hip_runtime.h>
#include <cstdio>
#include <cstdint>

#ifndef MK_ONE_LAUNCH
#define MK_ONE_LAUNCH 1
#endif

#ifndef PROBE_SEC
#define PROBE_SEC 0
#endif
#ifndef PROBE_ARG
#define PROBE_ARG 0
#endif
#define PROBE_K 8
#define PT_NOW() ((unsigned long long)__builtin_amdgcn_s_memrealtime())

#define LAS __attribute__((address_space(3)))
typedef unsigned short bf16_t;
typedef short bf16x8 __attribute__((ext_vector_type(8)));
typedef float f32x4 __attribute__((ext_vector_type(4)));
typedef float f32x16 __attribute__((ext_vector_type(16)));
typedef unsigned u32x4 __attribute__((ext_vector_type(4)));
typedef unsigned u32x2 __attribute__((ext_vector_type(2)));

constexpr int D_MODEL = 2048, BATCH = 4, SEQ = 2048, MTOK = BATCH * SEQ, D_FF = 5632, MEM_LEN = 256, MMEM = BATCH * MEM_LEN;
constexpr int N_GU = 2 * D_FF;
constexpr int NIN0 = 6656, NIN1 = 1792, NIN2 = 3072, NIN3 = 6912;
constexpr int K_OUT = 2560;
constexpr float RMS_EPS = 1e-6f;
constexpr float LOG2E = 1.4426950408889634f;

constexpr size_t MiB = 1u << 20;
constexpr size_t WS_CTL = 0, CTL_ZERO_BYTES = 1 * MiB;
constexpr size_t WS_PSUM = 1 * MiB, WS_UPS = 2 * MiB, WS_PSMEM = 3 * MiB, WS_CB = 4 * MiB;
constexpr size_t WS_XB = 8 * MiB, WS_MEMB = 40 * MiB, WS_MKV = 44 * MiB, WS_MK = 52 * MiB, WS_MVT = 56 * MiB;
constexpr size_t WS_CAT = 60 * MiB, WS_HID = 100 * MiB, WS_U = 188 * MiB, WS_QM = 296 * MiB, WS_KVM = 344 * MiB;
constexpr size_t WS_KBUF = 408 * MiB, WS_VTBUF = 456 * MiB;
constexpr size_t WS_WGU = 488 * MiB;
constexpr size_t WS_WD = 840 * MiB;
constexpr size_t WS_WIN0 = 1016 * MiB, WS_WIN1 = 1042 * MiB, WS_WIN2 = 1049 * MiB, WS_WIN3 = 1061 * MiB;
constexpr size_t WS_WOUT = 1088 * MiB;
constexpr size_t WS_WQB = 1128 * MiB, WS_WKVB = 1131 * MiB, WS_WMKV = 1135 * MiB, WS_XL = 1151 * MiB, WS_END = 1183 * MiB;
constexpr size_t WGU_BYTES = (size_t)N_GU * D_MODEL * 2, WD_BYTES = (size_t)D_MODEL * D_FF * 2, WOUT_BYTES = (size_t)D_MODEL * K_OUT * 2;
static_assert(WGU_BYTES == 44 * MiB && WD_BYTES == 22 * MiB && WOUT_BYTES == 10 * MiB, "weight sizes");

enum { I_X = 0, I_MEM, I_NORM_FFN1, I_F1G, I_F1U, I_F1D, I_NORM_MIX, I_NORM_FFN2, I_F2G, I_F2U, I_F2D, I_NORM_MEM, I_MEM_WKV, I_MEM_QN, I_MEM_KN,
       I_CONV_WIN, I_CONV_W, I_CONV_WOUT, I_MLA_WIN, I_MLA_QAN, I_MLA_WQB, I_MLA_KVAN, I_MLA_WKVB, I_MLA_QN, I_MLA_KN, I_MLA_WOUT,
       I_SWA_WIN, I_SWA_QN, I_SWA_KN, I_SWA_SINKS, I_SWA_WOUT, I_REL_BIAS, I_FOX_WIN, I_FOX_BF, I_FOX_QN, I_FOX_KN, I_FOX_WOUT, N_INPUTS };

__device__ __forceinline__ unsigned pk2(float lo, float hi) {
    typedef __bf16 b2 __attribute__((ext_vector_type(2))); typedef float f2 __attribute__((ext_vector_type(2)));
    return __builtin_bit_cast(unsigned, __builtin_convertvector((f2){lo, hi}, b2)); }
__device__ __forceinline__ float bf_lo(unsigned w) { return __uint_as_float(w << 16); }
__device__ __forceinline__ float bf_hi(unsigned w) { return __uint_as_float(w & 0xffff0000u); }
__device__ __forceinline__ void unpack8(const u32x4 v, float (&f)[8]) {
    f[0] = bf_lo(v.x); f[1] = bf_hi(v.x); f[2] = bf_lo(v.y); f[3] = bf_hi(v.y); f[4] = bf_lo(v.z); f[5] = bf_hi(v.z); f[6] = bf_lo(v.w); f[7] = bf_hi(v.w); }
__device__ __forceinline__ u32x4 pack8(const float (&f)[8]) { u32x4 o; o.x = pk2(f[0], f[1]); o.y = pk2(f[2], f[3]); o.z = pk2(f[4], f[5]); o.w = pk2(f[6], f[7]); return o; }
#define GAS __attribute__((address_space(1)))
__device__ __forceinline__ const GAS char* uni_ptr(const char* p) {
    const unsigned long long v = (unsigned long long)p; const unsigned lo = __builtin_amdgcn_readfirstlane((unsigned)v), hi = __builtin_amdgcn_readfirstlane((unsigned)(v >> 32));
    return (const GAS char*)(((unsigned long long)hi << 32) | lo); }
__device__ __forceinline__ float xor32_sum(float x) {
    const auto rr = __builtin_amdgcn_permlane32_swap(__float_as_uint(x), __float_as_uint(x), false, false);
    return __uint_as_float(rr[0]) + __uint_as_float(rr[1]); }
template <int CTRL> __device__ __forceinline__ float dpp_f(float x) { return __int_as_float(__builtin_amdgcn_update_dpp(0, __float_as_int(x), CTRL, 0xF, 0xF, true)); }
template <int N> __device__ __forceinline__ float group_sum(float s) {
    s += dpp_f<0xB1>(s); s += dpp_f<0x4E>(s); s += dpp_f<0x141>(s);
    if constexpr (N == 16) s += dpp_f<0x140>(s);
    return s;
}
__device__ __forceinline__ float rope_invf_turns(int i) {
    return __builtin_amdgcn_exp2f(-(float)i * (13.287712379549449f / 32.0f)) * 0.15915494309189535f; }
__device__ __forceinline__ void rope_cs(int pos, int i, float& c, float& s) {
    float t = (float)pos * rope_invf_turns(i); t = t - floorf(t); c = __builtin_amdgcn_cosf(t); s = __builtin_amdgcn_sinf(t); }

namespace pg8 {
constexpr int BM = 256, BK = 64, HALF = 128, HTB = HALF * BK * 2, STAGE_BYTES = 8 * HTB, NXCD = 8, WGM = 8;
__host__ __device__ __forceinline__ int lds_byte(int r, int c) { const int st = (r >> 4) * 2 + (c >> 5), rr = r & 15, cc = c & 31, ob = rr * 64 + cc * 2; return st * 1024 + (ob ^ (((ob >> 9) & 1) << 5)); }
__host__ __device__ __forceinline__ void stage_rc(int b, int& R, int& C) { const int st = b / 1024, sb = b % 1024, swz = sb ^ (((sb >> 9) & 1) << 5); R = (st >> 1) * 16 + swz / 64; C = (st & 1) * 32 + (swz % 64) / 2; }
__host__ __device__ __forceinline__ int perm32(int rho) { const int n = rho >> 4, i = rho & 15; return 8 * (i >> 2) + 4 * n + (i & 3); }
struct Unit { int pm, pn; };
struct Gemm { const bf16_t* A; const bf16_t* Bt; int M, N, K, lda; };
struct StaticOrder {
    int nM, nN, nwg, G, c;
    __host__ __device__ void init(int M, int N, int G_, int c_) { nM = M / BM; nN = N / BM; nwg = nM * nN; G = G_; c = c_; }
    __host__ __device__ bool next(int i, Unit& u) const {
        const long L = (long)i * G + c; if (L >= nwg) return false;
        int wgid = (int)L; { const int q = nwg / NXCD, r = nwg % NXCD, xcd = wgid % NXCD, off = wgid / NXCD; wgid = (xcd < r ? xcd * (q + 1) : r * (q + 1) + (xcd - r) * q) + off; }
        const int nig = WGM * nN, gid = wgid / nig, fm = gid * WGM, gsz = (nM - fm) < WGM ? (nM - fm) : WGM;
        u.pm = fm + ((wgid % nig) % gsz); u.pn = (wgid % nig) / gsz; return true;
    }
    __device__ __forceinline__ void a_ready(const Unit&) const {}
    __device__ __forceinline__ void done(const Unit&) const {}
};

struct EpiCtx { LAS float* tab; int parity; bool has_next; int nxt_pm; int tid; };
template <int CNT> struct RstdPf {
    f32x4 v[CNT / 4];
    __device__ __forceinline__ void issue(const float* ps, int pitch, int off, int row) {
        const float* p = ps + (size_t)row * pitch + off;
#pragma unroll
        for (int i = 0; i < CNT / 4; ++i) v[i] = *(const f32x4*)(p + 4 * i);
    }
    __device__ __forceinline__ float finish(float inv_dim) const {
        float s = 0.f;
#pragma unroll
        for (int i = 0; i < CNT / 4; ++i) s += (v[i][0] + v[i][1]) + (v[i][2] + v[i][3]);
        return __builtin_amdgcn_rsqf(s * inv_dim + RMS_EPS);
    }
};
__device__ __forceinline__ void tab_rstd(const EpiCtx& c, int wr, int fr, float (&rs)[2][4]) {
#pragma unroll
    for (int ai = 0; ai < 2; ++ai)
#pragma unroll
        for (int m = 0; m < 4; ++m) rs[ai][m] = c.tab[c.parity * 256 + ai * HALF + wr * 64 + m * 16 + fr];
}
__device__ __forceinline__ float silu_mul(float g, float u) { return g * __builtin_amdgcn_rcpf(1.0f + __builtin_amdgcn_exp2f(-g * LOG2E)) * u; }

struct EpiSwiGLU {
    static constexpr bool PERM = true, AFTER_DRAIN = false;
    bf16_t* H; const float* ps;
    __device__ __forceinline__ void prime(const Unit& u, LAS float* tab, int tid) const {
        if (tid < 256) { RstdPf<32> pf; pf.issue(ps, 32, 0, u.pm * BM + tid); tab[tid] = pf.finish(1.0f / D_MODEL); } }
    __device__ __forceinline__ void operator()(const f32x4 (&acc)[2][2][4][2], const Unit& u, int wr, int wc, int fr, int fq, const EpiCtx& c) const {
        const int row0 = u.pm * BM + wr * 64 + fr, col0 = u.pn * 128 + wc * 32 + 8 * fq;
        RstdPf<32> pf; const bool do_pf = c.has_next && c.tid < 256;
        if (do_pf) pf.issue(ps, 32, 0, c.nxt_pm * BM + c.tid);
        float rs[2][4]; tab_rstd(c, wr, fr, rs);
#pragma unroll
        for (int ai = 0; ai < 2; ++ai)
#pragma unroll
            for (int m = 0; m < 4; ++m) {
                const int row = row0 + ai * HALF + m * 16;
                const float r = rs[ai][m];
                const f32x4 g0 = acc[ai][0][m][0] * r, g1 = acc[ai][0][m][1] * r, u0 = acc[ai][1][m][0] * r, u1 = acc[ai][1][m][1] * r;
                u32x4 w;
                w.x = pk2(silu_mul(g0[0], u0[0]), silu_mul(g0[1], u0[1])); w.y = pk2(silu_mul(g0[2], u0[2]), silu_mul(g0[3], u0[3]));
                w.z = pk2(silu_mul(g1[0], u1[0]), silu_mul(g1[1], u1[1])); w.w = pk2(silu_mul(g1[2], u1[2]), silu_mul(g1[3], u1[3]));
                *(u32x4*)(H + (size_t)row * D_FF + col0) = w;
            }
        if (do_pf) c.tab[(c.parity ^ 1) * 256 + c.tid] = pf.finish(1.0f / D_MODEL);
    }
};
template <int MODE> struct EpiResid {
    static constexpr bool PERM = true, AFTER_DRAIN = false;
    const float* base32; float* out32; bf16_t* xh; bf16_t* xl; float* ps; float alpha;
    __device__ __forceinline__ void prime(const Unit&, LAS float*, int) const {}
    __device__ __forceinline__ void load_q(int q, int row0, int col0, f32x4 (&bv)[2][2][2]) const {
#pragma unroll
        for (int mm = 0; mm < 2; ++mm)
#pragma unroll
            for (int bj = 0; bj < 2; ++bj) {
                const size_t o = (size_t)(row0 + (q >> 1) * HALF + (2 * (q & 1) + mm) * 16) * D_MODEL + col0 + bj * HALF;
                if constexpr (MODE == 0) { bv[mm][bj][0] = *(const f32x4*)(base32 + o); bv[mm][bj][1] = *(const f32x4*)(base32 + o + 4); }
                else { const u32x4 h = *(const u32x4*)(xh + o), l = *(const u32x4*)(xl + o);
                       bv[mm][bj][0] = (f32x4){bf_lo(h.x) + bf_lo(l.x), bf_hi(h.x) + bf_hi(l.x), bf_lo(h.y) + bf_lo(l.y), bf_hi(h.y) + bf_hi(l.y)};
                       bv[mm][bj][1] = (f32x4){bf_lo(h.z) + bf_lo(l.z), bf_hi(h.z) + bf_hi(l.z), bf_lo(h.w) + bf_lo(l.w), bf_hi(h.w) + bf_hi(l.w)}; }
            }
    }
    __device__ __forceinline__ void store_q(int q, const f32x4 (&acc)[2][2][4][2], const Unit& u, int row0, int col0, int wc, int fq, const f32x4 (&bv)[2][2][2]) const {
        const int ai = q >> 1;
#pragma unroll
        for (int mm = 0; mm < 2; ++mm) {
            const int m = 2 * (q & 1) + mm, row = row0 + ai * HALF + m * 16; const size_t off = (size_t)row * D_MODEL + col0;
            float ss = 0.f;
#pragma unroll
            for (int bj = 0; bj < 2; ++bj) {
                const f32x4 v0 = bv[mm][bj][0] + acc[ai][bj][m][0] * alpha, v1 = bv[mm][bj][1] + acc[ai][bj][m][1] * alpha;
                if constexpr (MODE == 2) { *(f32x4*)(out32 + off + bj * HALF) = v0; *(f32x4*)(out32 + off + bj * HALF + 4) = v1; }
                else {
                    u32x4 h; h.x = pk2(v0[0], v0[1]); h.y = pk2(v0[2], v0[3]); h.z = pk2(v1[0], v1[1]); h.w = pk2(v1[2], v1[3]);
                    u32x4 l; l.x = pk2(v0[0] - bf_lo(h.x), v0[1] - bf_hi(h.x)); l.y = pk2(v0[2] - bf_lo(h.y), v0[3] - bf_hi(h.y));
                    l.z = pk2(v1[0] - bf_lo(h.z), v1[1] - bf_hi(h.z)); l.w = pk2(v1[2] - bf_lo(h.w), v1[3] - bf_hi(h.w));
                    *(u32x4*)(xh + off + bj * HALF) = h; *(u32x4*)(xl + off + bj * HALF) = l;
                    ss += (v0[0] * v0[0] + v0[1] * v0[1]) + (v0[2] * v0[2] + v0[3] * v0[3]) + (v1[0] * v1[0] + v1[1] * v1[1]) + (v1[2] * v1[2] + v1[3] * v1[3]);
                }
            }
            if constexpr (MODE != 2) { ss += __shfl_xor(ss, 16); ss += __shfl_xor(ss, 32); if (fq == 0) ps[(size_t)row * 32 + u.pn * 4 + wc] = ss; }
        }
    }
    __device__ __forceinline__ void operator()(const f32x4 (&acc)[2][2][4][2], const Unit& u, int wr, int wc, int fr, int fq, const EpiCtx&) const {
        const int row0 = u.pm * BM + wr * 64 + fr, col0 = u.pn * BM + wc * 32 + 8 * fq;
        f32x4 b0[2][2][2], b1[2][2][2];
        load_q(0, row0, col0, b0);
        load_q(1, row0, col0, b1); store_q(0, acc, u, row0, col0, wc, fq, b0);
        load_q(2, row0, col0, b0); store_q(1, acc, u, row0, col0, wc, fq, b1);
        load_q(3, row0, col0, b1); store_q(2, acc, u, row0, col0, wc, fq, b0);
        store_q(3, acc, u, row0, col0, wc, fq, b1);
    }
};
template <int CNT, bool WPS> struct EpiScale {
    static constexpr bool PERM = true, AFTER_DRAIN = false;
    bf16_t* O; int ldo; const float* ps; int ps_pitch, ps_off; float inv_dim; float* ops;
    __device__ __forceinline__ void prime(const Unit& u, LAS float* tab, int tid) const {
        if (tid < 256) { RstdPf<CNT> pf; pf.issue(ps, ps_pitch, ps_off, u.pm * BM + tid); tab[tid] = pf.finish(inv_dim); } }
    __device__ __forceinline__ void operator()(const f32x4 (&acc)[2][2][4][2], const Unit& u, int wr, int wc, int fr, int fq, const EpiCtx& c) const {
        const int row0 = u.pm * BM + wr * 64 + fr, col0 = u.pn * BM + wc * 32 + 8 * fq;
        RstdPf<CNT> pf; const bool do_pf = c.has_next && c.tid < 256;
        if (do_pf) pf.issue(ps, ps_pitch, ps_off, c.nxt_pm * BM + c.tid);
        float rs[2][4]; tab_rstd(c, wr, fr, rs);
#pragma unroll
        for (int ai = 0; ai < 2; ++ai)
#pragma unroll
            for (int m = 0; m < 4; ++m) {
                const int row = row0 + ai * HALF + m * 16;
                const float r = rs[ai][m];
                float ss = 0.f;
#pragma unroll
                for (int bj = 0; bj < 2; ++bj) {
                    const f32x4 v0 = acc[ai][bj][m][0] * r, v1 = acc[ai][bj][m][1] * r;
                    if (WPS) ss += (v0[0] * v0[0] + v0[1] * v0[1]) + (v0[2] * v0[2] + v0[3] * v0[3]) + (v1[0] * v1[0] + v1[1] * v1[1]) + (v1[2] * v1[2] + v1[3] * v1[3]);
                    u32x4 w; w.x = pk2(v0[0], v0[1]); w.y = pk2(v0[2], v0[3]); w.z = pk2(v1[0], v1[1]); w.w = pk2(v1[2], v1[3]);
                    *(u32x4*)(O + (size_t)row * ldo + col0 + bj * HALF) = w;
                }
                if (WPS) { ss += __shfl_xor(ss, 16); ss += __shfl_xor(ss, 32); if (fq == 0) ops[(size_t)row * 32 + u.pn * 4 + wc] = ss; }
            }
        if (do_pf) c.tab[(c.parity ^ 1) * 256 + c.tid] = pf.finish(inv_dim);
    }
};

template <class Epi, class Sched, bool ALIGN_EPI = true, int PCLASS = 0>
__device__ __forceinline__ void gemm_phase(LAS unsigned char* lds, const Gemm g, const Sched& S, const Epi& E, unsigned long long& pacc) {
    constexpr bool PRB = ((PROBE_SEC >= 2 && PROBE_SEC <= 5) || PROBE_SEC == 8) && PROBE_ARG == PCLASS;
    unsigned long long pt0 = 0; (void)pt0;
#define PG8_PT0(sec) do { if constexpr (PRB && PROBE_SEC == (sec)) pt0 = PT_NOW(); } while (0)
#define PG8_PT1(sec) do { if constexpr (PRB && PROBE_SEC == (sec)) pacc += PT_NOW() - pt0; } while (0)
    PG8_PT0(2);
    int tid = threadIdx.x; asm volatile("" : "+v"(tid));
    const int wid = __builtin_amdgcn_readfirstlane(tid >> 6), lane = tid & 63, wr = wid >> 2, wc = wid & 3, fr = lane & 15, fq = lane >> 4;
    const int K = g.K, nt = K / BK, lda = g.lda;
    unsigned voffA[2], voffB[2];
#pragma unroll
    for (int i = 0; i < 2; ++i) { int R, C; stage_rc(tid * 16 + i * 8192, R, C); const int Rb = Epi::PERM ? ((R & ~31) + perm32(R & 31)) : R;
        voffA[i] = (unsigned)(R * lda + C) * 2u; voffB[i] = (unsigned)(Rb * K + C) * 2u; }
    const size_t kstep = (size_t)(BK * 2);
    const size_t hstepA = (size_t)HALF * lda * 2, hstepB = (size_t)HALF * K * 2;
    const size_t tstepA = 2 * hstepA, tstepB = 2 * hstepB;
    const unsigned ldsw = (unsigned)wid * 1024u;
    const int aoff = lds_byte(wr * 64 + fr, fq * 8), boff = lds_byte(wc * 32 + fr, fq * 8);
#define PG8_SA(b, h) (((b) * 2 + (h)) * HTB)
#define PG8_SB(b, h) ((4 + (b) * 2 + (h)) * HTB)
#define PG8_STAGE(bufoff, gbase, voff) do { _Pragma("unroll") for (int _i = 0; _i < 2; ++_i) \
        __builtin_amdgcn_global_load_lds((const unsigned*)((const char*)(gbase) + (voff)[_i]), (LAS unsigned*)(lds + (bufoff) + ldsw + _i * 8192), 16, 0, 0); } while (0)
#define PG8_LDA(dst, b, h) do { _Pragma("unroll") for (int m = 0; m < 4; ++m) _Pragma("unroll") for (int k = 0; k < 2; ++k) dst[m][k] = *(const LAS bf16x8*)(lds + PG8_SA(b, h) + aoff + m * 2048 + k * 1024); } while (0)
#define PG8_LDB(dst, b, h) do { _Pragma("unroll") for (int n = 0; n < 2; ++n) _Pragma("unroll") for (int k = 0; k < 2; ++k) dst[n][k] = *(const LAS bf16x8*)(lds + PG8_SB(b, h) + boff + n * 2048 + k * 1024); } while (0)
#define PG8_MMA(ai, bj, At, Bt) do { __builtin_amdgcn_s_setprio(1); _Pragma("unroll") for (int m = 0; m < 4; ++m) _Pragma("unroll") for (int n = 0; n < 2; ++n) _Pragma("unroll") for (int k = 0; k < 2; ++k) \
        acc[ai][bj][m][n] = __builtin_amdgcn_mfma_f32_16x16x32_bf16(Bt[n][k], At[m][k], acc[ai][bj][m][n], 0, 0, 0); __builtin_amdgcn_s_setprio(0); } while (0)
#define PG8_WAIT_V(n) asm volatile("s_waitcnt vmcnt(" #n ")" ::: "memory")
#define PG8_WAIT_L(n) asm volatile("s_waitcnt lgkmcnt(" #n ")" ::: "memory")
#define PG8_BAR __builtin_amdgcn_s_barrier()
#define PG8_SCHED __builtin_amdgcn_sched_barrier(0)
    Unit cur, nxt; int ui = 0;
    if (!S.next(0, cur)) return;
    f32x4 acc[2][2][4][2];
#pragma unroll
    for (int a = 0; a < 2; ++a)
#pragma unroll
        for (int b = 0; b < 2; ++b)
#pragma unroll
            for (int m = 0; m < 4; ++m)
#pragma unroll
                for (int n = 0; n < 2; ++n) acc[a][b][m][n] = (f32x4){0.f, 0.f, 0.f, 0.f};
    bf16x8 At[4][2], B0[2][2], B1[2][2];
    const char* cA = (const char*)g.A + (size_t)cur.pm * tstepA; const char* cB = (const char*)g.Bt + (size_t)cur.pn * tstepB;
    LAS float* rtab = (LAS float*)(lds + 131072 + 1024);
    E.prime(cur, rtab, tid); asm volatile("s_waitcnt vmcnt(0) lgkmcnt(0)" ::: "memory");
    S.a_ready(cur);
    PG8_STAGE(PG8_SB(0, 0), cB, voffB); PG8_STAGE(PG8_SB(0, 1), cB + hstepB, voffB); PG8_STAGE(PG8_SA(0, 0), cA, voffA); PG8_STAGE(PG8_SA(0, 1), cA + hstepA, voffA);
    if (wr == 1) PG8_BAR;
    PG8_WAIT_V(2); PG8_BAR;
    PG8_STAGE(PG8_SB(1, 0), cB + kstep, voffB); PG8_STAGE(PG8_SA(1, 0), cA + kstep, voffA); PG8_STAGE(PG8_SB(1, 1), cB + hstepB + kstep, voffB);
    PG8_WAIT_V(6); PG8_BAR;
    PG8_PT1(2);
    for (;;) {
        const bool has_next = S.next(ui + 1, nxt);
        PG8_PT0(3); if constexpr (PRB && PROBE_SEC == 8) pt0 = (unsigned long long)__builtin_readcyclecounter();
        const char* nA = has_next ? (const char*)g.A + (size_t)nxt.pm * tstepA : cA; const char* nB = has_next ? (const char*)g.Bt + (size_t)nxt.pn * tstepB : cB;
        for (int t = 0; t < nt; t += 2) {
            const bool last = (t == nt - 2);
            const char* a1 = cA + (size_t)(t + 1) * kstep;
            const char* a2 = last ? nA : cA + (size_t)(t + 2) * kstep; const char* b2 = last ? nB : cB + (size_t)(t + 2) * kstep;
            const char* a3 = a2 + kstep; const char* b3 = b2 + kstep;
            if (last && has_next) S.a_ready(nxt);
            PG8_LDB(B0, 0, 0); PG8_LDB(B1, 0, 1); PG8_SCHED; PG8_LDA(At, 0, 0); PG8_STAGE(PG8_SA(1, 1), a1 + hstepA, voffA);
            PG8_WAIT_V(8); PG8_WAIT_L(0); PG8_BAR; PG8_MMA(0, 0, At, B0); PG8_MMA(0, 1, At, B1); PG8_BAR; PG8_SCHED;
            PG8_LDA(At, 0, 1); PG8_STAGE(PG8_SB(0, 0), b2, voffB); PG8_STAGE(PG8_SB(0, 1), b2 + hstepB, voffB); PG8_STAGE(PG8_SA(0, 0), a2, voffA);
            PG8_WAIT_V(8); PG8_WAIT_L(0); PG8_BAR; PG8_MMA(1, 0, At, B0); PG8_MMA(1, 1, At, B1); PG8_BAR; PG8_SCHED;
            PG8_LDB(B0, 1, 0); PG8_LDB(B1, 1, 1); PG8_SCHED; PG8_LDA(At, 1, 0); PG8_STAGE(PG8_SA(0, 1), a2 + hstepA, voffA);
            PG8_WAIT_V(8); PG8_WAIT_L(0); PG8_BAR; PG8_MMA(0, 0, At, B0); PG8_MMA(0, 1, At, B1); PG8_BAR; PG8_SCHED;
            PG8_LDA(At, 1, 1); PG8_STAGE(PG8_SB(1, 0), b3, voffB); PG8_STAGE(PG8_SB(1, 1), b3 + hstepB, voffB); PG8_STAGE(PG8_SA(1, 0), a3, voffA);
            PG8_WAIT_V(8); PG8_WAIT_L(0); PG8_BAR; PG8_MMA(1, 0, At, B0); PG8_MMA(1, 1, At, B1); PG8_BAR; PG8_SCHED;
        }
        PG8_PT1(3); if constexpr (PRB && PROBE_SEC == 8) pacc += ((unsigned long long)__builtin_readcyclecounter() - pt0) >> 4; PG8_PT0(4);
        if constexpr (ALIGN_EPI) { if (wr == 0) PG8_BAR; }
        { const EpiCtx ec{rtab, ui & 1, has_next, nxt.pm, tid}; E(acc, cur, wr, wc, fr, fq, ec); } S.done(cur);
        PG8_PT1(4);
        if (!has_next) break;
#pragma unroll
        for (int a = 0; a < 2; ++a)
#pragma unroll
            for (int b = 0; b < 2; ++b)
#pragma unroll
                for (int m = 0; m < 4; ++m)
#pragma unroll
                    for (int n = 0; n < 2; ++n) acc[a][b][m][n] = (f32x4){0.f, 0.f, 0.f, 0.f};
        cur = nxt; cA = nA; cB = nB; ++ui;
        if constexpr (ALIGN_EPI) { if (wr == 1) PG8_BAR; }
    }
    PG8_PT0(5);
    PG8_WAIT_V(0);
    if constexpr (!ALIGN_EPI) { if (wr == 0) PG8_BAR; }
    PG8_BAR;
    PG8_PT1(5);
#undef PG8_PT0
#undef PG8_PT1
#undef PG8_SA
#undef PG8_SB
#undef PG8_STAGE
#undef PG8_LDA
#undef PG8_LDB
#undef PG8_MMA
#undef PG8_WAIT_V
#undef PG8_WAIT_L
#undef PG8_BAR
#undef PG8_SCHED
}
}

struct FaArgs {
    const bf16_t* Q; int q_pitch, q_col0, q_hstride;
    const bf16_t* K; int k_pitch, k_col0, k_hstride;
    const float* kgain; int kg_lds;
    const bf16_t* KR;
    int Skv, kv_group, nheads;
    const bf16_t* V; int v_pitch, v_col0, v_hstride;
    bf16_t* O; int o_pitch, o_col0;
    const float* qgain; const float* bias; const float* sinks; float qscale;
    float mbound;
};
__device__ __forceinline__ float fa_mbound(const float* gq, const float* gk, int n1, int n2, float qscale) {
    float aq = 0.f, ak = 0.f, bq = 0.f, bk = 0.f;
    for (int i = 0; i < n1; ++i) { aq = fmaxf(aq, fabsf(gq[i])); ak = fmaxf(ak, fabsf(gk[i])); }
    for (int i = n1; i < n1 + n2; ++i) { bq = fmaxf(bq, fabsf(gq[i])); bk = fmaxf(bk, fabsf(gk[i])); }
    return qscale * ((float)n1 * aq * ak + (float)n2 * bq * bk) * 1.02f + 0.25f;
}
__device__ const unsigned char T5_BUCKET[128] = {
    0, 1, 2, 3, 4, 5, 6, 7, 8, 9, 10, 11, 12, 13, 14, 15, 16, 16, 16, 17, 17, 18, 18, 18, 19, 19, 19, 20, 20, 20, 20, 21, 21, 21, 21, 22, 22, 22, 22, 22, 23, 23, 23, 23, 23, 23,
    24, 24, 24, 24, 24, 24, 25, 25, 25, 25, 25, 25, 25, 26, 26, 26, 26, 26, 26, 26, 26, 27, 27, 27, 27, 27, 27, 27, 27, 27, 27, 28, 28, 28, 28, 28, 28, 28, 28, 28, 28,
    29, 29, 29, 29, 29, 29, 29, 29, 29, 29, 29, 29, 30, 30, 30, 30, 30, 30, 30, 30, 30, 30, 30, 30, 30, 30, 31, 31, 31, 31, 31, 31, 31, 31, 31, 31, 31, 31, 31, 31, 31};

template <int DQK, int DV, int MODE>
__device__ __forceinline__ void fa_unit(LAS unsigned char* lds, const FaArgs& A, const int b, const int h, const int qb, unsigned long long& pacc) {
    constexpr bool FPRB = (PROBE_SEC >= 9 && PROBE_SEC <= 13 && PROBE_ARG == MODE);
    unsigned long long ft0 = 0; (void)ft0;
#define FA_PT0(sec) do { if constexpr (FPRB && PROBE_SEC == (sec)) ft0 = PT_NOW(); } while (0)
#define FA_PT1(sec) do { if constexpr (FPRB && PROBE_SEC == (sec)) pacc += PT_NOW() - ft0; } while (0)
    FA_PT0(12);
    constexpr int NKS = DQK / 16, NDB = DV / 32, KP = DQK + 8;
    constexpr int VPB = (DV == 64) ? 192 : 320;
    constexpr int KBYTES = 64 * KP * 2, VBYTES = 64 * VPB;
    constexpr int OFF_K = 0, OFF_V = 2 * KBYTES, OFF_B = OFF_V + 2 * VBYTES, OFF_TAB = OFF_B + 512;
    static_assert(OFF_TAB + 2048 <= 120 * 1024, "FA LDS");
    constexpr int DKN = (MODE == 0) ? 128 : DQK;
    constexpr int KCH = DKN / 8, KPTN = 64 * KCH / 512, KPTR = (MODE == 0) ? 1 : 0, KPT = KPTN + KPTR, VCH = DV / 8, VPT = DV * 8 / 512;
    static_assert(KPTN * 512 == 64 * KCH && VPT * 512 == DV * 8 && (KCH == 8 || KCH == 16), "FA staging");
    int tid = threadIdx.x; asm volatile("" : "+v"(tid));
    const int lane = tid & 63, w = __builtin_amdgcn_readfirstlane(tid >> 6), r = lane & 31, hh = lane >> 5;
    const int wrow = (MODE == 1) ? (w & 1) : w;
    const int hw = (MODE == 1) ? h + (w >> 1) : h;
    const int q0 = (MODE == 1) ? qb * 64 : qb * 256, qw0 = q0 + wrow * 32, qpos = qw0 + r;
    const int hk = (MODE == 1) ? h / A.kv_group : h;

    bf16x8 Qf[NKS];
    {
        int opq = 0; asm volatile("" : "+v"(opq));
        const GAS char* Qb = uni_ptr((const char*)(A.Q + (size_t)(b * SEQ + q0) * A.q_pitch + A.q_col0 + hw * A.q_hstride));
        const unsigned qoff = (unsigned)((wrow * 32 + r) * A.q_pitch + 8 * hh) * 2u;
        float qf[NKS][8];
#pragma unroll
        for (int ks = 0; ks < NKS; ++ks) { const u32x4 v = *(const GAS u32x4*)(Qb + qoff + 32 * ks); unpack8(v, qf[ks]); }
        if constexpr (MODE == 0) {
            float sn = 0.f, sr = 0.f;
#pragma unroll
            for (int ks = 0; ks < 8; ++ks)
#pragma unroll
                for (int j = 0; j < 8; ++j) sn += qf[ks][j] * qf[ks][j];
#pragma unroll
            for (int ks = 8; ks < 12; ++ks)
#pragma unroll
                for (int j = 0; j < 8; ++j) sr += qf[ks][j] * qf[ks][j];
            sn = xor32_sum(sn); sr = xor32_sum(sr);
            const float rn = 1.0f / sqrtf(sn * (1.0f / 128.0f) + RMS_EPS), rr = 1.0f / sqrtf(sr * (1.0f / 64.0f) + RMS_EPS);
#pragma unroll
            for (int ks = 0; ks < 8; ++ks) {
                const f32x4 g0 = *(const f32x4*)(A.qgain + 16 * ks + 8 * hh), g1 = *(const f32x4*)(A.qgain + 16 * ks + 8 * hh + 4);
#pragma unroll
                for (int j = 0; j < 4; ++j) { qf[ks][j] *= rn * g0[j] * A.qscale; qf[ks][4 + j] *= rn * g1[j] * A.qscale; }
            }
#pragma unroll
            for (int ks = 8; ks < 10; ++ks) {
                const int i0 = 16 * (ks - 8) + 8 * hh;
                const f32x4 ga0 = *(const f32x4*)(A.qgain + 128 + i0), ga1 = *(const f32x4*)(A.qgain + 128 + i0 + 4);
                const f32x4 gb0 = *(const f32x4*)(A.qgain + 160 + i0), gb1 = *(const f32x4*)(A.qgain + 160 + i0 + 4);
#pragma unroll
                for (int j = 0; j < 8; ++j) {
                    const float ga = j < 4 ? ga0[j & 3] : ga1[j & 3], gb = j < 4 ? gb0[j & 3] : gb1[j & 3];
                    const float t1 = qf[ks][j] * rr * ga, t2 = qf[ks + 2][j] * rr * gb;
                    float c, s; rope_cs(qpos, i0 + j + opq, c, s);
                    qf[ks][j] = (t1 * c - t2 * s) * A.qscale; qf[ks + 2][j] = (t1 * s + t2 * c) * A.qscale;
                }
            }
        } else {
            float ss = 0.f;
#pragma unroll
            for (int ks = 0; ks < NKS; ++ks)
#pragma unroll
                for (int j = 0; j < 8; ++j) ss += qf[ks][j] * qf[ks][j];
            ss = xor32_sum(ss);
            const float rs = 1.0f / sqrtf(ss * (1.0f / DQK) + RMS_EPS) * A.qscale;
#pragma unroll
            for (int ks = 0; ks < NKS; ++ks) {
                const f32x4 g0 = *(const f32x4*)(A.qgain + 16 * ks + 8 * hh), g1 = *(const f32x4*)(A.qgain + 16 * ks + 8 * hh + 4);
#pragma unroll
                for (int j = 0; j < 4; ++j) { qf[ks][j] *= rs * g0[j]; qf[ks][4 + j] *= rs * g1[j]; }
            }
        }
#pragma unroll
        for (int ks = 0; ks < NKS; ++ks) Qf[ks] = __builtin_bit_cast(bf16x8, pack8(qf[ks]));
    }
    float mshift = A.mbound;
    if constexpr (MODE == 1) {
        float mb = A.bias[(lane & 31) * 32 + hw];
#pragma unroll
        for (int o = 1; o < 32; o <<= 1) mb = fmaxf(mb, __shfl_xor(mb, o));
        mshift += mb * LOG2E;
        *(LAS float*)(lds + OFF_TAB + (tid >> 7) * 512 + 4 * (tid & 127)) = A.bias[(int)T5_BUCKET[tid & 127] * 32 + hw] * LOG2E - mshift;
    }
    if constexpr (MODE == 2) mshift += A.bias[(size_t)(b * A.nheads + h) * SEQ + qpos];

    int t_lo = 0, t_hi;
    if constexpr (MODE == 3) t_hi = A.Skv / 64; else if constexpr (MODE == 1) t_hi = qb + 1; else t_hi = 4 * qb + 4;
    if constexpr (MODE == 1) { const int lowk = q0 - 127; t_lo = lowk > 0 ? lowk / 64 : 0; }
    const int nt = t_hi - t_lo;
    const bf16_t* Kg = A.K + (size_t)(b * A.Skv) * A.k_pitch + A.k_col0 + hk * A.k_hstride;
    const bf16_t* KRg = (MODE == 0) ? A.KR + (size_t)(b * SEQ) * 64 : nullptr;
    const bf16_t* Vg = A.V + (size_t)(b * A.Skv) * A.v_pitch + A.v_col0 + hk * A.v_hstride;
    const float* Bg = (MODE == 2) ? A.bias + (size_t)(b * A.nheads + h) * SEQ : nullptr;
    u32x4 kst[KPT], vst[VPT]; f32x4 bst = (f32x4){0.f, 0.f, 0.f, 0.f};
    unsigned koff[KPT], voff[VPT];
#pragma unroll
    for (int i = 0; i < KPTN; ++i) { const int c = tid + 512 * i, row = c / KCH, cc = c % KCH; koff[i] = (unsigned)(row * A.k_pitch + cc * 8) * 2u; }
    if constexpr (MODE == 0) koff[KPTN] = (unsigned)((tid >> 3) * 64 + (tid & 7) * 8) * 2u;
    f32x4 kg0 = (f32x4){1.f, 1.f, 1.f, 1.f}, kg1 = kg0;
    if constexpr (KCH == 8) { kg0 = *(const f32x4*)(A.kgain + 8 * (tid & 7)); kg1 = *(const f32x4*)(A.kgain + 8 * (tid & 7) + 4); }
#pragma unroll
    for (int i = 0; i < VPT; ++i) { const int c = tid + 512 * i, key = c / VCH, cc = c % VCH; voff[i] = (unsigned)(key * A.v_pitch + cc * 8) * 2u; }
#define FA_LOAD(t) do { const GAS char* _kt = uni_ptr((const char*)Kg + (size_t)(64 * (t)) * A.k_pitch * 2); const GAS char* _vt = uni_ptr((const char*)Vg + (size_t)(64 * (t)) * A.v_pitch * 2); \
        _Pragma("unroll") for (int _i = 0; _i < KPTN; ++_i) kst[_i] = *(const GAS u32x4*)(_kt + koff[_i]); \
        if constexpr (MODE == 0) { const GAS char* _kr = uni_ptr((const char*)KRg + (size_t)(64 * (t)) * 64 * 2); kst[KPTN] = *(const GAS u32x4*)(_kr + koff[KPTN]); } \
        _Pragma("unroll") for (int _i = 0; _i < VPT; ++_i) vst[_i] = *(const GAS u32x4*)(_vt + voff[_i]); \
        if (MODE == 2) { if (tid < 16) bst = *(const f32x4*)(Bg + 64 * (t) + 4 * tid); } } while (0)
#define FA_WRITE(buf) do { \
        _Pragma("unroll") for (int _i = 0; _i < KPTN; ++_i) { const int _c = tid + 512 * _i, _row = _c / KCH, _cc = _c % KCH; \
            float _f[8]; unpack8(kst[_i], _f); float _ss = 0.f; \
            _Pragma("unroll") for (int _j = 0; _j < 8; ++_j) _ss += _f[_j] * _f[_j]; \
            _ss = group_sum<KCH>(_ss);            \
            const float _rs = __builtin_amdgcn_rsqf(_ss * (1.0f / DKN) + RMS_EPS); \
            f32x4 _g0 = kg0, _g1 = kg1; if constexpr (KCH == 16) { _g0 = *(const LAS f32x4*)(lds + A.kg_lds + 32 * _cc); _g1 = *(const LAS f32x4*)(lds + A.kg_lds + 32 * _cc + 16); } \
            _Pragma("unroll") for (int _j = 0; _j < 4; ++_j) { _f[_j] *= _rs * _g0[_j]; _f[4 + _j] *= _rs * _g1[_j]; } \
            *(LAS u32x4*)(lds + OFF_K + (buf) * KBYTES + (_row * KP + _cc * 8) * 2) = pack8(_f); } \
        if constexpr (MODE == 0) *(LAS u32x4*)(lds + OFF_K + (buf) * KBYTES + ((tid >> 3) * KP + 128 + (tid & 7) * 8) * 2) = kst[KPTN]; \
        _Pragma("unroll") for (int _i = 0; _i < VPT; ++_i) { const int _c = tid + 512 * _i, _key = _c / VCH, _cc = _c % VCH; *(LAS u32x4*)(lds + OFF_V + (buf) * VBYTES + _key * VPB + _cc * 16) = vst[_i]; } \
        if (MODE == 2) { if (tid < 16) *(LAS f32x4*)(lds + OFF_B + (buf) * 256 + 16 * tid) = bst; } } while (0)

    f32x16 O[NDB];
#pragma unroll
    for (int db = 0; db < NDB; ++db)
#pragma unroll
        for (int i = 0; i < 16; ++i) O[db][i] = 0.f;
    float l_run = 0.f;
    FA_LOAD(t_lo);
    FA_PT1(12);
    for (int it = 0; it < nt; ++it) {
        const int t = t_lo + it, buf = it & 1;
        FA_PT0(10);
        FA_WRITE(buf);
        asm volatile("s_waitcnt lgkmcnt(0)" ::: "memory");
        FA_PT1(10); FA_PT0(9);
        __syncthreads();
        FA_PT1(9); FA_PT0(11);
        if (it + 1 < nt) FA_LOAD(t + 1);
#pragma unroll
        for (int sub = 0; sub < 2; ++sub) {
            const int ks0 = 64 * t + 32 * sub;
            bool active = true;
            if constexpr (MODE == 0 || MODE == 2) active = (ks0 <= qw0 + 31);
            if constexpr (MODE == 1) active = (ks0 <= qw0 + 31) && (ks0 + 31 >= qw0 - 127);
            if (!active) continue;
            f32x16 s;
            if constexpr (MODE == 2) {
#pragma unroll
                for (int g = 0; g < 4; ++g) { const f32x4 bb = *(const LAS f32x4*)(lds + OFF_B + buf * 256 + (32 * sub + 8 * g + 4 * hh) * 4); s[4 * g] = bb[0]; s[4 * g + 1] = bb[1]; s[4 * g + 2] = bb[2]; s[4 * g + 3] = bb[3]; }
            } else if constexpr (MODE == 1) {
#pragma unroll
                for (int i = 0; i < 16; ++i) { int dist = qpos - (ks0 + (i & 3) + 8 * (i >> 2) + 4 * hh); dist = dist < 0 ? 0 : (dist > 127 ? 127 : dist); s[i] = *(const LAS float*)(lds + OFF_TAB + (w >> 1) * 512 + 4 * dist); }
            } else {
#pragma unroll
                for (int i = 0; i < 16; ++i) s[i] = -mshift;
            }
#pragma unroll
            for (int ks = 0; ks < NKS; ++ks) {
                const bf16x8 a = *(const LAS bf16x8*)(lds + OFF_K + buf * KBYTES + ((32 * sub + r) * KP + 16 * ks + 8 * hh) * 2);
                s = __builtin_amdgcn_mfma_f32_32x32x16_bf16(a, Qf[ks], s, 0, 0, 0);
            }
            u32x2 vf[NDB][2][2];
            {
                const unsigned vbase = (unsigned)(unsigned long long)(lds + OFF_V + buf * VBYTES) + (unsigned)((32 * sub + 4 * hh + ((lane & 15) >> 2)) * VPB + (16 * ((lane >> 4) & 1) + 4 * (lane & 3)) * 2);
#pragma unroll
                for (int dp = 0; dp < NDB; dp += 2)
                    asm volatile("ds_read_b64_tr_b16 %0, %9 offset:%10\n\tds_read_b64_tr_b16 %1, %9 offset:%11\n\tds_read_b64_tr_b16 %2, %9 offset:%12\n\tds_read_b64_tr_b16 %3, %9 offset:%13\n\t"
                                 "ds_read_b64_tr_b16 %4, %9 offset:%14\n\tds_read_b64_tr_b16 %5, %9 offset:%15\n\tds_read_b64_tr_b16 %6, %9 offset:%16\n\tds_read_b64_tr_b16 %7, %9 offset:%17"
                                 : "=&v"(vf[dp][0][0]), "=&v"(vf[dp][0][1]), "=&v"(vf[dp][1][0]), "=&v"(vf[dp][1][1]), "=&v"(vf[dp + 1][0][0]), "=&v"(vf[dp + 1][0][1]), "=&v"(vf[dp + 1][1][0]), "=&v"(vf[dp + 1][1][1]), "+v"(s)
                                 : "v"(vbase),
                                   "i"(64 * dp + 0 * VPB), "i"(64 * dp + 8 * VPB), "i"(64 * dp + 16 * VPB), "i"(64 * dp + 24 * VPB),
                                   "i"(64 * (dp + 1) + 0 * VPB), "i"(64 * (dp + 1) + 8 * VPB), "i"(64 * (dp + 1) + 16 * VPB), "i"(64 * (dp + 1) + 24 * VPB)
                                 : "memory");
            }
            if constexpr (MODE == 0 || MODE == 2) {
                if (ks0 + 31 > qw0) {
#pragma unroll
                    for (int i = 0; i < 16; ++i) { const int key = ks0 + (i & 3) + 8 * (i >> 2) + 4 * hh; if (key > qpos) s[i] = -__builtin_inff(); }
                }
            }
            if constexpr (MODE == 1) {
#pragma unroll
                for (int i = 0; i < 16; ++i) { const int key = ks0 + (i & 3) + 8 * (i >> 2) + 4 * hh; if ((unsigned)(qpos - key) >= 128u) s[i] = -__builtin_inff(); }
            }
            float psum = 0.f;
#pragma unroll
            for (int i = 0; i < 16; ++i) { s[i] = __builtin_amdgcn_exp2f(MODE == 2 ? s[i] - mshift : s[i]); psum += s[i]; }
            l_run += psum;
            bf16x8 P[2];
#pragma unroll
            for (int s2 = 0; s2 < 2; ++s2) { u32x4 pw; pw.x = pk2(s[8 * s2], s[8 * s2 + 1]); pw.y = pk2(s[8 * s2 + 2], s[8 * s2 + 3]); pw.z = pk2(s[8 * s2 + 4], s[8 * s2 + 5]); pw.w = pk2(s[8 * s2 + 6], s[8 * s2 + 7]); P[s2] = __builtin_bit_cast(bf16x8, pw); }
            if constexpr (NDB == 2)
                asm volatile("s_waitcnt lgkmcnt(0)" : "+v"(vf[0][0][0]), "+v"(vf[0][0][1]), "+v"(vf[0][1][0]), "+v"(vf[0][1][1]), "+v"(vf[1][0][0]), "+v"(vf[1][0][1]), "+v"(vf[1][1][0]), "+v"(vf[1][1][1]), "+v"(P[0]), "+v"(P[1]) :: "memory");
            else
                asm volatile("s_waitcnt lgkmcnt(0)" : "+v"(vf[0][0][0]), "+v"(vf[0][0][1]), "+v"(vf[0][1][0]), "+v"(vf[0][1][1]), "+v"(vf[1][0][0]), "+v"(vf[1][0][1]), "+v"(vf[1][1][0]), "+v"(vf[1][1][1]),
                                                      "+v"(vf[NDB - 2][0][0]), "+v"(vf[NDB - 2][0][1]), "+v"(vf[NDB - 2][1][0]), "+v"(vf[NDB - 2][1][1]), "+v"(vf[NDB - 1][0][0]), "+v"(vf[NDB - 1][0][1]), "+v"(vf[NDB - 1][1][0]), "+v"(vf[NDB - 1][1][1]), "+v"(P[0]), "+v"(P[1]) :: "memory");
#pragma unroll
            for (int db = 0; db < NDB; ++db)
#pragma unroll
                for (int s2 = 0; s2 < 2; ++s2) {
                    const bf16x8 a = __builtin_bit_cast(bf16x8, (u32x4){vf[db][s2][0].x, vf[db][s2][0].y, vf[db][s2][1].x, vf[db][s2][1].y});
                    O[db] = __builtin_amdgcn_mfma_f32_32x32x16_bf16(a, P[s2], O[db], 0, 0, 0);
                }
        }
        FA_PT1(11);
    }
    FA_PT0(13);
#undef FA_LOAD
#undef FA_WRITE
    float l_tot = xor32_sum(l_run);
    if constexpr (MODE == 1) l_tot += __builtin_amdgcn_exp2f(A.sinks[hw] * LOG2E - mshift);
    const float inv_l = 1.0f / l_tot;
    bf16_t* Op = A.O + (size_t)(b * SEQ + qpos) * A.o_pitch + A.o_col0 + hw * DV;
#pragma unroll
    for (int db = 0; db < NDB; ++db)
#pragma unroll
        for (int gp = 0; gp < 4; gp += 2) {
            u32x2 a, c;
            a.x = pk2(O[db][4 * gp] * inv_l, O[db][4 * gp + 1] * inv_l); a.y = pk2(O[db][4 * gp + 2] * inv_l, O[db][4 * gp + 3] * inv_l);
            c.x = pk2(O[db][4 * gp + 4] * inv_l, O[db][4 * gp + 5] * inv_l); c.y = pk2(O[db][4 * gp + 6] * inv_l, O[db][4 * gp + 7] * inv_l);
            const auto rx = __builtin_amdgcn_permlane32_swap(a.x, c.x, false, false);
            const auto ry = __builtin_amdgcn_permlane32_swap(a.y, c.y, false, false);
            *(u32x4*)(Op + 32 * db + 8 * gp + 8 * hh) = (u32x4){rx[0], ry[0], rx[1], ry[1]};
        }
    __syncthreads();
    FA_PT1(13);
#undef FA_PT0
#undef FA_PT1
}

template <int D>
__device__ __forceinline__ void headnorm_items(const bf16_t* src, int src_pitch, int src_col0, int src_hstride, int H, const float* gain,
                                               bf16_t* dst, int dst_D, int dst_d0, int S, int M, int gw, int NGW, int lane) {
    constexpr int LPI = D / 8, IPW = 64 / LPI;
    const int li = lane % LPI, sub = lane / LPI;
    const f32x4 g0 = *(const f32x4*)(gain + 8 * li), g1 = *(const f32x4*)(gain + 8 * li + 4);
    const int total = M * H;
    for (int it = gw * IPW + sub; it < total; it += NGW * IPW) {
        const int m = it / H, h = it % H;
        const u32x4 v = *(const u32x4*)(src + (size_t)m * src_pitch + src_col0 + h * src_hstride + 8 * li);
        float f[8]; unpack8(v, f);
        float ss = 0.f;
#pragma unroll
        for (int j = 0; j < 8; ++j) ss += f[j] * f[j];
#pragma unroll
        for (int o = 1; o < LPI; o <<= 1) ss += __shfl_xor(ss, o);
        const float rs = 1.0f / sqrtf(ss * (1.0f / D) + RMS_EPS);
#pragma unroll
        for (int j = 0; j < 4; ++j) { f[j] *= rs * g0[j]; f[4 + j] *= rs * g1[j]; }
        const int bb = m / S, s = m % S;
        *(u32x4*)(dst + ((size_t)(bb * H + h) * S + s) * dst_D + dst_d0 + 8 * li) = pack8(f);
    }
}
__device__ __forceinline__ void mla_krope_items(const bf16_t* src, int src_pitch, int col0, const float* gain, bf16_t* KR, int gw, int NGW, int lane) {
    const int li = lane & 7, sub = lane >> 3;
    const f32x4 ga = *(const f32x4*)(gain + 4 * li), gb = *(const f32x4*)(gain + 32 + 4 * li);
    for (int m = gw * 8 + sub; m < MTOK; m += NGW * 8) {
        const u32x2 va = *(const u32x2*)(src + (size_t)m * src_pitch + col0 + 4 * li), vb = *(const u32x2*)(src + (size_t)m * src_pitch + col0 + 32 + 4 * li);
        float a[4] = {bf_lo(va.x), bf_hi(va.x), bf_lo(va.y), bf_hi(va.y)}, bq[4] = {bf_lo(vb.x), bf_hi(vb.x), bf_lo(vb.y), bf_hi(vb.y)};
        float ss = 0.f;
#pragma unroll
        for (int j = 0; j < 4; ++j) ss += a[j] * a[j] + bq[j] * bq[j];
        ss += __shfl_xor(ss, 1); ss += __shfl_xor(ss, 2); ss += __shfl_xor(ss, 4);
        const float rs = 1.0f / sqrtf(ss * (1.0f / 64.0f) + RMS_EPS);
        const int s = m % SEQ;
        float o1[4], o2[4];
#pragma unroll
        for (int j = 0; j < 4; ++j) { const float t1 = a[j] * rs * ga[j], t2 = bq[j] * rs * gb[j]; float c, sn; rope_cs(s, 4 * li + j, c, sn); o1[j] = t1 * c - t2 * sn; o2[j] = t1 * sn + t2 * c; }
        *(u32x2*)(KR + (size_t)m * 64 + 4 * li) = (u32x2){pk2(o1[0], o1[1]), pk2(o1[2], o1[3])};
        *(u32x2*)(KR + (size_t)m * 64 + 32 + 4 * li) = (u32x2){pk2(o2[0], o2[1]), pk2(o2[2], o2[3])};
    }
}
__device__ __forceinline__ void vtrans_items(const bf16_t* src, int pitch, int col0, int hstride, int H, int DV, bf16_t* dst, int S, int B, LAS unsigned char* scr, int gw, int NGW, int lane) {
    const int ndb = DV / 32, ntb = S / 64, total = B * H * ntb * ndb;
    for (int it = gw; it < total; it += NGW) {
        const int dbk = it % ndb, tb = (it / ndb) % ntb, bh = it / (ndb * ntb), bb = bh / H, h = bh % H;
        u32x4 v[4];
#pragma unroll
        for (int i = 0; i < 4; ++i) { const int c = lane + 64 * i, tok = c >> 2, dc = c & 3; v[i] = *(const u32x4*)(src + (size_t)(bb * S + 64 * tb + tok) * pitch + col0 + h * hstride + 32 * dbk + 8 * dc); }
#pragma unroll
        for (int i = 0; i < 4; ++i) { const int c = lane + 64 * i, tok = c >> 2, dc = c & 3; const unsigned wv[4] = {v[i].x, v[i].y, v[i].z, v[i].w};
#pragma unroll
            for (int e = 0; e < 8; ++e) *(LAS unsigned short*)(scr + ((8 * dc + e) * 66 + tok) * 2) = (unsigned short)((e & 1) ? (wv[e >> 1] >> 16) : (wv[e >> 1] & 0xffffu)); }
        asm volatile("s_waitcnt lgkmcnt(0)" ::: "memory");
        const int d = lane & 31, half = lane >> 5;
        unsigned o[16];
#pragma unroll
        for (int i = 0; i < 16; ++i) o[i] = *(const LAS unsigned*)(scr + (d * 66 + 32 * half + 2 * i) * 2);
        bf16_t* dp = dst + ((size_t)(bh * DV + 32 * dbk + d)) * S + 64 * tb + 32 * half;
#pragma unroll
        for (int i = 0; i < 4; ++i) *(u32x4*)(dp + 8 * i) = (u32x4){o[4 * i], o[4 * i + 1], o[4 * i + 2], o[4 * i + 3]};
        asm volatile("s_waitcnt lgkmcnt(0)" ::: "memory");
    }
}
__device__ __forceinline__ void conv_items(const bf16_t* u, const float* cw, bf16_t* cat, int gt, int NT) {
    const int total = (MTOK / 4) * (D_MODEL / 8);
    for (int it = gt; it < total; it += NT) {
        const int tg = it / (D_MODEL / 8), c8 = (it % (D_MODEL / 8)) * 8, m0 = 4 * tg, s0 = m0 % SEQ;
        u32x4 gcv[6], xtv[6], gbv[4];
#pragma unroll
        for (int i = 0; i < 6; ++i) {
            const int mi = (s0 + i - 2 >= 0) ? m0 + i - 2 : m0;
            const bf16_t* p = u + (size_t)mi * NIN0 + c8; gcv[i] = *(const u32x4*)(p + D_MODEL); xtv[i] = *(const u32x4*)(p + 2 * D_MODEL);
        }
#pragma unroll
        for (int k = 0; k < 4; ++k) gbv[k] = *(const u32x4*)(u + (size_t)(m0 + k) * NIN0 + c8);
        float w0[8], w1[8], w2[8];
#pragma unroll
        for (int j = 0; j < 8; ++j) { w0[j] = cw[c8 + j]; w1[j] = cw[D_MODEL + c8 + j]; w2[j] = cw[2 * D_MODEL + c8 + j]; }
        float z[6][8];
#pragma unroll
        for (int i = 0; i < 6; ++i) { float a[8], b[8]; unpack8(gcv[i], a); unpack8(xtv[i], b); const bool ok = (s0 + i - 2 >= 0);
#pragma unroll
            for (int j = 0; j < 8; ++j) z[i][j] = ok ? a[j] * b[j] : 0.f; }
#pragma unroll
        for (int k = 0; k < 4; ++k) { float gb[8], o[8]; unpack8(gbv[k], gb);
#pragma unroll
            for (int j = 0; j < 8; ++j) o[j] = gb[j] * (z[k][j] * w0[j] + z[k + 1][j] * w1[j] + z[k + 2][j] * w2[j]);
            *(u32x4*)(cat + (size_t)(m0 + k) * K_OUT + c8) = pack8(o); }
    }
}
__device__ __forceinline__ void fox_scan_items(const bf16_t* u, int pitch, int fcol0, const float* bfv, float* CB, int gw, int NGW, int lane) {
    if ((gw & 15) != 0 && NGW >= 2048) return;
    const int w16 = NGW >= 2048 ? (gw >> 4) : gw, nw16 = NGW >= 2048 ? (NGW >> 4) : NGW;
    for (int it = w16; it < BATCH * 32; it += nw16) {
        const int bb = it / 32, h = it % 32; const float bias = bfv[h];
        float v[32]; float run = 0.f;
#pragma unroll
        for (int i = 0; i < 32; ++i) { const int s = lane * 32 + i; const float x = __uint_as_float(((unsigned)u[(size_t)(bb * SEQ + s) * pitch + fcol0 + h]) << 16) + bias;
            const float ls = fminf(x, 0.f) - __builtin_amdgcn_logf(1.0f + __builtin_amdgcn_exp2f(-fabsf(x) * LOG2E)) * 0.6931471805599453f; run += ls; v[i] = run; }
        float tot = run;
#pragma unroll
        for (int o = 1; o < 64; o <<= 1) { const float t = __shfl_up(tot, o); if (lane >= o) tot += t; }
        const float base = tot - run;
        float* cp = CB + (size_t)it * SEQ + lane * 32;
#pragma unroll
        for (int i = 0; i < 8; ++i) *(f32x4*)(cp + 4 * i) = (f32x4){-(base + v[4 * i]) * LOG2E, -(base + v[4 * i + 1]) * LOG2E, -(base + v[4 * i + 2]) * LOG2E, -(base + v[4 * i + 3]) * LOG2E};
    }
}
__device__ __forceinline__ void rowinit_items(const float* src, bf16_t* dst, float* ps, int rows, int gw, int NGW, int lane) {
    for (int m = gw; m < rows; m += NGW) {
        const f32x4* xr = (const f32x4*)(src + (size_t)m * D_MODEL); float ss = 0.f;
#pragma unroll
        for (int j = 0; j < 8; ++j) { const f32x4 v = xr[64 * j + lane]; ss += (v[0] * v[0] + v[1] * v[1]) + (v[2] * v[2] + v[3] * v[3]);
            *(u32x2*)(dst + (size_t)m * D_MODEL + 4 * (64 * j + lane)) = (u32x2){pk2(v[0], v[1]), pk2(v[2], v[3])}; }
#pragma unroll
        for (int o = 1; o < 64; o <<= 1) ss += __shfl_xor(ss, o);
        if (lane < 32) ps[(size_t)m * 32 + lane] = (lane == 0) ? ss : 0.f;
    }
}

struct Seg { int in_idx; int src_off; int K; int Nsrc; int col0; int ncols; int dst_mib; int drow0; int gain_idx; int gain_off; int inter; int start; };
__device__ const Seg SEGS[] = {
    {I_F1G, 0, 2048, 5632, 0, 5632, 488, 0, I_NORM_FFN1, 0, 1, 0},
    {I_F1U, 0, 2048, 5632, 0, 5632, 488, 128, I_NORM_FFN1, 0, 1, 5632},
    {I_MEM_WKV, 0, 2048, 1024, 0, 1024, 1135, 0, I_NORM_MEM, 0, 0, 11264},
    {I_MEM_WKV, 2097152, 2048, 1024, 0, 1024, 1135, 1024, I_NORM_MEM, 2048, 0, 12288},
    {I_MEM_WKV, 4194304, 2048, 1024, 0, 1024, 1135, 2048, I_NORM_MEM, 4096, 0, 13312},
    {I_MEM_WKV, 6291456, 2048, 1024, 0, 1024, 1135, 3072, I_NORM_MEM, 6144, 0, 14336},
    {I_F1D, 0, 5632, 2048, 0, 2048, 840, 0, -1, 0, 0, 15360},
    {I_CONV_WIN, 0, 2048, 6656, 0, 6656, 1016, 0, I_NORM_MIX, 0, 0, 20992},
    {I_CONV_WOUT, 0, 2560, 2048, 0, 2048, 1088, 0, -1, 0, 0, 27648},
    {I_F2G, 0, 2048, 5632, 0, 5632, 532, 0, I_NORM_FFN2, 0, 1, 30208},
    {I_F2U, 0, 2048, 5632, 0, 5632, 532, 128, I_NORM_FFN2, 0, 1, 35840},
    {I_F2D, 0, 5632, 2048, 0, 2048, 862, 0, -1, 0, 0, 41472},
    {I_F1G, 11534336, 2048, 5632, 0, 5632, 576, 0, I_NORM_FFN1, 2048, 1, 47104},
    {I_F1U, 11534336, 2048, 5632, 0, 5632, 576, 128, I_NORM_FFN1, 2048, 1, 52736},
    {I_F1D, 11534336, 5632, 2048, 0, 2048, 884, 0, -1, 0, 0, 58368},
    {I_MLA_WIN, 0, 2048, 1600, 0, 1024, 1042, 0, I_NORM_MIX, 2048, 0, 64000},
    {I_MLA_WIN, 0, 2048, 1600, 1088, 512, 1042, 1024, I_NORM_MIX, 2048, 0, 65024},
    {I_MLA_WIN, 0, 2048, 1600, 1024, 64, 1042, 1536, I_NORM_MIX, 2048, 0, 65536},
    {I_MLA_WQB, 0, 512, 3072, 0, 3072, 1128, 0, I_MLA_QAN, 0, 0, 65600},
    {I_MLA_WKVB, 0, 512, 4096, 0, 4096, 1131, 0, I_MLA_KVAN, 0, 0, 66368},
    {I_MLA_WOUT, 0, 2560, 2048, 0, 2048, 1098, 0, -1, 0, 0, 67392},
    {I_F2G, 11534336, 2048, 5632, 0, 5632, 620, 0, I_NORM_FFN2, 2048, 1, 69952},
    {I_F2U, 11534336, 2048, 5632, 0, 5632, 620, 128, I_NORM_FFN2, 2048, 1, 75584},
    {I_F2D, 11534336, 5632, 2048, 0, 2048, 906, 0, -1, 0, 0, 81216},
    {I_F1G, 23068672, 2048, 5632, 0, 5632, 664, 0, I_NORM_FFN1, 4096, 1, 86848},
    {I_F1U, 23068672, 2048, 5632, 0, 5632, 664, 128, I_NORM_FFN1, 4096, 1, 92480},
    {I_F1D, 23068672, 5632, 2048, 0, 2048, 928, 0, -1, 0, 0, 98112},
    {I_SWA_WIN, 0, 2048, 3072, 0, 3072, 1049, 0, I_NORM_MIX, 4096, 0, 103744},
    {I_SWA_WOUT, 0, 2560, 2048, 0, 2048, 1108, 0, -1, 0, 0, 106816},
    {I_F2G, 23068672, 2048, 5632, 0, 5632, 708, 0, I_NORM_FFN2, 4096, 1, 109376},
    {I_F2U, 23068672, 2048, 5632, 0, 5632, 708, 128, I_NORM_FFN2, 4096, 1, 115008},
    {I_F2D, 23068672, 5632, 2048, 0, 2048, 950, 0, -1, 0, 0, 120640},
    {I_F1G, 34603008, 2048, 5632, 0, 5632, 752, 0, I_NORM_FFN1, 6144, 1, 126272},
    {I_F1U, 34603008, 2048, 5632, 0, 5632, 752, 128, I_NORM_FFN1, 6144, 1, 131904},
    {I_F1D, 34603008, 5632, 2048, 0, 2048, 972, 0, -1, 0, 0, 137536},
    {I_FOX_WIN, 0, 2048, 6688, 0, 6144, 1061, 0, I_NORM_MIX, 6144, 0, 143168},
    {I_FOX_WIN, 0, 2048, 6688, 6176, 512, 1061, 6144, I_NORM_MIX, 6144, 0, 149312},
    {I_FOX_WIN, 0, 2048, 6688, 6144, 32, 1061, 6656, I_NORM_MIX, 6144, 0, 149824},
    {I_FOX_WOUT, 0, 2560, 2048, 0, 2048, 1118, 0, -1, 0, 0, 149856},
    {I_F2G, 34603008, 2048, 5632, 0, 5632, 796, 0, I_NORM_FFN2, 6144, 1, 152416},
    {I_F2U, 34603008, 2048, 5632, 0, 5632, 796, 128, I_NORM_FFN2, 6144, 1, 158048},
    {I_F2D, 34603008, 5632, 2048, 0, 2048, 994, 0, -1, 0, 0, 163680},
};
constexpr int NSEG = 42, NITEMS = 169312, P0_ITEMS = 21504;
struct Slot { int phase, blk0, nblk, it0, it1; };
constexpr Slot SLOTS[] = {{1, 192, 64, 21504, 27648}, {3, 64, 192, 27648, 46080}, {4, 128, 128, 46080, 52224}, {6, 128, 128, 52224, 64512}, {8, 128, 128, 64512, 76800}, {10, 224, 32, 76800, 79872}, {13, 128, 128, 79872, 86016}, {15, 128, 128, 86016, 98304}, {17, 128, 128, 98304, 110592}, {19, 128, 128, 110592, 122880}, {21, 128, 128, 122880, 129024}, {23, 128, 128, 129024, 141312}, {25, 128, 128, 141312, 153600}, {27, 96, 160, 153600, 168960}, {29, 128, 128, 168960, 169312}, {31, 128, 128, 169312, 169312}};
constexpr int NSLOT = 16;
constexpr int slot_of(int phase) { for (int i = 0; i < NSLOT; ++i) if (SLOTS[i].phase == phase) return i; return -1; }

struct CvtItem { const float* src; bf16_t* dst; const float* gain; int Nsrc, K; };
__device__ __forceinline__ void cvt_load(const CvtItem& c, int lane, f32x4 (&v)[8]) {
    const float* p = c.src + (size_t)(8 * (lane >> 3)) * c.Nsrc + 4 * (lane & 7);
#pragma unroll
    for (int j = 0; j < 8; ++j) v[j] = __builtin_nontemporal_load((const f32x4*)(p + (size_t)j * c.Nsrc));
}
__device__ __forceinline__ void cvt_store(const CvtItem& c, int lane, const f32x4 (&v)[8]) {
    f32x4 g0 = (f32x4){1.f, 1.f, 1.f, 1.f}, g1 = g0;
    if (c.gain) { g0 = *(const f32x4*)(c.gain + 8 * (lane >> 3)); g1 = *(const f32x4*)(c.gain + 8 * (lane >> 3) + 4); }
    bf16_t* q = c.dst + (size_t)(4 * (lane & 7)) * c.K + 8 * (lane >> 3);
#pragma unroll
    for (int e = 0; e < 4; ++e) {
        u32x4 o; o.x = pk2(v[0][e] * g0[0], v[1][e] * g0[1]); o.y = pk2(v[2][e] * g0[2], v[3][e] * g0[3]); o.z = pk2(v[4][e] * g1[0], v[5][e] * g1[1]); o.w = pk2(v[6][e] * g1[2], v[7][e] * g1[3]);
        __builtin_nontemporal_store(o, (u32x4*)(q + (size_t)e * c.K));
    }
}

#define XB_TMO      128
#define XB_XCNT(j)  (256  + 64 * (j))
#define XB_XSUB(j)  (1280 + 64 * (j))
#define XB_XGEN(j)  (2304 + 64 * (j))
#define XB_TOP      3328
#define XB_TOPGEN   3392
#define XCD_BAR_WORDS 3456
#define XB_SPIN_CAP (1u << 18)
__device__ __forceinline__ unsigned xb_ld(unsigned* p)              { return __hip_atomic_load(p, __ATOMIC_RELAXED, __HIP_MEMORY_SCOPE_AGENT); }
__device__ __forceinline__ unsigned xb_add(unsigned* p, unsigned v) { return __hip_atomic_fetch_add(p, v, __ATOMIC_RELAXED, __HIP_MEMORY_SCOPE_AGENT); }
__device__ __forceinline__ unsigned xb_xcc_id() { return (unsigned)__builtin_amdgcn_s_getreg((3 << 11) | 20) & 0xFu; }
#define XB_SPIN(cond, bar) do { unsigned _sp = 0; while (cond) { __builtin_amdgcn_s_sleep(1); \
    if ((++_sp & 255u) == 0u) { if (xb_ld(&(bar)[XB_TMO])) break; if (_sp > XB_SPIN_CAP) { atomicAdd(&(bar)[XB_TMO], 1u); break; } } } } while (0)
struct XcdBarrier { unsigned* bar; unsigned x; volatile LAS unsigned* st; };
__device__ __forceinline__ XcdBarrier xcd_barrier_post(unsigned* bar, volatile LAS unsigned* st) {
    XcdBarrier b; b.bar = bar; b.x = xb_xcc_id(); b.st = st;
    if (threadIdx.x == 0) (void)xb_add(&bar[XB_XCNT(b.x)], 1u);
    return b;
}
__device__ __forceinline__ void xcd_barrier_complete(unsigned* bar, unsigned x, unsigned& nloc, unsigned& nx) {
    const unsigned G = gridDim.x * gridDim.y * gridDim.z;
    unsigned sum, cnt, mine, sp = 0u;
    for (;;) {
        sum = 0u; cnt = 0u; mine = 0u;
#pragma unroll
        for (unsigned j = 0; j < 16; ++j) { const unsigned c = xb_ld(&bar[XB_XCNT(j)]); sum += c; cnt += (c > 0u) ? 1u : 0u; mine = (j == x) ? c : mine; }
        if (sum == G) break;
        __builtin_amdgcn_s_sleep(1);
        if ((++sp & 255u) == 0u) { if (xb_ld(&bar[XB_TMO])) break; if (sp > XB_SPIN_CAP) { atomicAdd(&bar[XB_TMO], 1u); break; } }
    }
    nloc = mine > 0u ? mine : 1u; nx = cnt > 0u ? cnt : 1u;
}
__device__ __forceinline__ void xcd_barrier(const XcdBarrier& b) {
    asm volatile("s_waitcnt vmcnt(0)" ::: "memory");
    __syncthreads();
    if (threadIdx.x == 0) {
        unsigned* bar = b.bar;
        __builtin_amdgcn_s_waitcnt(0);
        unsigned nloc = b.st[0], nx = b.st[1];
        if (nloc == 0u) { xcd_barrier_complete(bar, b.x, nloc, nx); b.st[0] = nloc; b.st[1] = nx; }
        const unsigned old = xb_add(&bar[XB_XSUB(b.x)], 1u);
        const unsigned gen = old / nloc;
        if (old + 1u == (gen + 1u) * nloc) {
            __builtin_amdgcn_fence(__ATOMIC_RELEASE, "agent");
            asm volatile("s_waitcnt vmcnt(0)" ::: "memory");
            const unsigned og = xb_add(&bar[XB_TOP], 1u);
            const unsigned tg = og / nx;
            if (og + 1u == (tg + 1u) * nx) xb_add(&bar[XB_TOPGEN], 1u);
            else XB_SPIN(xb_ld(&bar[XB_TOPGEN]) == tg, bar);
            __builtin_amdgcn_fence(__ATOMIC_ACQUIRE, "agent");
            xb_add(&bar[XB_XGEN(b.x)], 1u);
            asm volatile("s_waitcnt vmcnt(0)" ::: "memory");
        } else {
            XB_SPIN(xb_ld(&bar[XB_XGEN(b.x)]) == gen, bar);
            __builtin_amdgcn_fence(__ATOMIC_ACQUIRE, "agent");
            asm volatile("s_waitcnt vmcnt(0)" ::: "memory");
        }
    }
    __syncthreads();
}

constexpr int RING_BYTES = 131072, LDSCTL_OFF = RING_BYTES, LDS_BYTES = 147456;
constexpr int KG_LDS = 122880;
constexpr int CW_BAR = 4096;
constexpr int NPHASES = 33;

struct Args { const float* in[N_INPUTS]; float* out; unsigned char* ws; int ph_lo, ph_hi; };
static_assert(sizeof(Args) == N_INPUTS * 8 + 8 + 8 + 8, "Args has no padding");

__device__ __forceinline__ CvtItem cvt_item(const Args& args, unsigned char* ws, int it, int& sg) {
    while (sg + 1 < NSEG && it >= SEGS[sg + 1].start) ++sg;
    const Seg s = SEGS[sg];
    const int nbc = s.ncols / 32, rr = it - s.start, kb = rr / nbc, nb = rr % nbc, n = 32 * nb;
    const int drow = s.drow0 + (s.inter ? (((n >> 7) << 8) + (n & 127)) : n);
    CvtItem c;
    c.src = args.in[s.in_idx] + s.src_off + (size_t)(64 * kb) * s.Nsrc + s.col0 + n;
    c.dst = (bf16_t*)(ws + (size_t)s.dst_mib * MiB) + (size_t)drow * s.K + 64 * kb;
    c.gain = s.gain_idx >= 0 ? args.in[s.gain_idx] + s.gain_off + 64 * kb : nullptr;
    c.Nsrc = s.Nsrc; c.K = s.K;
    return c;
}
__device__ __forceinline__ void convert_range(const Args& args, unsigned char* ws, int it0, int it1, int widx, int nw, int lane) {
    int sg = 0;
    int it = it0 + widx;
    for (; it + nw < it1; it += 2 * nw) {
        const CvtItem a = cvt_item(args, ws, it, sg); const CvtItem b = cvt_item(args, ws, it + nw, sg);
        f32x4 va[8], vb[8];
        cvt_load(a, lane, va); cvt_load(b, lane, vb);
        cvt_store(a, lane, va); cvt_store(b, lane, vb);
    }
    if (it < it1) { const CvtItem a = cvt_item(args, ws, it, sg); f32x4 va[8]; cvt_load(a, lane, va); cvt_store(a, lane, va); }
}

__global__ void __launch_bounds__(512, 2) trunk_fwd(Args args) {
    extern __shared__ __attribute__((aligned(16))) unsigned char lds_raw[];
    LAS unsigned char* lds = (LAS unsigned char*)lds_raw;
    const int tid = threadIdx.x, wave = __builtin_amdgcn_readfirstlane(tid >> 6);
    const int G = gridDim.x, bx = blockIdx.x;
    const int vcu = (G % 8 == 0) ? (bx % 8) * (G / 8) + bx / 8 : bx;
    const int gw = vcu * 8 + wave, NGW = G * 8, NT = NGW * 64;
    const bool plan_ok = (G == 256);
#define LANE_ ({ int t_ = threadIdx.x; asm volatile("" : "+v"(t_)); t_ & 63; })
#define GT_ (gw * 64 + LANE_)
    unsigned char* ws = args.ws;
    const int lo = args.ph_lo, hi = args.ph_hi;
    for (int u = tid; u < (LDS_BYTES - LDSCTL_OFF) / 4; u += 512) ((LAS unsigned*)(lds + LDSCTL_OFF))[u] = 0u;
    __syncthreads();
    XcdBarrier bar; bar.bar = (unsigned*)(ws + WS_CTL) + CW_BAR; bar.x = 0; bar.st = nullptr;
    if (hi - lo > 1) bar = xcd_barrier_post((unsigned*)(ws + WS_CTL) + CW_BAR, (volatile LAS unsigned*)(lds + LDSCTL_OFF + 64));

    float* PSUM = (float*)(ws + WS_PSUM); float* UPS = (float*)(ws + WS_UPS); float* PSMEM = (float*)(ws + WS_PSMEM); float* CB = (float*)(ws + WS_CB);
    bf16_t* XB = (bf16_t*)(ws + WS_XB); bf16_t* XL = (bf16_t*)(ws + WS_XL); bf16_t* MEMB = (bf16_t*)(ws + WS_MEMB); bf16_t* MKV = (bf16_t*)(ws + WS_MKV);
    bf16_t* CAT = (bf16_t*)(ws + WS_CAT); bf16_t* HID = (bf16_t*)(ws + WS_HID); bf16_t* U = (bf16_t*)(ws + WS_U); bf16_t* QM = (bf16_t*)(ws + WS_QM); bf16_t* KVM = (bf16_t*)(ws + WS_KVM);

    float* OUT = args.out;

    unsigned long long pacc = 0, pph = 0; (void)pph;
#define PH(id) if (PROBE_SEC == 6 && PROBE_ARG == (id)) pph = PT_NOW(); if (lo <= (id) && (id) < hi)
#define BAR(id) do { if (PROBE_SEC == 6 && PROBE_ARG == (id)) { asm volatile("s_waitcnt vmcnt(0)" ::: "memory"); __syncthreads(); pacc += PT_NOW() - pph; } \
        if (lo <= (id) && (id) + 1 < hi) { const bool pb_ = (PROBE_SEC == 1) || (PROBE_SEC == 7 && PROBE_ARG == (id)); const unsigned long long tb_ = pb_ ? PT_NOW() : 0ull; xcd_barrier(bar); if (pb_) pacc += PT_NOW() - tb_; } } while (0)
#define GEMM_PHASE_C(PC, EPI_T, E_INIT, Aptr, Bptr, M_, N_, K_, LDA_, C_) do { pg8::Gemm g_{(Aptr), (Bptr), (M_), (N_), (K_), (LDA_)}; pg8::StaticOrder S_; S_.init((M_), (N_), G, (C_)); \
        EPI_T E_ E_INIT; pg8::gemm_phase<EPI_T, pg8::StaticOrder, true, PC>(lds, g_, S_, E_, pacc); } while (0)
#define GEMM_PHASE(PC, EPI_T, E_INIT, Aptr, Bptr, M_, N_, K_, LDA_) do { pg8::Gemm g_{(Aptr), (Bptr), (M_), (N_), (K_), (LDA_)}; pg8::StaticOrder S_; S_.init((M_), (N_), G, bx); \
        EPI_T E_ E_INIT; pg8::gemm_phase<EPI_T, pg8::StaticOrder, true, PC>(lds, g_, S_, E_, pacc); } while (0)
#define COMMA ,
#define TAIL_SLOT(id) do { constexpr int k_ = slot_of(id); if constexpr (k_ >= 0) { if (plan_ok && bx >= SLOTS[k_].blk0) \
        convert_range(args, ws, SLOTS[k_].it0, SLOTS[k_].it1, (bx - SLOTS[k_].blk0) * 8 + wave, SLOTS[k_].nblk * 8, LANE_); } } while (0)

    PH(0) {
        if (plan_ok) {
            const int lane = LANE_;
            f32x4 xv[4][8];
#pragma unroll
            for (int r4 = 0; r4 < 4; ++r4)
#pragma unroll
                for (int j = 0; j < 8; ++j) xv[r4][j] = ((const f32x4*)(args.in[I_X] + (size_t)(gw + r4 * 2048) * D_MODEL))[64 * j + lane];
            convert_range(args, ws, 0, P0_ITEMS, gw, NGW, lane);
#pragma unroll
            for (int r4 = 0; r4 < 4; ++r4) {
                const int m = gw + r4 * 2048; float ss = 0.f;
#pragma unroll
                for (int j = 0; j < 8; ++j) { const f32x4 v = xv[r4][j]; ss += (v[0] * v[0] + v[1] * v[1]) + (v[2] * v[2] + v[3] * v[3]);
                    *(u32x2*)(XB + (size_t)m * D_MODEL + 4 * (64 * j + lane)) = (u32x2){pk2(v[0], v[1]), pk2(v[2], v[3])}; }
#pragma unroll
                for (int o = 1; o < 64; o <<= 1) ss += __shfl_xor(ss, o);
                if (lane < 32) PSUM[(size_t)m * 32 + lane] = (lane == 0) ? ss : 0.f;
            }
        } else {
            convert_range(args, ws, 0, NITEMS, gw, NGW, LANE_);
            rowinit_items(args.in[I_X], XB, PSUM, MTOK, gw, NGW, LANE_);
        }
        rowinit_items(args.in[I_MEM], MEMB, PSMEM, MMEM, gw, NGW, LANE_);
        { u32x4* z1 = (u32x4*)(ws + WS_WIN1 + (size_t)1600 * D_MODEL * 2); const int n1 = 192 * D_MODEL * 2 / 16; for (int i = GT_; i < n1; i += NT) z1[i] = (u32x4){0u, 0u, 0u, 0u};
          u32x4* z3 = (u32x4*)(ws + WS_WIN3 + (size_t)6688 * D_MODEL * 2); const int n3 = 224 * D_MODEL * 2 / 16; for (int i = GT_; i < n3; i += NT) z3[i] = (u32x4){0u, 0u, 0u, 0u}; }
    }
    BAR(0);

#define GU_PHASE(id, L, WHICH) PH(id) GEMM_PHASE(0, pg8::EpiSwiGLU, {HID COMMA PSUM}, XB, (const bf16_t*)(ws + WS_WGU + (size_t)(2 * (L) + (WHICH)) * WGU_BYTES), MTOK, N_GU, D_MODEL, D_MODEL)
#define DN_PHASE(id, L, WHICH, RMODE) PH(id) GEMM_PHASE(1, pg8::EpiResid<RMODE>, {args.in[I_X] COMMA OUT COMMA XB COMMA XL COMMA PSUM COMMA 0.5f}, HID, (const bf16_t*)(ws + WS_WD + (size_t)(2 * (L) + (WHICH)) * WD_BYTES), MTOK, D_MODEL, D_FF, D_FF); BAR(id)
#define OUT_PHASE(id, L) PH(id) GEMM_PHASE(3, pg8::EpiResid<1>, {args.in[I_X] COMMA OUT COMMA XB COMMA XL COMMA PSUM COMMA 1.0f}, CAT, (const bf16_t*)(ws + WS_WOUT + (size_t)(L) * WOUT_BYTES), MTOK, D_MODEL, K_OUT, K_OUT); BAR(id)
#define MEM_FA(L, UPITCH, MQCOL) do { FaArgs fa_; fa_.Q = U; fa_.q_pitch = (UPITCH); fa_.q_col0 = (MQCOL); fa_.q_hstride = 128; fa_.K = MKV; fa_.k_pitch = 4096; fa_.k_col0 = (L) * 1024; fa_.k_hstride = 128; fa_.kgain = args.in[I_MEM_KN] + (L) * 128; fa_.kg_lds = KG_LDS + 512; fa_.KR = nullptr; fa_.V = MKV; fa_.v_pitch = 4096; fa_.v_col0 = (L) * 1024 + 512; fa_.v_hstride = 128; \
        fa_.Skv = MEM_LEN; fa_.kv_group = 1; fa_.nheads = 4; fa_.O = CAT; fa_.o_pitch = K_OUT; fa_.o_col0 = 2048; fa_.qgain = args.in[I_MEM_QN] + (L) * 128; fa_.bias = nullptr; fa_.sinks = nullptr; \
        fa_.qscale = 0.08838834764831845f * LOG2E; fa_.mbound = fa_mbound(fa_.qgain, args.in[I_MEM_KN] + (L) * 128, 128, 0, fa_.qscale); \
        if (tid < 32) *(LAS f32x4*)(lds + KG_LDS + 512 + 16 * tid) = *(const f32x4*)(fa_.kgain + 4 * tid); __syncthreads(); \
        for (int i_ = bx; i_ < 16 * 8; i_ += G) fa_unit<128, 128, 3>(lds, fa_, (i_ >> 3) >> 2, (i_ >> 3) & 3, i_ & 7, pacc); } while (0)

    PH(1) {
        GEMM_PHASE(0, pg8::EpiSwiGLU, {HID COMMA PSUM}, XB, (const bf16_t*)(ws + WS_WGU), MTOK, N_GU, D_MODEL, D_MODEL);
        GEMM_PHASE_C(5, pg8::EpiScale<32 COMMA false>, {MKV COMMA 4096 COMMA PSMEM COMMA 32 COMMA 0 COMMA 1.0f / D_MODEL COMMA nullptr}, MEMB, (const bf16_t*)(ws + WS_WMKV), MMEM, 4096, D_MODEL, D_MODEL, plan_ok ? ((bx + 128) & 255) : bx);
        TAIL_SLOT(1);
    }
    BAR(1);
    DN_PHASE(2, 0, 0, 0);
    PH(3) {
        GEMM_PHASE(2, pg8::EpiScale<32 COMMA false>, {U COMMA NIN0 COMMA PSUM COMMA 32 COMMA 0 COMMA 1.0f / D_MODEL COMMA nullptr}, XB, (const bf16_t*)(ws + WS_WIN0), MTOK, NIN0, D_MODEL, D_MODEL);
        TAIL_SLOT(3);
    }
    BAR(3);
    PH(4) { conv_items(U, args.in[I_CONV_W], CAT, GT_, NT); MEM_FA(0, NIN0, 6144); TAIL_SLOT(4); }
    BAR(4);
    OUT_PHASE(5, 0);
    PH(6) { GEMM_PHASE(0, pg8::EpiSwiGLU, {HID COMMA PSUM}, XB, (const bf16_t*)(ws + WS_WGU + (size_t)1 * WGU_BYTES), MTOK, N_GU, D_MODEL, D_MODEL); TAIL_SLOT(6); }
    BAR(6);
    DN_PHASE(7, 0, 1, 1);

    PH(8) { GEMM_PHASE(0, pg8::EpiSwiGLU, {HID COMMA PSUM}, XB, (const bf16_t*)(ws + WS_WGU + (size_t)2 * WGU_BYTES), MTOK, N_GU, D_MODEL, D_MODEL); TAIL_SLOT(8); }
    BAR(8);
    DN_PHASE(9, 1, 0, 1);
    PH(10) { GEMM_PHASE(2, pg8::EpiScale<32 COMMA true>, {U COMMA NIN1 COMMA PSUM COMMA 32 COMMA 0 COMMA 1.0f / D_MODEL COMMA UPS}, XB, (const bf16_t*)(ws + WS_WIN1), MTOK, NIN1, D_MODEL, D_MODEL); TAIL_SLOT(10); }
    BAR(10);
    PH(11) {
        GEMM_PHASE(4, pg8::EpiScale<8 COMMA false>, {QM COMMA 3072 COMMA UPS COMMA 32 COMMA 0 COMMA 1.0f / 512.0f COMMA nullptr}, U, (const bf16_t*)(ws + WS_WQB), MTOK, 3072, 512, NIN1);
        GEMM_PHASE(4, pg8::EpiScale<8 COMMA false>, {KVM COMMA 4096 COMMA UPS COMMA 32 COMMA 8 COMMA 1.0f / 512.0f COMMA nullptr}, U + 512, (const bf16_t*)(ws + WS_WKVB), MTOK, 4096, 512, NIN1);
        if (plan_ok) { if (bx >= 128) mla_krope_items(U, NIN1, 1536, args.in[I_MLA_KN] + 128, (bf16_t*)(ws + WS_MK), (bx - 128) * 8 + wave, 1024, LANE_); }
        else mla_krope_items(U, NIN1, 1536, args.in[I_MLA_KN] + 128, (bf16_t*)(ws + WS_MK), gw, NGW, LANE_);
    }
    BAR(11);
    PH(13) {
        FaArgs fa; fa.Q = QM; fa.q_pitch = 3072; fa.q_col0 = 0; fa.q_hstride = 192; fa.K = KVM; fa.k_pitch = 4096; fa.k_col0 = 0; fa.k_hstride = 256; fa.kgain = args.in[I_MLA_KN]; fa.kg_lds = KG_LDS; fa.KR = (const bf16_t*)(ws + WS_MK);
        fa.V = KVM; fa.v_pitch = 4096; fa.v_col0 = 128; fa.v_hstride = 256; fa.Skv = SEQ; fa.kv_group = 1; fa.nheads = 16;
        if (tid < 32) *(LAS f32x4*)(lds + KG_LDS + 16 * tid) = *(const f32x4*)(fa.kgain + 4 * tid);
        __syncthreads();
        fa.O = CAT; fa.o_pitch = K_OUT; fa.o_col0 = 0; fa.qgain = args.in[I_MLA_QN]; fa.bias = nullptr; fa.sinks = nullptr; fa.qscale = 0.07216878364870323f * LOG2E; fa.mbound = fa_mbound(fa.qgain, args.in[I_MLA_KN], 128, 64, fa.qscale);
        for (int j = vcu; j < 64 * 4; j += G) { const int bh = j >> 2, q4 = j & 3; for (int k = 0; k < 2; ++k) fa_unit<192, 128, 0>(lds, fa, bh >> 4, bh & 15, k ? q4 : 7 - q4, pacc); }
        MEM_FA(1, NIN1, 1024);
        TAIL_SLOT(13);
    }
    BAR(13);
    OUT_PHASE(14, 1);
    PH(15) { GEMM_PHASE(0, pg8::EpiSwiGLU, {HID COMMA PSUM}, XB, (const bf16_t*)(ws + WS_WGU + (size_t)3 * WGU_BYTES), MTOK, N_GU, D_MODEL, D_MODEL); TAIL_SLOT(15); }
    BAR(15);
    DN_PHASE(16, 1, 1, 1);

    PH(17) { GEMM_PHASE(0, pg8::EpiSwiGLU, {HID COMMA PSUM}, XB, (const bf16_t*)(ws + WS_WGU + (size_t)4 * WGU_BYTES), MTOK, N_GU, D_MODEL, D_MODEL); TAIL_SLOT(17); }
    BAR(17);
    DN_PHASE(18, 2, 0, 1);
    PH(19) { GEMM_PHASE(2, pg8::EpiScale<32 COMMA false>, {U COMMA NIN2 COMMA PSUM COMMA 32 COMMA 0 COMMA 1.0f / D_MODEL COMMA nullptr}, XB, (const bf16_t*)(ws + WS_WIN2), MTOK, NIN2, D_MODEL, D_MODEL); TAIL_SLOT(19); }
    BAR(19);
    PH(21) {
        FaArgs fa; fa.Q = U; fa.q_pitch = NIN2; fa.q_col0 = 0; fa.q_hstride = 64; fa.K = U; fa.k_pitch = NIN2; fa.k_col0 = 2048; fa.k_hstride = 64; fa.kgain = args.in[I_SWA_KN]; fa.kg_lds = 0; fa.KR = nullptr;
        fa.V = U; fa.v_pitch = NIN2; fa.v_col0 = 2304; fa.v_hstride = 64; fa.Skv = SEQ; fa.kv_group = 8; fa.nheads = 32;
        fa.O = CAT; fa.o_pitch = K_OUT; fa.o_col0 = 0; fa.qgain = args.in[I_SWA_QN]; fa.bias = args.in[I_REL_BIAS]; fa.sinks = args.in[I_SWA_SINKS]; fa.qscale = 0.125f * LOG2E; fa.mbound = fa_mbound(fa.qgain, args.in[I_SWA_KN], 64, 0, fa.qscale);
        for (int i = vcu, k = 0; i < 1024; i += G, ++k) fa_unit<64, 64, 1>(lds, fa, i >> 8, ((i >> 6) & 3) * 8 + ((i >> 5) & 1) * 4, ((i & 31) + 8 * k) & 31, pacc);
        MEM_FA(2, NIN2, 2560);
        TAIL_SLOT(21);
    }
    BAR(21);
    OUT_PHASE(22, 2);
    PH(23) { GEMM_PHASE(0, pg8::EpiSwiGLU, {HID COMMA PSUM}, XB, (const bf16_t*)(ws + WS_WGU + (size_t)5 * WGU_BYTES), MTOK, N_GU, D_MODEL, D_MODEL); TAIL_SLOT(23); }
    BAR(23);
    DN_PHASE(24, 2, 1, 1);

    PH(25) { GEMM_PHASE(0, pg8::EpiSwiGLU, {HID COMMA PSUM}, XB, (const bf16_t*)(ws + WS_WGU + (size_t)6 * WGU_BYTES), MTOK, N_GU, D_MODEL, D_MODEL); TAIL_SLOT(25); }
    BAR(25);
    DN_PHASE(26, 3, 0, 1);
    PH(27) { GEMM_PHASE(2, pg8::EpiScale<32 COMMA false>, {U COMMA NIN3 COMMA PSUM COMMA 32 COMMA 0 COMMA 1.0f / D_MODEL COMMA nullptr}, XB, (const bf16_t*)(ws + WS_WIN3), MTOK, NIN3, D_MODEL, D_MODEL); TAIL_SLOT(27); }
    BAR(27);
    PH(28) { fox_scan_items(U, NIN3, 6656, args.in[I_FOX_BF], CB, gw, NGW, LANE_); }
    BAR(28);
    PH(29) {
        FaArgs fa; fa.Q = U; fa.q_pitch = NIN3; fa.q_col0 = 0; fa.q_hstride = 64; fa.K = U; fa.k_pitch = NIN3; fa.k_col0 = 2048; fa.k_hstride = 64; fa.kgain = args.in[I_FOX_KN]; fa.kg_lds = 0; fa.KR = nullptr;
        fa.V = U; fa.v_pitch = NIN3; fa.v_col0 = 4096; fa.v_hstride = 64; fa.Skv = SEQ; fa.kv_group = 1; fa.nheads = 32;
        fa.O = CAT; fa.o_pitch = K_OUT; fa.o_col0 = 0; fa.qgain = args.in[I_FOX_QN]; fa.bias = CB; fa.sinks = nullptr; fa.qscale = 0.125f * LOG2E; fa.mbound = fa_mbound(fa.qgain, args.in[I_FOX_KN], 64, 0, fa.qscale);
        for (int j = vcu; j < 128 * 4; j += G) { const int bh = j >> 2, q4 = j & 3; for (int k = 0; k < 2; ++k) fa_unit<64, 64, 2>(lds, fa, bh >> 5, bh & 31, k ? q4 : 7 - q4, pacc); }
        MEM_FA(3, NIN3, 6144);
        TAIL_SLOT(29);
    }
    BAR(29);
    OUT_PHASE(30, 3);
    PH(31) { GEMM_PHASE(0, pg8::EpiSwiGLU, {HID COMMA PSUM}, XB, (const bf16_t*)(ws + WS_WGU + (size_t)7 * WGU_BYTES), MTOK, N_GU, D_MODEL, D_MODEL); TAIL_SLOT(31); }
    BAR(31);
    DN_PHASE(32, 3, 1, 2);
    if (PROBE_SEC != 0 && bx == 0 && wave == 0) { const unsigned long long t_end = PT_NOW() + PROBE_K * pacc; while (PT_NOW() < t_end) __builtin_amdgcn_s_sleep(32); }
}

extern "C" void kernel_launch(void* const* d_in, const int* in_sizes, int n_in, void* d_out, int out_size, void* d_ws, size_t ws_size, hipStream_t stream) {
    static int grid = 0;
    if (grid == 0) {
        if (n_in != N_INPUTS || out_size != MTOK * D_MODEL || ws_size < WS_END) { fprintf(stderr, "kernel_launch: unexpected problem: n_in %d out %d ws %zu (need %zu)\n", n_in, out_size, ws_size, (size_t)WS_END); grid = -1; return; }
        int dev = 0, cus = 0, per_cu = 0;
        if (hipGetDevice(&dev) != hipSuccess || hipDeviceGetAttribute(&cus, hipDeviceAttributeMultiprocessorCount, dev) != hipSuccess) { grid = -1; return; }
        if (hipFuncSetAttribute((const void*)trunk_fwd, hipFuncAttributeMaxDynamicSharedMemorySize, LDS_BYTES) != hipSuccess) { fprintf(stderr, "kernel_launch: hipFuncSetAttribute failed\n"); grid = -1; return; }
        if (hipOccupancyMaxActiveBlocksPerMultiprocessor(&per_cu, (const void*)trunk_fwd, 512, LDS_BYTES) != hipSuccess || per_cu < 1)
            fprintf(stderr, "kernel_launch: note: occupancy query reports %d workgroups per CU\n", per_cu);
        (void)hipGetLastError();
        grid = cus;
    }
    if (grid < 0) return;
    if (hipMemsetAsync((char*)d_ws + WS_CTL, 0, CTL_ZERO_BYTES, stream) != hipSuccess) { fprintf(stderr, "kernel_launch: memset failed\n"); return; }
    Args a{};
    for (int i = 0; i < N_INPUTS; ++i) a.in[i] = (const float*)d_in[i];
    a.out = (float*)d_out; a.ws = (unsigned char*)d_ws;
#if MK_ONE_LAUNCH
    a.ph_lo = 0; a.ph_hi = NPHASES;
    hipLaunchKernelGGL(trunk_fwd, dim3(grid), dim3(512), LDS_BYTES, stream, a);
#else
    for (int p = 0; p < NPHASES; ++p) { a.ph_lo = p; a.ph_hi = p + 1; hipLaunchKernelGGL(trunk_fwd, dim3(grid), dim3(512), LDS_BYTES, stream, a); }
#endif
    const hipError_t le = hipPeekAtLastError();
    if (le != hipSuccess) fprintf(stderr, "kernel_launch: launch failed: %s\n", hipGetErrorName(le));
}
```
